# Optimizing an MI355X kernel written in HIP

```python
import jax, jax.numpy as jnp
from jax import lax
import numpy as np

D_MODEL = 1024
BATCH = 16
SEQ = 2048
DEPTH = 4

CTX_LEN = 256
GRID_W = 64

N_BRANCH = 4
BRANCH_W = D_MODEL // 4
GLA_HEADS = 4
GLA_DV = BRANCH_W // GLA_HEADS
GLA_DK = GLA_DV // 2
QK_W = GLA_HEADS * GLA_DK
V_W = GLA_HEADS * GLA_DV
GLA_CHUNK = 64
GK_RANK = 16
GK_TAU = 16.0
POOL_WINDOWS = (2, 4, 8, 16)
POOL_GROUP = BRANCH_W // 4
POOL_W = BRANCH_W
FFT_GROUPS = 4
FFT_GROUP = BRANCH_W // FFT_GROUPS
FFT_W = BRANCH_W
SGU_GROUPS = 4
SGU_GROUP = BRANCH_W // SGU_GROUPS
SGU_CHUNK = 128
SGU_W = BRANCH_W
IN_WIDTHS = (QK_W, QK_W, V_W, V_W, GK_RANK, GK_RANK, POOL_W, FFT_W, SGU_W, SGU_W)
N_IN = sum(IN_WIDTHS)
D_FF = 2816
N_EXPERTS = 8
TOP_K = 2
ALPHA = (2 * DEPTH) ** 0.25
BETA = (8 * DEPTH) ** -0.25
EPS = 1e-6

kernel_name = "hybrid_gla_pool_fourier_sgu_moe_dit"


def layer_norm(x, g=None, b=None):
    xf = x.astype(jnp.float32)
    mu = jnp.mean(xf, -1, keepdims=True)
    var = jnp.mean(jnp.square(xf - mu), -1, keepdims=True)
    y = ((xf - mu) * lax.rsqrt(var + EPS)).astype(x.dtype)
    if g is not None:
        y = y * g + b
    return y


def modulate(x, shift, scale):
    return layer_norm(x) * (1 + scale) + shift


def split_cols(p):
    offsets = [int(o) for o in np.cumsum(IN_WIDTHS)[:-1]]
    return jnp.split(p, offsets, axis=-1)


def split_heads(a, n):
    bsz, t, w = a.shape
    return a.reshape(bsz, t, n, w // n).transpose(0, 2, 1, 3)


def gla_chunked(q, k, v, log_a, h0, inclusive):
    bsz, nh, t, _ = q.shape
    dv = v.shape[-1]
    n = t // GLA_CHUNK
    rs = lambda a: a.reshape(bsz, nh, n, GLA_CHUNK, a.shape[-1])
    q, k, v, log_a = rs(q), rs(k), rs(v), rs(log_a)
    b = jnp.cumsum(log_a, axis=3)
    b_last = b[:, :, :, -1:, :]
    q_e = q * jnp.exp(b)
    k_e = k * jnp.exp(-b)
    k_tail = k * jnp.exp(b_last - b)
    mask = jnp.tril(jnp.ones((GLA_CHUNK, GLA_CHUNK), bool), 0 if inclusive else -1)
    att = jnp.where(mask, jnp.einsum('bhncd,bhnsd->bhncs', q_e, k_e), 0.0)
    o_intra = jnp.einsum('bhncs,bhnsv->bhncv', att, v)
    dh = jnp.einsum('bhncd,bhncv->bhndv', k_tail, v)
    decay = jnp.exp(b_last[:, :, :, 0, :])

    def step(h, inp):
        dec, d = inp
        return dec[..., None] * h + d, h

    h_final, h_prev = lax.scan(step, h0, (jnp.moveaxis(decay, 2, 0), jnp.moveaxis(dh, 2, 0)))
    h_prev = jnp.moveaxis(h_prev, 0, 2)
    o_inter = jnp.einsum('bhncd,bhndv->bhncv', q_e, h_prev)
    return (o_intra + o_inter).reshape(bsz, nh, t, dv), h_final


def gla_direction(q, k, v, log_a, h0, reverse):
    if reverse:
        fl = lambda a: jnp.flip(a, 2)
        o, h = gla_chunked(fl(q), fl(k), fl(v), fl(log_a), h0, False)
        return fl(o), h
    return gla_chunked(q, k, v, log_a, h0, True)


def gla_final_state(k, v, log_a):
    b = jnp.cumsum(log_a, axis=2)
    w = jnp.exp(b[:, :, -1:, :] - b)
    return jnp.einsum('bhtd,bhtv->bhdv', k * w, v)


def gla_inputs(q, k, v, lf, lb, w_gk2, b_gk):
    f32 = jnp.float32
    q = split_heads(q.astype(f32), GLA_HEADS) * GLA_DK ** -0.5
    k = split_heads(k.astype(f32), GLA_HEADS)
    v = split_heads(v.astype(f32), GLA_HEADS)
    la_f = split_heads(jax.nn.log_sigmoid((lf @ w_gk2[0] + b_gk[0]).astype(f32)) / GK_TAU, GLA_HEADS)
    la_b = split_heads(jax.nn.log_sigmoid((lb @ w_gk2[1] + b_gk[1]).astype(f32)) / GK_TAU, GLA_HEADS)
    return q, k, v, la_f, la_b


def gla_output(o_f, o_b, r, g):
    o = (o_f + o_b).transpose(0, 2, 1, 3)
    o = o * lax.rsqrt(jnp.mean(jnp.square(o), -1, keepdims=True) + EPS)
    bsz, t = o.shape[:2]
    return o.reshape(bsz, t, V_W).astype(r.dtype) * g * jax.nn.silu(r)


def window_mean(x, win, axis):
    n = x.shape[axis]
    pad_shape = list(x.shape)
    pad_shape[axis] = 1
    prefix = jnp.concatenate([jnp.zeros(pad_shape, x.dtype), jnp.cumsum(x, axis=axis)], axis=axis)
    pos = jnp.arange(n)
    lo = jnp.clip(pos - win // 2, 0, n)
    hi = jnp.clip(pos + (win - win // 2), 0, n)
    total = jnp.take(prefix, hi, axis=axis) - jnp.take(prefix, lo, axis=axis)
    cnt_shape = [1] * x.ndim
    cnt_shape[axis] = n
    return total / (hi - lo).astype(x.dtype).reshape(cnt_shape)


def pool_branch(xp, pool_w, pool_scale, rows):
    bsz, t, w = xp.shape
    xf = xp.astype(jnp.float32)
    if rows is not None:
        xf = xf.reshape(bsz, rows, GRID_W, w)
    outs = []
    for gi, win in enumerate(POOL_WINDOWS):
        xg = xf[..., gi * POOL_GROUP:(gi + 1) * POOL_GROUP]
        m = window_mean(xg, win, 1)
        if rows is not None:
            m = window_mean(m, win, 2)
        outs.append(jnp.einsum('...c,cd->...d', (m - xg).astype(xp.dtype), pool_w[gi]))
    return jnp.concatenate(outs, -1).reshape(bsz, t, w) * pool_scale


def fourier_branch(xf_in):
    bsz, t, w = xf_in.shape
    z = xf_in.astype(jnp.float32).reshape(bsz, t, FFT_GROUPS, FFT_GROUP)
    y = jnp.fft.fft2(z, axes=(1, 3), norm="ortho").real
    return y.reshape(bsz, t, w).astype(xf_in.dtype)


def sgu_branch(u, v, ln_g, ln_b, sgu_w, sgu_b):
    bsz, t, w = u.shape
    u = jax.nn.gelu(u)
    v = layer_norm(jax.nn.gelu(v), ln_g, ln_b)
    vb = v.reshape(bsz, t // SGU_CHUNK, SGU_CHUNK, SGU_GROUPS, SGU_GROUP)
    s = jnp.einsum('gst,bntgc->bnsgc', sgu_w, vb) + sgu_b.T[None, None, :, :, None]
    return u * s.reshape(bsz, t, w)


def mixer_out(h, cols, o_f, o_b, rows, gla_g, pool_w, pool_scale, sgu_ln_g, sgu_ln_b, sgu_w, sgu_b,
              w_gate, w_branch, w_o):
    ys = (gla_output(o_f, o_b, cols[3], gla_g),
          pool_branch(cols[6], pool_w, pool_scale, rows),
          fourier_branch(cols[7]),
          sgu_branch(cols[8], cols[9], sgu_ln_g, sgu_ln_b, sgu_w, sgu_b))
    m = jax.nn.sigmoid(h @ w_gate[0]) * (ys[0] @ w_branch[0])
    for i in range(1, N_BRANCH):
        m = m + jax.nn.sigmoid(h @ w_gate[i]) * (ys[i] @ w_branch[i])
    return m @ w_o


def token_mix(h_ctx, h_lat, rows, w_in, w_gk2, b_gk, gla_g, pool_w, pool_scale, sgu_ln_g, sgu_ln_b,
              sgu_w, sgu_b, w_gate, w_branch, w_o, ctx_out):
    cc = split_cols(h_ctx @ w_in)
    cl = split_cols(h_lat @ w_in)
    qc, kc, vc, afc, abc = gla_inputs(cc[0], cc[1], cc[2], cc[4], cc[5], w_gk2, b_gk)
    ql, kl, vl, afl, abl = gla_inputs(cl[0], cl[1], cl[2], cl[4], cl[5], w_gk2, b_gk)
    bsz = h_ctx.shape[0]
    zero = jnp.zeros((bsz, GLA_HEADS, GLA_DK, GLA_DV), jnp.float32)
    if ctx_out:
        ocf, hcf = gla_direction(qc, kc, vc, afc, zero, False)
        ocb, hcb = gla_direction(qc, kc, vc, abc, zero, True)
    else:
        fl = lambda a: jnp.flip(a, 2)
        hcf = gla_final_state(kc, vc, afc)
        hcb = gla_final_state(fl(kc), fl(vc), fl(abc))
    olf, _ = gla_direction(ql, kl, vl, afl, hcf, False)
    olb, _ = gla_direction(ql, kl, vl, abl, hcb, True)
    y_lat = mixer_out(h_lat, cl, olf, olb, rows, gla_g, pool_w, pool_scale, sgu_ln_g, sgu_ln_b,
                      sgu_w, sgu_b, w_gate, w_branch, w_o)
    y_ctx = None
    if ctx_out:
        y_ctx = mixer_out(h_ctx, cc, ocf, ocb, None, gla_g, pool_w, pool_scale, sgu_ln_g, sgu_ln_b,
                          sgu_w, sgu_b, w_gate, w_branch, w_o)
    return y_ctx, y_lat


def swiglu(h, wg, wu, wd):
    return (jax.nn.silu(h @ wg) * (h @ wu)) @ wd


def moe_swiglu(h, w_router, wg, wu, wd):
    logits = (h @ w_router).astype(jnp.float32)
    top_v, top_i = lax.top_k(logits, TOP_K)
    top_w = jax.nn.softmax(top_v, axis=-1)
    gate = jnp.sum(jax.nn.one_hot(top_i, N_EXPERTS, dtype=jnp.float32) * top_w[..., None], axis=-2)
    gate = gate.astype(h.dtype)
    out = gate[..., 0:1] * swiglu(h, wg[0], wu[0], wd[0])
    for e in range(1, N_EXPERTS):
        out = out + gate[..., e:e + 1] * swiglu(h, wg[e], wu[e], wd[e])
    return out


def setup_inputs(seed: int = 0) -> dict:
    key = jax.random.key(seed)
    ks = iter(jax.random.split(key, 40))
    nrm = lambda shape, scale: jax.random.normal(next(ks), shape, jnp.float32) * scale
    D = D_MODEL
    n_dense = (DEPTH + 1) // 2
    n_moe = DEPTH // 2
    return {
        "x": nrm((BATCH, SEQ, D), 1.0),
        "c": nrm((BATCH, D), 1.0),
        "ctx": nrm((BATCH, CTX_LEN, D), 1.0),
        "c_ctx": nrm((D,), 1.0),
        "w_mod": nrm((DEPTH, D, 6 * D), 0.5 * D ** -0.5),
        "b_mod": nrm((DEPTH, 6 * D), 0.02),
        "w_in": nrm((DEPTH, D, N_IN), D ** -0.5),
        "w_gk2": nrm((DEPTH, 2, GK_RANK, QK_W), GK_RANK ** -0.5),
        "b_gk": 1.0 + nrm((DEPTH, 2, QK_W), 0.5),
        "gla_g": 1.0 + nrm((DEPTH, V_W), 0.02),
        "pool_w": nrm((DEPTH, len(POOL_WINDOWS), POOL_GROUP, POOL_GROUP), POOL_GROUP ** -0.5),
        "pool_scale": 1.0 + nrm((DEPTH, POOL_W), 0.02),
        "sgu_ln_g": 1.0 + nrm((DEPTH, SGU_W), 0.02),
        "sgu_ln_b": nrm((DEPTH, SGU_W), 0.02),
        "sgu_w": nrm((DEPTH, SGU_GROUPS, SGU_CHUNK, SGU_CHUNK), SGU_CHUNK ** -0.5),
        "sgu_b": 1.0 + nrm((DEPTH, SGU_GROUPS, SGU_CHUNK), 0.02),
        "w_gate": nrm((DEPTH, N_BRANCH, D, D), D ** -0.5),
        "w_branch": nrm((DEPTH, N_BRANCH, BRANCH_W, D), BRANCH_W ** -0.5),
        "w_o": nrm((DEPTH, D, D), BETA * D ** -0.5),
        "ln_g": 1.0 + nrm((DEPTH, 2, D), 0.02),
        "ln_b": nrm((DEPTH, 2, D), 0.02),
        "w_ffn_gate": nrm((n_dense, D, D_FF), D ** -0.5),
        "w_ffn_up": nrm((n_dense, D, D_FF), D ** -0.5),
        "w_ffn_down": nrm((n_dense, D_FF, D), BETA * D_FF ** -0.5),
        "w_router": nrm((n_moe, D, N_EXPERTS), D ** -0.5),
        "w_exp_gate": nrm((n_moe, N_EXPERTS, D, D_FF), D ** -0.5),
        "w_exp_up": nrm((n_moe, N_EXPERTS, D, D_FF), D ** -0.5),
        "w_exp_down": nrm((n_moe, N_EXPERTS, D_FF, D), BETA * D_FF ** -0.5),
    }


def reference(x, c, ctx, c_ctx, w_mod, b_mod, w_in, w_gk2, b_gk, gla_g, pool_w, pool_scale,
              sgu_ln_g, sgu_ln_b, sgu_w, sgu_b, w_gate, w_branch, w_o, ln_g, ln_b,
              w_ffn_gate, w_ffn_up, w_ffn_down, w_router, w_exp_gate, w_exp_up, w_exp_down):
    rows = x.shape[1] // GRID_W
    s_lat = jax.nn.silu(c)[:, None, :]
    s_ctx = jax.nn.silu(c_ctx)[None, None, :]
    xl, xc = x, ctx
    for l in range(DEPTH):
        last = l == DEPTH - 1
        ml = jnp.split(s_lat @ w_mod[l] + b_mod[l], 6, axis=-1)
        mc = jnp.split(s_ctx @ w_mod[l] + b_mod[l], 6, axis=-1)
        hl = modulate(xl, ml[0], ml[1])
        hc = modulate(xc, mc[0], mc[1])
        yc, yl = token_mix(hc, hl, rows, w_in[l], w_gk2[l], b_gk[l], gla_g[l], pool_w[l],
                           pool_scale[l], sgu_ln_g[l], sgu_ln_b[l], sgu_w[l], sgu_b[l],
                           w_gate[l], w_branch[l], w_o[l], not last)
        xl = layer_norm(ALPHA * xl + ml[2] * yl, ln_g[l, 0], ln_b[l, 0])
        if not last:
            xc = layer_norm(ALPHA * xc + mc[2] * yc, ln_g[l, 0], ln_b[l, 0])
        if l % 2 == 0:
            ffn = lambda h, i=l // 2: swiglu(h, w_ffn_gate[i], w_ffn_up[i], w_ffn_down[i])
        else:
            ffn = lambda h, i=l // 2: moe_swiglu(h, w_router[i], w_exp_gate[i], w_exp_up[i], w_exp_down[i])
        hl = modulate(xl, ml[3], ml[4])
        xl = layer_norm(ALPHA * xl + ml[5] * ffn(hl), ln_g[l, 1], ln_b[l, 1])
        if not last:
            hc = modulate(xc, mc[3], mc[4])
            xc = layer_norm(ALPHA * xc + mc[5] * ffn(hc), ln_g[l, 1], ln_b[l, 1])
    return xl
```

```cpp
#include <hip/hip_runtime.h>
#include <cstdio>
#include <cstdint>

#define GAS __attribute__((address_space(1)))
#define LAS __attribute__((address_space(3)))
typedef unsigned short bf16;
typedef short bf16x8 __attribute__((ext_vector_type(8)));
typedef float f32x4 __attribute__((ext_vector_type(4)));
typedef unsigned u32x4 __attribute__((ext_vector_type(4)));
typedef unsigned u32x2 __attribute__((ext_vector_type(2)));
typedef float f32x2 __attribute__((ext_vector_type(2)));

#ifndef PROBE
#define PROBE 0
#endif
constexpr int NB = 16, T = 2048, TC = 256, D = 1024, DEPTH = 4;
constexpr int MLAT = NB * T, MCTX = NB * TC, M = MLAT + MCTX;
constexpr int NIN = 1824, NINP = 2048, DFF = 2816, NE = 8;
constexpr int NTHR = 512, NWAVE = 8;
constexpr float ALPHA = 1.6817928305074290f;
constexpr float EPS = 1e-6f;
constexpr int C_Q = 0, C_K = 128, C_V = 256, C_R = 512, C_LAF = 768, C_LAB = 896, C_POOL = 1024, C_FFT = 1280, C_SU = 1536, C_SV = 1792;

constexpr size_t MiB = 1u << 20;
constexpr size_t WS_CTL = 0, CTL_BYTES = 1 * MiB;
constexpr size_t WS_MOD = 1 * MiB;
constexpr size_t WS_CS64 = 3 * MiB;
constexpr size_t WS_DLC = 3 * MiB + 65536;
constexpr size_t WS_SGUW = 3 * MiB + 512 * 1024;
constexpr size_t WS_TF1 = 4 * MiB;
constexpr size_t WS_TF2 = 4 * MiB + 8192;
constexpr size_t WS_TW = 4 * MiB + 24576;
constexpr size_t WS_ROUTE = 20 * MiB;
constexpr size_t WS_W = 22 * MiB;
constexpr size_t WS_XC = 384 * MiB;
constexpr size_t WS_G8 = WS_XC;
constexpr size_t OUT_H8 = 72 * MiB;
constexpr bool DOWN8_DENSE = true;
constexpr bool DOWN8_MOE = true;
constexpr float ACT8_SCALE = 2.0f;
constexpr float G8_SCALE = 32.0f;
constexpr size_t WS_H = 400 * MiB;
constexpr bool XBF16 = true;
constexpr size_t WS_R = 472 * MiB;
constexpr size_t WS_END = 904 * MiB;
constexpr size_t R_YS = 0, R_MM = 72 * MiB, R_BIG = 144 * MiB;
constexpr size_t R_COLS = R_BIG, R_SCR = R_BIG + 144 * MiB;
constexpr size_t R_ZT = R_SCR, R_ZTC = R_SCR + 32 * MiB, R_DH = R_SCR + 36 * MiB, R_DEC = R_SCR + 72 * MiB;
constexpr size_t R_G = R_BIG;
constexpr size_t R_ACT = 0, R_Y2 = 204 * MiB;
constexpr size_t WE_WIN = 0;
constexpr size_t WE_WBR = WE_WIN + (size_t)4 * 6144 * 1024;
constexpr size_t WE_WO = WE_WBR + (size_t)4 * 4 * 1024 * 256;
constexpr size_t WE_GUD = WE_WO + (size_t)4 * 1024 * 1024;
constexpr size_t WE_DD = WE_GUD + (size_t)2 * 5632 * 1024;
constexpr size_t WE_GUE = WE_DD + (size_t)2 * 1024 * 2816;
constexpr size_t WE_DE = WE_GUE + (size_t)2 * 8 * 5632 * 1024;
constexpr size_t WE_END = WE_DE + (size_t)2 * 8 * 1024 * 2816;
static_assert(WE_END * 2 <= 362 * MiB, "weights fit");
constexpr int MAXP = 296;
constexpr size_t RT_TOKE = 0, RT_TOKR = (size_t)M * 2, RT_TOKW = (size_t)M * 4, RT_TOKS = (size_t)M * 6, RT_S2T = (size_t)M * 8, RT_PE = RT_S2T + (size_t)MAXP * 256, RT_BLK = RT_PE + 512, RT_IDT = RT_BLK + 2048;
static_assert((RT_IDT + M) * 4 <= 2 * MiB, "route tables fit");
constexpr int CW_BAR = 4096;
constexpr int CW_CNT = 16384;
constexpr int LDS_BYTES = 147456;
constexpr int LDS_MISC = 147456 - 256;

typedef __bf16 hwbf2 __attribute__((ext_vector_type(2)));
__device__ __forceinline__ unsigned pk2(float lo, float hi) { hwbf2 v; v[0] = (__bf16)lo; v[1] = (__bf16)hi; return __builtin_bit_cast(unsigned, v); }
__device__ __forceinline__ unsigned f2bf(float f) { return (unsigned)__builtin_bit_cast(unsigned short, (__bf16)f); }
__device__ __forceinline__ unsigned pk4_fp8(float a, float b, float c, float d) { int w = 0; w = __builtin_amdgcn_cvt_pk_fp8_f32(a, b, w, false); w = __builtin_amdgcn_cvt_pk_fp8_f32(c, d, w, true); return (unsigned)w; }
__device__ __forceinline__ float bf2f(unsigned b) { return __builtin_bit_cast(float, b << 16); }
__device__ __forceinline__ float bflo(unsigned w) { return __builtin_bit_cast(float, w << 16); }
__device__ __forceinline__ float bfhi(unsigned w) { return __builtin_bit_cast(float, w & 0xffff0000u); }
typedef float f32x2 __attribute__((ext_vector_type(2)));
__device__ __forceinline__ float sigmoidf_(float x) { return __builtin_amdgcn_rcpf(1.0f + __expf(-x)); }
__device__ __forceinline__ float siluf_(float x) { return x * __builtin_amdgcn_rcpf(1.0f + __expf(-x)); }
__device__ __forceinline__ float gelu_tanh_(float x) { const float u = 0.7978845608028654f * (x + 0.044715f * x * x * x); return x * __builtin_amdgcn_rcpf(1.0f + __expf(-2.0f * u)); }
__device__ __forceinline__ float logsigmoidf_(float z) { return fminf(z, 0.f) - __logf(1.0f + __expf(-fabsf(z))); }
template <int CTRL, int RMASK> __device__ __forceinline__ float dpp_get(float v) { return __builtin_bit_cast(float, __builtin_amdgcn_update_dpp(0, __builtin_bit_cast(int, v), CTRL, RMASK, 0xF, true)); }
__device__ __forceinline__ float wave_sum(float v) {
    v += dpp_get<0xB1, 0xF>(v); v += dpp_get<0x4E, 0xF>(v); v += dpp_get<0x141, 0xF>(v); v += dpp_get<0x140, 0xF>(v);
    v += dpp_get<0x142, 0xA>(v); v += dpp_get<0x143, 0xC>(v);
    return __builtin_bit_cast(float, __builtin_amdgcn_readlane(__builtin_bit_cast(int, v), 63));
}

__device__ __forceinline__ int otid() { int t = threadIdx.x; asm volatile("" : "+v"(t)); return t; }
__device__ __forceinline__ int oblk() { int b = blockIdx.x; asm volatile("" : "+s"(b)); return b; }
__device__ __forceinline__ int ogrid() { int g = gridDim.x; asm volatile("" : "+s"(g)); return g; }
__device__ __forceinline__ int owave() { return __builtin_amdgcn_readfirstlane(otid() >> 6); }
__device__ __forceinline__ unsigned ozero() { unsigned z; asm volatile("s_mov_b32 %0, 0" : "=s"(z)); return z; }
__device__ __forceinline__ unsigned char* ows(unsigned char* p) { return p + ozero(); }
__device__ __forceinline__ const float* const* oin(const float* const* p) { return p; }
__device__ __forceinline__ float* oout(float* p) { return p + ozero(); }

#define XB_TMO      128
#define XB_XCNT(j)  (256  + 64 * (j))
#define XB_XSUB(j)  (1280 + 64 * (j))
#define XB_XGEN(j)  (2304 + 64 * (j))
#define XB_TOP      3328
#define XB_TOPGEN   3392
#define XB_LSUB(j)  (3456 + 64 * (j))
#define XB_LGEN(j)  (4480 + 64 * (j))
#define XCD_BAR_WORDS 3456
#define XB_SPIN_CAP (1u << 22)
__device__ __forceinline__ unsigned xb_ld(unsigned* p)              { return __hip_atomic_load(p, __ATOMIC_RELAXED, __HIP_MEMORY_SCOPE_AGENT); }
__device__ __forceinline__ unsigned xb_add(unsigned* p, unsigned v) { return __hip_atomic_fetch_add(p, v, __ATOMIC_RELAXED, __HIP_MEMORY_SCOPE_AGENT); }
__device__ __forceinline__ unsigned xb_xcc_id() { return (unsigned)__builtin_amdgcn_s_getreg((3 << 11) | 20) & 0xFu; }
#define XB_SPIN(cond, bar) do { unsigned _sp = 0; while (cond) { __builtin_amdgcn_s_sleep(1); \
    if ((++_sp & 255u) == 0u) { if (xb_ld(&(bar)[XB_TMO])) break; if (_sp > XB_SPIN_CAP) { atomicAdd(&(bar)[XB_TMO], 1u); break; } } } } while (0)
struct XcdBarrier { unsigned* bar; unsigned x; volatile LAS unsigned* st; };
__device__ __forceinline__ XcdBarrier xcd_barrier_post(unsigned* bar, volatile LAS unsigned* st) {
    XcdBarrier b; b.bar = bar; b.x = xb_xcc_id(); b.st = st;
    if (threadIdx.x == 0) { st[3] = xb_add(&bar[XB_XCNT(b.x)], 1u); st[4] = b.x; }
    return b;
}
__device__ __forceinline__ void xcd_barrier_complete(unsigned* bar, unsigned x, unsigned& nloc, unsigned& nx, unsigned& even) {
    const unsigned G = gridDim.x * gridDim.y * gridDim.z;
    unsigned sum, cnt, mine, odd, sp = 0u;
    for (;;) {
        sum = 0u; cnt = 0u; mine = 0u; odd = 0u;
#pragma unroll
        for (unsigned j = 0; j < 16; ++j) { const unsigned c = xb_ld(&bar[XB_XCNT(j)]); sum += c; cnt += (c > 0u) ? 1u : 0u; mine = (j == x) ? c : mine; odd += (j < 8u ? c != 32u : c != 0u) ? 1u : 0u; }
        if (sum == G) break;
        __builtin_amdgcn_s_sleep(1);
        if ((++sp & 255u) == 0u) { if (xb_ld(&bar[XB_TMO])) break; if (sp > XB_SPIN_CAP) { atomicAdd(&bar[XB_TMO], 1u); break; } }
    }
    nloc = mine > 0u ? mine : 1u; nx = cnt > 0u ? cnt : 1u; even = (odd == 0u && sum == 256u) ? 1u : 0u;
}
__device__ __forceinline__ void xcd_barrier(const XcdBarrier& b, bool rel) {
    asm volatile("s_waitcnt vmcnt(0)" ::: "memory");
    __syncthreads();
    if (otid() == 0) {
        unsigned* bar = b.bar;
        __builtin_amdgcn_s_waitcnt(0);
        unsigned nloc = b.st[0], nx = b.st[1];
        if (nloc == 0u) { unsigned even; xcd_barrier_complete(bar, b.x, nloc, nx, even); b.st[0] = nloc; b.st[1] = nx; b.st[2] = even; }
        const unsigned old = xb_add(&bar[XB_XSUB(b.x)], 1u);
        const unsigned gen = old / nloc;
        if (old + 1u == (gen + 1u) * nloc) {
            if (rel) __builtin_amdgcn_fence(__ATOMIC_RELEASE, "agent");
            asm volatile("s_waitcnt vmcnt(0)" ::: "memory");
            const unsigned og = xb_add(&bar[XB_TOP], 1u);
            const unsigned tg = og / nx;
            if (og + 1u == (tg + 1u) * nx) xb_add(&bar[XB_TOPGEN], 1u);
            else XB_SPIN(xb_ld(&bar[XB_TOPGEN]) == tg, bar);
            __builtin_amdgcn_fence(__ATOMIC_ACQUIRE, "agent");
            xb_add(&bar[XB_XGEN(b.x)], 1u);
            asm volatile("s_waitcnt vmcnt(0)" ::: "memory");
        } else {
            XB_SPIN(xb_ld(&bar[XB_XGEN(b.x)]) == gen, bar);
            __builtin_amdgcn_fence(__ATOMIC_ACQUIRE, "agent");
            asm volatile("s_waitcnt vmcnt(0)" ::: "memory");
        }
    }
    __syncthreads();
}

__device__ __forceinline__ void xcd_local_barrier(unsigned* bar, unsigned x) {
    asm volatile("s_waitcnt vmcnt(0)" ::: "memory");
    __syncthreads();
    if (otid() == 0) {
        __builtin_amdgcn_s_waitcnt(0);
        const unsigned old = xb_add(&bar[XB_LSUB(x)], 1u);
        const unsigned gen = old / 32u;
        if (old + 1u == (gen + 1u) * 32u) xb_add(&bar[XB_LGEN(x)], 1u);
        else XB_SPIN(xb_ld(&bar[XB_LGEN(x)]) == gen, bar);
        __builtin_amdgcn_fence(__ATOMIC_ACQUIRE, "agent");
        asm volatile("s_waitcnt vmcnt(0)" ::: "memory");
    }
    __syncthreads();
}

struct Params { const float* in[28]; float* out; unsigned char* ws; };
struct Ctx {
    LAS unsigned char* lds;
    unsigned char* ws_;
    const float* const* in_;
    float* out_;
    int vx, vr, loc;
};
__device__ __forceinline__ int ovx(const Ctx& C) { int v = C.vx; asm volatile("" : "+s"(v)); return v; }
__device__ __forceinline__ int ovr(const Ctx& C) { int v = C.vr; asm volatile("" : "+s"(v)); return v; }
__device__ __forceinline__ int oloc(const Ctx& C) { int v = C.loc; asm volatile("" : "+s"(v)); return v; }
__device__ __forceinline__ int lrow(const Ctx& C, int j) { const int vx = ovx(C); return j < 4096 ? 4096 * vx + j : MLAT + 512 * vx + (j - 4096); }
__device__ __forceinline__ bf16* wsb(const Ctx& C, size_t off) { return (bf16*)(ows(C.ws_) + off); }
__device__ __forceinline__ bf16* wW(const Ctx& C, size_t eoff) { return (bf16*)(ows(C.ws_) + WS_W) + eoff; }
__device__ __forceinline__ const float* modv(const Ctx& C, int l, int r, int part) { return (const float*)(ows(C.ws_) + WS_MOD) + ((size_t)(l * 17 + r) * 6144 + part * 1024); }
__device__ __forceinline__ int row_r(int m) { return m < MLAT ? (m >> 11) : 16; }

constexpr int TG_ROWB = 144;
constexpr int TG_OPB = 128 * TG_ROWB;
__device__ __forceinline__ void tg_tile(f32x4 (&acc)[4][2], LAS unsigned char* lds, const bf16* pa0, const bf16* pa1, const bf16* pb0, const bf16* pb1, int nk) {
    const int tid = otid(), lane = tid & 63, wave = tid >> 6, wr = wave >> 2, wc = wave & 3, fr = lane & 15, fq = lane >> 4;
    const int so0 = (tid >> 3) * TG_ROWB + (tid & 7) * 16, so1 = so0 + 64 * TG_ROWB;
    u32x4 ra0 = *(const u32x4*)pa0, ra1 = *(const u32x4*)pa1, rb0 = *(const u32x4*)pb0, rb1 = *(const u32x4*)pb1;
    *(LAS u32x4*)(lds + so0) = ra0; *(LAS u32x4*)(lds + so1) = ra1; *(LAS u32x4*)(lds + TG_OPB + so0) = rb0; *(LAS u32x4*)(lds + TG_OPB + so1) = rb1;
    __syncthreads();
    for (int kt = 0; kt < nk; ++kt) {
        const bool more = kt + 1 < nk;
        if (more) { const int ko = (kt + 1) * 64; ra0 = *(const u32x4*)(pa0 + ko); ra1 = *(const u32x4*)(pa1 + ko); rb0 = *(const u32x4*)(pb0 + ko); rb1 = *(const u32x4*)(pb1 + ko); }
        LAS unsigned char* cur = lds + (kt & 1) * (2 * TG_OPB);
#pragma unroll
        for (int ks = 0; ks < 2; ++ks) {
            bf16x8 af[4], bfr[2];
#pragma unroll
            for (int m = 0; m < 4; ++m) af[m] = *(const LAS bf16x8*)(cur + (wr * 64 + m * 16 + fr) * TG_ROWB + ks * 64 + fq * 16);
#pragma unroll
            for (int n = 0; n < 2; ++n) bfr[n] = *(const LAS bf16x8*)(cur + TG_OPB + (wc * 32 + n * 16 + fr) * TG_ROWB + ks * 64 + fq * 16);
#pragma unroll
            for (int m = 0; m < 4; ++m)
#pragma unroll
                for (int n = 0; n < 2; ++n) acc[m][n] = __builtin_amdgcn_mfma_f32_16x16x32_bf16(bfr[n], af[m], acc[m][n], 0, 0, 0);
        }
        if (more) { LAS unsigned char* nxt = lds + ((kt + 1) & 1) * (2 * TG_OPB);
            *(LAS u32x4*)(nxt + so0) = ra0; *(LAS u32x4*)(nxt + so1) = ra1; *(LAS u32x4*)(nxt + TG_OPB + so0) = rb0; *(LAS u32x4*)(nxt + TG_OPB + so1) = rb1; }
        __syncthreads();
    }
}
__device__ __forceinline__ void tg_zero(f32x4 (&acc)[4][2]) {
#pragma unroll
    for (int m = 0; m < 4; ++m)
#pragma unroll
        for (int n = 0; n < 2; ++n) acc[m][n] = (f32x4){0.f, 0.f, 0.f, 0.f};
}

enum { EM_NONE = 0, EM_SIGMOID = 1, EM_COLS = 2 };
__device__ __forceinline__ f32x4 epi_apply(f32x4 v, int mode, int col, const float* bgk) {
    if (mode == EM_NONE) return v;
    if (mode == EM_SIGMOID) { for (int j = 0; j < 4; ++j) v[j] = sigmoidf_(v[j]); return v; }
    if (col < C_K) { for (int j = 0; j < 4; ++j) v[j] *= 0.17677669529663689f; }
    else if (col < C_R) {}
    else if (col < C_LAF) { for (int j = 0; j < 4; ++j) v[j] = siluf_(v[j]); }
    else if (col < C_POOL) { for (int j = 0; j < 4; ++j) v[j] = logsigmoidf_(v[j] + bgk[col - C_LAF + j]) * 0.0625f; }
    else if (col < C_SU) {}
    else { for (int j = 0; j < 4; ++j) v[j] = gelu_tanh_(v[j]); }
    return v;
}
__device__ __forceinline__ void tg_gemm_plain(const Ctx& C, const bf16* A, int lda, const int* rowmap, int mrows, const bf16* Bt, int ldb, int ncols, int K,
                                              bf16* O, int ldo, int mode, const float* bgk) {
    const int tid = otid(), lane = tid & 63, wave = owave(), wr = wave >> 2, wc = wave & 3, fr = lane & 15, fq = lane >> 4;
    const int ntn = ncols / 128, ntiles = (mrows / 128) * ntn;
    for (int t = oblk(); t < ntiles; t += ogrid()) {
        const int tm = t / ntn, tn = t % ntn;
        const int r0 = tm * 128 + (tid >> 3), r1 = r0 + 64;
        const size_t ar0 = rowmap ? (size_t)rowmap[r0] : (size_t)r0, ar1 = rowmap ? (size_t)rowmap[r1] : (size_t)r1;
        const bf16* pa0 = A + ar0 * lda + (tid & 7) * 8; const bf16* pa1 = A + ar1 * lda + (tid & 7) * 8;
        const bf16* pb0 = Bt + (size_t)(tn * 128 + (tid >> 3)) * ldb + (tid & 7) * 8; const bf16* pb1 = pb0 + (size_t)64 * ldb;
        f32x4 acc[4][2]; tg_zero(acc);
        tg_tile(acc, C.lds, pa0, pa1, pb0, pb1, K / 64);
#pragma unroll
        for (int m = 0; m < 4; ++m)
#pragma unroll
            for (int n = 0; n < 2; ++n) {
                const int row = tm * 128 + wr * 64 + m * 16 + fr, col = tn * 128 + wc * 32 + n * 16 + 4 * fq;
                const f32x4 v = epi_apply(acc[m][n], mode, col, bgk);
                u32x2 w; w.x = pk2(v[0], v[1]); w.y = pk2(v[2], v[3]);
                *(u32x2*)(O + (size_t)row * ldo + col) = w;
            }
    }
}


namespace pg8 {
constexpr int BM = 256, BK = 64, HALF = 128, HTB = HALF * BK * 2, STAGE_BYTES = 8 * HTB;
__device__ __forceinline__ int lds_byte(int r, int c) { return r * 128 + ((((c >> 3) ^ (r >> 1)) & 7) << 4) + (c & 7) * 2; }
__device__ __forceinline__ void stage_rc(int b, int& R, int& C) { R = b >> 7; C = ((((b >> 4) ^ (R >> 1)) & 7) << 3) + ((b & 15) >> 1); }
__device__ __forceinline__ int perm32(int rho) { const int n = rho >> 4, i = rho & 15; return 8 * (i >> 2) + 4 * n + (i & 3); }
struct Unit { int ap, bp, orow, ocol, akb; };
struct Gemm { const bf16* A; const bf16* Bt; int K; const int* rowmap; int lda; };
struct GridOrder {
    int nM, nN, nwg, G, c, vx, pb, rev;
    __device__ __forceinline__ void init(int nM_, int nN_, int G_, int c_) { nM = nM_; nN = nN_; nwg = nM * nN; G = G_; c = c_; vx = -1; pb = 0; rev = 0; }
    __device__ __forceinline__ void init_l(int nMl, int nN_, int vr_, int vx_, int rev_ = 0) { nM = nMl; nN = nN_; nwg = nM * nN; G = 32; c = vr_; vx = vx_; pb = 0; rev = rev_; }
    __device__ __forceinline__ void init_p(int nMl, int nN_, int vr_, int pb_, int rev_ = 0) { nM = nMl; nN = nN_; nwg = nM * nN; G = 32; c = vr_; vx = -2; pb = pb_; rev = rev_; }
    __device__ __forceinline__ bool mn(int i, int& pm, int& pn) const {
        const long L = (long)i * G + c; if (L >= nwg) return false;
        int wgid = (int)L; if (vx == -1) { const int q = nwg / 8, r = nwg % 8, xcd = wgid % 8, off = wgid / 8; wgid = (xcd < r ? xcd * (q + 1) : r * (q + 1) + (xcd - r) * q) + off; }
        const int nig = 8 * nN, gid = wgid / nig, fm = gid * 8, gsz = (nM - fm) < 8 ? (nM - fm) : 8;
        pm = fm + ((wgid % nig) % gsz); pn = (wgid % nig) / gsz;
        if (rev) pm = nM - 1 - pm;
        if (vx >= 0) pm = pm < 16 ? 16 * vx + pm : 128 + 2 * vx + (pm - 16); else if (vx == -2) pm += pb;
        return true;
    }
};
__device__ __forceinline__ unsigned cvt_pk_bf16(float lo, float hi) { unsigned r; asm volatile("v_cvt_pk_bf16_f32 %0, %1, %2" : "=v"(r) : "v"(lo), "v"(hi)); return r; }

typedef int i32x4 __attribute__((ext_vector_type(4)));
template <class Epi, class Sched, bool GATHER, bool F8 = false>
__device__ __forceinline__ void gemm_phase(LAS unsigned char* lds, const Gemm g, const Sched& S, const Epi& E) {
    const int tid = otid(), wid = __builtin_amdgcn_readfirstlane(tid >> 6), lane = tid & 63, wr = wid >> 2, wc = wid & 3, fr = lane & 15, fq = lane >> 4;
    const int K = g.K, nt = K / BK;
    int Rl[2]; unsigned Cb[2], voffB[2];
#pragma unroll
    for (int i = 0; i < 2; ++i) { int R, Cc; stage_rc(tid * 16 + i * 8192, R, Cc); const int Rb = (R & ~31) + perm32(R & 31); Rl[i] = R; Cb[i] = (unsigned)Cc * 2u; voffB[i] = (unsigned)(Rb * K + Cc) * 2u; }
    const size_t kstep = (size_t)(BK * 2), hstep = (size_t)HALF * K * 2, tstep = 2 * hstep;
    const unsigned ldsw = (unsigned)wid * 1024u;
    const int aoff0 = lds_byte(wr * 64 + fr, fq * 8), aoff1 = lds_byte(wr * 64 + fr, 32 + fq * 8), boff0 = lds_byte(wc * 32 + fr, fq * 8), boff1 = lds_byte(wc * 32 + fr, 32 + fq * 8);
#define PG8_SA(b, h) (((b) * 2 + (h)) * HTB)
#define PG8_SB(b, h) ((4 + (b) * 2 + (h)) * HTB)
#define PG8_STAGE(bufoff, gbase, voff) do { _Pragma("unroll") for (int _i = 0; _i < 2; ++_i) \
        __builtin_amdgcn_global_load_lds((const unsigned*)((const char*)(gbase) + (voff)[_i]), (LAS unsigned*)(lds + (bufoff) + ldsw + _i * 8192), 16, 0, 0); } while (0)
#define PG8_LDA(dst, b, h) do { _Pragma("unroll") for (int m = 0; m < 4; ++m) { dst[m][0] = *(const LAS bf16x8*)(lds + PG8_SA(b, h) + aoff0 + m * 2048); dst[m][1] = *(const LAS bf16x8*)(lds + PG8_SA(b, h) + aoff1 + m * 2048); } } while (0)
#define PG8_LDB(dst, b, h) do { _Pragma("unroll") for (int n = 0; n < 2; ++n) { dst[n][0] = *(const LAS bf16x8*)(lds + PG8_SB(b, h) + boff0 + n * 2048); dst[n][1] = *(const LAS bf16x8*)(lds + PG8_SB(b, h) + boff1 + n * 2048); } } while (0)
#define PG8_MMA(ai, bj, At, Bt) do { __builtin_amdgcn_s_setprio(1); _Pragma("unroll") for (int m = 0; m < 4; ++m) _Pragma("unroll") for (int n = 0; n < 2; ++n) { \
        if (F8) { const i32x4 b0_ = __builtin_bit_cast(i32x4, Bt[n][0]), b1_ = __builtin_bit_cast(i32x4, Bt[n][1]), a0_ = __builtin_bit_cast(i32x4, At[m][0]), a1_ = __builtin_bit_cast(i32x4, At[m][1]); \
            acc[ai][bj][m][n] = __builtin_amdgcn_mfma_scale_f32_16x16x128_f8f6f4(__builtin_shufflevector(b0_, b1_, 0, 1, 2, 3, 4, 5, 6, 7), __builtin_shufflevector(a0_, a1_, 0, 1, 2, 3, 4, 5, 6, 7), acc[ai][bj][m][n], 0, 0, 0, 0x7F7F7F7F, 0, 0x7F7F7F7F); } \
        else { _Pragma("unroll") for (int k = 0; k < 2; ++k) acc[ai][bj][m][n] = __builtin_amdgcn_mfma_f32_16x16x32_bf16(Bt[n][k], At[m][k], acc[ai][bj][m][n], 0, 0, 0); } } __builtin_amdgcn_s_setprio(0); } while (0)
#define PG8_WAIT_V(n) asm volatile("s_waitcnt vmcnt(" #n ")" ::: "memory")
#define PG8_WAIT_L(n) asm volatile("s_waitcnt lgkmcnt(" #n ")" ::: "memory")
#define PG8_WAIT_VF() do { (void)fresh; PG8_WAIT_V(8); } while (0)
#define PG8_BAR __builtin_amdgcn_s_barrier()
#define PG8_SCHED __builtin_amdgcn_sched_barrier(0)
#define PG8_AOFF(dst, u) do { _Pragma("unroll") for (int _h = 0; _h < 2; ++_h) _Pragma("unroll") for (int _i = 0; _i < 2; ++_i) { \
        const int _r = (u).ap * BM + _h * HALF + Rl[_i]; const unsigned _row = GATHER ? (unsigned)g.rowmap[_r] : (unsigned)_r; dst[_h][_i] = _row * (unsigned)(g.lda * 2) + Cb[_i] + (unsigned)(u).akb; } } while (0)
    Unit cur, nxt; int ui = 0;
    if (!S.next(0, cur)) return;
    f32x4 acc[2][2][4][2];
#pragma unroll
    for (int a = 0; a < 2; ++a)
#pragma unroll
        for (int b = 0; b < 2; ++b)
#pragma unroll
            for (int m = 0; m < 4; ++m)
#pragma unroll
                for (int n = 0; n < 2; ++n) acc[a][b][m][n] = (f32x4){0.f, 0.f, 0.f, 0.f};
    bf16x8 At[4][2], B0[2][2], B1[2][2];
    unsigned ao[2][2], nao[2][2]; bool fresh = false;
    PG8_AOFF(ao, cur);
    const char* Ab = (const char*)g.A;
    const char* cB = (const char*)g.Bt + (size_t)cur.bp * tstep;
    PG8_STAGE(PG8_SB(0, 0), cB, voffB); PG8_STAGE(PG8_SB(0, 1), cB + hstep, voffB); PG8_STAGE(PG8_SA(0, 0), Ab, ao[0]); PG8_STAGE(PG8_SA(0, 1), Ab, ao[1]);
    if (wr == 1) PG8_BAR;
    PG8_WAIT_V(2); PG8_BAR;
    PG8_STAGE(PG8_SB(1, 0), cB + kstep, voffB); PG8_STAGE(PG8_SA(1, 0), Ab + kstep, ao[0]); PG8_STAGE(PG8_SB(1, 1), cB + hstep + kstep, voffB);
    PG8_WAIT_V(6); PG8_BAR;
    for (;;) {
        const bool has_next = S.next(ui + 1, nxt);
        if (has_next) { PG8_AOFF(nao, nxt); }
        else {
#pragma unroll
            for (int _h = 0; _h < 2; ++_h)
#pragma unroll
                for (int _i = 0; _i < 2; ++_i) nao[_h][_i] = ao[_h][_i]; }
        const char* nB = has_next ? (const char*)g.Bt + (size_t)nxt.bp * tstep : cB;
#pragma unroll 1
        for (int t = 0; t < nt; t += 2) {
            const bool last = (t == nt - 2);
            const char* a1 = Ab + (size_t)(t + 1) * kstep;
            const char* a2 = last ? Ab : Ab + (size_t)(t + 2) * kstep; const char* b2 = last ? nB : cB + (size_t)(t + 2) * kstep;
            const char* a3 = a2 + kstep; const char* b3 = b2 + kstep;
            PG8_LDB(B0, 0, 0); PG8_LDB(B1, 0, 1); PG8_SCHED; PG8_LDA(At, 0, 0); PG8_STAGE(PG8_SA(1, 1), a1, ao[1]);
            if (last) {
#pragma unroll
                for (int _h = 0; _h < 2; ++_h)
#pragma unroll
                    for (int _i = 0; _i < 2; ++_i) ao[_h][_i] = nao[_h][_i]; }
            PG8_WAIT_VF(); PG8_WAIT_L(0); PG8_BAR; PG8_MMA(0, 0, At, B0); PG8_MMA(0, 1, At, B1); PG8_BAR; PG8_SCHED;
            PG8_LDA(At, 0, 1); PG8_STAGE(PG8_SB(0, 0), b2, voffB); PG8_STAGE(PG8_SB(0, 1), b2 + hstep, voffB); PG8_STAGE(PG8_SA(0, 0), a2, ao[0]);
            PG8_WAIT_VF(); PG8_WAIT_L(0); PG8_BAR; PG8_MMA(1, 0, At, B0); PG8_MMA(1, 1, At, B1); PG8_BAR; PG8_SCHED;
            fresh = false;
            PG8_LDB(B0, 1, 0); PG8_LDB(B1, 1, 1); PG8_SCHED; PG8_LDA(At, 1, 0); PG8_STAGE(PG8_SA(0, 1), a2, ao[1]);
            PG8_WAIT_V(8); PG8_WAIT_L(0); PG8_BAR; PG8_MMA(0, 0, At, B0); PG8_MMA(0, 1, At, B1); PG8_BAR; PG8_SCHED;
            PG8_LDA(At, 1, 1); PG8_STAGE(PG8_SB(1, 0), b3, voffB); PG8_STAGE(PG8_SB(1, 1), b3 + hstep, voffB); PG8_STAGE(PG8_SA(1, 0), a3, ao[0]);
            PG8_WAIT_V(8); PG8_WAIT_L(0); PG8_BAR; PG8_MMA(1, 0, At, B0); PG8_MMA(1, 1, At, B1); PG8_BAR; PG8_SCHED;
        }
        if (wr == 0) PG8_BAR;
        E(acc, cur, wr, wc, fr, fq);
        if (PROBE == 12) { asm volatile("" ::: "memory"); E(acc, cur, wr, wc, fr, fq); }
        if (!has_next) break;
#pragma unroll
        for (int a = 0; a < 2; ++a)
#pragma unroll
            for (int b = 0; b < 2; ++b)
#pragma unroll
                for (int m = 0; m < 4; ++m)
#pragma unroll
                    for (int n = 0; n < 2; ++n) acc[a][b][m][n] = (f32x4){0.f, 0.f, 0.f, 0.f};
        cur = nxt; cB = nB; ++ui; fresh = true;
        if (wr == 1) PG8_BAR;
    }
    PG8_WAIT_V(0);
    PG8_BAR;
#undef PG8_SA
#undef PG8_SB
#undef PG8_STAGE
#undef PG8_LDA
#undef PG8_LDB
#undef PG8_MMA
#undef PG8_WAIT_V
#undef PG8_WAIT_L
#undef PG8_WAIT_VF
#undef PG8_BAR
#undef PG8_SCHED
#undef PG8_AOFF
}
struct EpiAct {
    static constexpr int NVM = 16;
    bf16* O; int ldo; int mode; const float* bgk;
    __device__ __forceinline__ void operator()(const f32x4 (&acc)[2][2][4][2], const Unit& u, int wr, int wc, int fr, int fq) const {
#pragma unroll
        for (int ai = 0; ai < 2; ++ai)
#pragma unroll
            for (int m = 0; m < 4; ++m) { bf16* rowp = O + (size_t)(u.orow + ai * HALF + wr * 64 + m * 16 + fr) * ldo + u.ocol + wc * 32 + 8 * fq;
#pragma unroll
                for (int bj = 0; bj < 2; ++bj) { const int col = u.ocol + bj * HALF + wc * 32 + 8 * fq;
                    const f32x4 v0 = epi_apply(acc[ai][bj][m][0], mode, col, bgk), v1 = epi_apply(acc[ai][bj][m][1], mode, col + 4, bgk);
                    u32x4 w; w.x = cvt_pk_bf16(v0[0], v0[1]); w.y = cvt_pk_bf16(v0[2], v0[3]); w.z = cvt_pk_bf16(v1[0], v1[1]); w.w = cvt_pk_bf16(v1[2], v1[3]);
                    *(u32x4*)(rowp + bj * HALF) = w; } }
    }
};
__device__ __forceinline__ size_t p_index(size_t row, int i, int c) { return row * 4096 + (size_t)((c >> 6) * 256 + ((c >> 5) & 1) * 128 + i * 32 + (c & 31)); }
struct EpiP {
    static constexpr int NVM = 16;
    bf16* O;
    __device__ __forceinline__ void operator()(const f32x4 (&acc)[2][2][4][2], const Unit& u, int wr, int wc, int fr, int fq) const {
        const int i = u.ocol >> 10, c0 = (u.ocol & 1023) + wc * 32 + 8 * fq;
#pragma unroll
        for (int ai = 0; ai < 2; ++ai)
#pragma unroll
            for (int m = 0; m < 4; ++m) { const size_t row = (size_t)(u.orow + ai * HALF + wr * 64 + m * 16 + fr);
#pragma unroll
                for (int bj = 0; bj < 2; ++bj) { const f32x4 v0 = acc[ai][bj][m][0], v1 = acc[ai][bj][m][1];
                    u32x4 w; w.x = cvt_pk_bf16(v0[0], v0[1]); w.y = cvt_pk_bf16(v0[2], v0[3]); w.z = cvt_pk_bf16(v1[0], v1[1]); w.w = cvt_pk_bf16(v1[2], v1[3]);
                    *(u32x4*)(O + p_index(row, i, c0 + bj * HALF)) = w; } }
    }
};
struct EpiCols {
    static constexpr int NVM = 16;
    bf16* O;
    __device__ __forceinline__ void operator()(const f32x4 (&acc)[2][2][4][2], const Unit& u, int wr, int wc, int fr, int fq) const {
        const int tile = __builtin_amdgcn_readfirstlane(u.ocol >> 8);
        f32x4 bv[2][2];
        if (tile == 3) {
#pragma unroll
            for (int bj = 0; bj < 2; ++bj)
#pragma unroll
                for (int n = 0; n < 2; ++n) bv[bj][n] = *(const LAS f32x4*)((LAS unsigned char*)131072 + (bj * HALF + wc * 32 + 8 * fq + 4 * n) * 4);
        }
#pragma unroll
        for (int ai = 0; ai < 2; ++ai)
#pragma unroll
            for (int m = 0; m < 4; ++m) { bf16* rowp = O + (size_t)(u.orow + ai * HALF + wr * 64 + m * 16 + fr) * NINP + u.ocol + wc * 32 + 8 * fq;
#pragma unroll
                for (int bj = 0; bj < 2; ++bj) { f32x4 v0 = acc[ai][bj][m][0], v1 = acc[ai][bj][m][1];
                    if (tile == 0) { if (bj == 0) { v0 = v0 * 0.17677669529663689f; v1 = v1 * 0.17677669529663689f; } }
                    else if (tile == 2) {
#pragma unroll
                        for (int j = 0; j < 4; ++j) { v0[j] = siluf_(v0[j]); v1[j] = siluf_(v1[j]); } }
                    else if (tile == 3) {
#pragma unroll
                        for (int j = 0; j < 4; ++j) { v0[j] = logsigmoidf_(v0[j] + bv[bj][0][j]) * 0.0625f; v1[j] = logsigmoidf_(v1[j] + bv[bj][1][j]) * 0.0625f; } }
                    else if (tile >= 6) {
#pragma unroll
                        for (int j = 0; j < 4; ++j) { v0[j] = gelu_tanh_(v0[j]); v1[j] = gelu_tanh_(v1[j]); } }
                    u32x4 w; w.x = cvt_pk_bf16(v0[0], v0[1]); w.y = cvt_pk_bf16(v0[2], v0[3]); w.z = cvt_pk_bf16(v1[0], v1[1]); w.w = cvt_pk_bf16(v1[2], v1[3]);
                    *(u32x4*)(rowp + bj * HALF) = w; } }
    }
};
struct EpiGateMix {
    static constexpr int NVM = 8;
    const bf16* P; bf16* MMo; float gs;
    __device__ __forceinline__ void operator()(const f32x4 (&acc)[2][2][4][2], const Unit& u, int wr, int wc, int fr, int fq) const {
        const int col = (u.ocol >> 2) + wc * 16 + 4 * fq;
#pragma unroll
        for (int ai = 0; ai < 2; ++ai) {
            u32x2 pw[4][4];
#pragma unroll
            for (int m = 0; m < 4; ++m) { const size_t row = (size_t)(u.orow + ai * HALF + wr * 64 + m * 16 + fr);
#pragma unroll
                for (int i = 0; i < 4; ++i) pw[m][i] = *(const u32x2*)(P + p_index(row, i, col)); }
#pragma unroll
            for (int m = 0; m < 4; ++m) { const size_t row = (size_t)(u.orow + ai * HALF + wr * 64 + m * 16 + fr);
                f32x2 s01 = (f32x2){0.f, 0.f}, s23 = s01; const float kc = -1.4426950408889634f * gs;
#pragma unroll
                for (int i = 0; i < 4; ++i) { const f32x4 g = acc[ai][i >> 1][m][i & 1];
                    f32x2 d01 = (f32x2){__builtin_amdgcn_exp2f(g[0] * kc), __builtin_amdgcn_exp2f(g[1] * kc)}, d23 = (f32x2){__builtin_amdgcn_exp2f(g[2] * kc), __builtin_amdgcn_exp2f(g[3] * kc)};
                    d01 = d01 + 1.0f; d23 = d23 + 1.0f;
                    const f32x2 r01 = (f32x2){__builtin_amdgcn_rcpf(d01[0]), __builtin_amdgcn_rcpf(d01[1])}, r23 = (f32x2){__builtin_amdgcn_rcpf(d23[0]), __builtin_amdgcn_rcpf(d23[1])};
                    const f32x2 p01 = (f32x2){bflo(pw[m][i].x), bfhi(pw[m][i].x)}, p23 = (f32x2){bflo(pw[m][i].y), bfhi(pw[m][i].y)};
                    s01 = r01 * p01 + s01; s23 = r23 * p23 + s23; }
                f32x4 s; s[0] = s01[0]; s[1] = s01[1]; s[2] = s23[0]; s[3] = s23[1];
                u32x2 w; w.x = cvt_pk_bf16(s[0], s[1]); w.y = cvt_pk_bf16(s[2], s[3]);
                *(u32x2*)(MMo + row * D + col) = w; } }
    }
};
struct EpiSwiGLU {
    static constexpr int NVM = 8;
    bf16* O; int ldo; float gs; float o8;
    __device__ __forceinline__ void operator()(const f32x4 (&acc)[2][2][4][2], const Unit& u, int wr, int wc, int fr, int fq) const {
#pragma unroll
        for (int ai = 0; ai < 2; ++ai)
#pragma unroll
            for (int m = 0; m < 4; ++m) { bf16* rowp = O + (size_t)(u.orow + ai * HALF + wr * 64 + m * 16 + fr) * ldo + u.ocol + wc * 32 + 8 * fq;
                f32x4 v0, v1;
#pragma unroll
                for (int j = 0; j < 4; ++j) { v0[j] = siluf_(acc[ai][0][m][0][j] * gs) * (acc[ai][1][m][0][j] * gs); v1[j] = siluf_(acc[ai][0][m][1][j] * gs) * (acc[ai][1][m][1][j] * gs); }
                if (o8 > 0.f) { u32x2 w; w.x = pk4_fp8(v0[0] * o8, v0[1] * o8, v0[2] * o8, v0[3] * o8); w.y = pk4_fp8(v1[0] * o8, v1[1] * o8, v1[2] * o8, v1[3] * o8);
                    *(u32x2*)((unsigned char*)O + (size_t)(u.orow + ai * HALF + wr * 64 + m * 16 + fr) * ldo + u.ocol + wc * 32 + 8 * fq) = w; }
                else { u32x4 w; w.x = cvt_pk_bf16(v0[0], v0[1]); w.y = cvt_pk_bf16(v0[2], v0[3]); w.z = cvt_pk_bf16(v1[0], v1[1]); w.w = cvt_pk_bf16(v1[2], v1[3]);
                    *(u32x4*)rowp = w; } }
    }
};
struct EpiScale {
    static constexpr int NVM = 16;
    bf16* O; int ldo; float gs;
    __device__ __forceinline__ void operator()(const f32x4 (&acc)[2][2][4][2], const Unit& u, int wr, int wc, int fr, int fq) const {
#pragma unroll
        for (int ai = 0; ai < 2; ++ai)
#pragma unroll
            for (int m = 0; m < 4; ++m) { bf16* rowp = O + (size_t)(u.orow + ai * HALF + wr * 64 + m * 16 + fr) * ldo + u.ocol + wc * 32 + 8 * fq;
#pragma unroll
                for (int bj = 0; bj < 2; ++bj) { const f32x4 v0 = acc[ai][bj][m][0] * gs, v1 = acc[ai][bj][m][1] * gs;
                    u32x4 w; w.x = cvt_pk_bf16(v0[0], v0[1]); w.y = cvt_pk_bf16(v0[2], v0[3]); w.z = cvt_pk_bf16(v1[0], v1[1]); w.w = cvt_pk_bf16(v1[2], v1[3]);
                    *(u32x4*)(rowp + bj * HALF) = w; } }
    }
};
template <int KIND> struct Sched {
    GridOrder go; int bp0, p0; const int* pe;
    __device__ __forceinline__ bool next(int i, Unit& u) const {
        int pm, pn; if (!go.mn(i, pm, pn)) return false;
        u.akb = 0;
        if (KIND == 0) { u.ap = pm; u.bp = bp0 + pn; u.orow = pm * BM; u.ocol = pn * BM; }
        else if (KIND == 4) { const int i = pn & 3, cp = pn >> 2; u.ap = pm; u.bp = i * 4 + cp; u.orow = pm * BM; u.ocol = i * 1024 + cp * BM; u.akb = i * 512; }
        else if (KIND == 1) { u.ap = pm; u.bp = pn; u.orow = pn * 2048 + pm * BM; u.ocol = 512; }
        else if (KIND == 2) { const int e = pe ? pe[p0 + pm] : 0; u.ap = p0 + pm; u.bp = e * 44 + pn; u.orow = pm * BM; u.ocol = pn * HALF; }
        else { const int e = pe ? pe[p0 + pm] : 0; u.ap = pm; u.bp = e * bp0 + pn; u.orow = (p0 + pm) * BM; u.ocol = pn * BM; }
        return true;
    }
};
}

__device__ __forceinline__ int gate_row(int i, int cc) { return 256 * (cc >> 6) + 128 * (i >> 1) + 32 * ((cc >> 4) & 3) + 8 * ((cc >> 2) & 3) + 4 * (i & 1) + (cc & 3); }
__device__ __forceinline__ void xpose_item(const float* W, int ldw, int k0, int n0, bf16* WT, int ldk, int drow0, LAS float* scr, int lane, int gate_i = -1) {
    { float wv[32];
#pragma unroll
      for (int i = 0; i < 32; ++i) { const int kk = 2 * i + (lane >> 5); wv[i] = W[(size_t)(k0 + kk) * ldw + n0 + (lane & 31)]; }
#pragma unroll
      for (int i = 0; i < 32; ++i) { const int kk = 2 * i + (lane >> 5); scr[kk * 33 + (lane & 31)] = wv[i]; } }
    asm volatile("s_waitcnt lgkmcnt(0)" ::: "memory");
    const int c = lane & 7;
#pragma unroll
    for (int j = 0; j < 4; ++j) { const int n = (lane >> 3) + 8 * j; const LAS float* s = scr + (8 * c) * 33 + n;
        u32x4 o; o.x = pk2(s[0 * 33], s[1 * 33]); o.y = pk2(s[2 * 33], s[3 * 33]); o.z = pk2(s[4 * 33], s[5 * 33]); o.w = pk2(s[6 * 33], s[7 * 33]);
        const int drow = gate_i < 0 ? drow0 + n : drow0 + gate_row(gate_i, n0 + n);
        *(u32x4*)(WT + (size_t)drow * ldk + k0 + 8 * c) = o; }
    asm volatile("s_waitcnt lgkmcnt(0)" ::: "memory");
}
__device__ __forceinline__ void xpose_item_fp8(const float* W, int ldw, int k0, int n0, unsigned char* WT, int ldk, LAS float* scr, int lane, int gate_i, float scale, int drow0 = 0) {
    { float wv[32];
#pragma unroll
      for (int i = 0; i < 32; ++i) { const int kk = 2 * i + (lane >> 5); wv[i] = W[(size_t)(k0 + kk) * ldw + n0 + (lane & 31)]; }
#pragma unroll
      for (int i = 0; i < 32; ++i) { const int kk = 2 * i + (lane >> 5); scr[kk * 33 + (lane & 31)] = wv[i]; } }
    asm volatile("s_waitcnt lgkmcnt(0)" ::: "memory");
    const int c = lane & 7;
#pragma unroll
    for (int j = 0; j < 4; ++j) { const int n = (lane >> 3) + 8 * j; const LAS float* s = scr + (8 * c) * 33 + n;
        u32x2 o; o.x = pk4_fp8(s[0 * 33] * scale, s[1 * 33] * scale, s[2 * 33] * scale, s[3 * 33] * scale); o.y = pk4_fp8(s[4 * 33] * scale, s[5 * 33] * scale, s[6 * 33] * scale, s[7 * 33] * scale);
        const int drow = gate_i < 0 ? drow0 + n : gate_row(gate_i, n0 + n);
        *(u32x2*)(WT + (size_t)drow * ldk + k0 + 8 * c) = o; }
    asm volatile("s_waitcnt lgkmcnt(0)" ::: "memory");
}
__device__ __forceinline__ void xpose_dispatch(const Ctx& C, int it, LAS float* scr) {
    const float* const* in = oin(C.in_); const int lane = otid() & 63;
    if (it < 4 * 768) { const int l = it / 768, r = it % 768, part = r / 384, q = r % 384, kb = q / 24, nb = q % 24;
        const int n0 = (part ? 1056 : 0) + nb * 32, drow = (part ? 1280 : 0) + nb * 32;
        xpose_item(in[6] + (size_t)l * D * NIN, NIN, kb * 64, n0, wW(C, WE_WIN + (size_t)l * 6144 * 1024), 1024, drow, scr, lane); return; }
    it -= 4 * 768;
    if (it < 16 * 512) { const int li = it / 512, q = it % 512, kb = q / 32, nb = q % 32, l = li >> 2, i = li & 3;
        xpose_item_fp8(in[16] + (size_t)li * D * D, D, kb * 64, nb * 32, ows(C.ws_) + WS_G8 + (size_t)l * 4096 * 1024, 1024, scr, lane, i, G8_SCALE); return; }
    it -= 16 * 512;
    if (it < 16 * 128) { const int li = it / 128, q = it % 128, kb = q / 32, nb = q % 32;
        xpose_item(in[17] + (size_t)li * 256 * D, D, kb * 64, nb * 32, wW(C, WE_WBR + (size_t)li * 1024 * 256), 256, nb * 32, scr, lane); return; }
    it -= 16 * 128;
    if (it < 4 * 512) { const int l = it / 512, q = it % 512, kb = q / 32, nb = q % 32;
        xpose_item(in[18] + (size_t)l * D * D, D, kb * 64, nb * 32, wW(C, WE_WO + (size_t)l * D * D), 1024, nb * 32, scr, lane); return; }
    it -= 4 * 512;
    if (it < 4 * 1408) { const int jw = it / 1408, q = it % 1408, kb = q / 88, nb = q % 88, j = jw >> 1, which = jw & 1, n0 = nb * 32;
        xpose_item_fp8(in[which ? 22 : 21] + (size_t)j * D * DFF, DFF, kb * 64, n0, (unsigned char*)wW(C, WE_GUD + (size_t)j * 5632 * 1024), 1024, scr, lane, -1, G8_SCALE, (n0 >> 7) * 256 + which * 128 + (n0 & 127)); return; }
    it -= 4 * 1408;
    if (it < 2 * 1408) { const int j = it / 1408, q = it % 1408, kb = q / 32, nb = q % 32;
        if (DOWN8_DENSE) xpose_item_fp8(in[23] + (size_t)j * DFF * D, D, kb * 64, nb * 32, (unsigned char*)wW(C, WE_DD + (size_t)j * 1024 * 2816), 2816, scr, lane, -1, G8_SCALE, nb * 32);
        else xpose_item(in[23] + (size_t)j * DFF * D, D, kb * 64, nb * 32, wW(C, WE_DD + (size_t)j * 1024 * 2816), 2816, nb * 32, scr, lane); return; }
    it -= 2 * 1408;
    (void)it;
}
constexpr int XPE_GU = 16 * 1408, XPE_ALL = 24 * 1408;
constexpr bool DEFER_EXPERT_CONV = false;
__device__ __forceinline__ void xpose_expert(const Ctx& C, int jm, int idx, LAS float* scr, int lane) {
    const float* const* in = oin(C.in_);
    if (idx < XPE_GU) { const int ew = idx / 1408, q = idx % 1408, kb = q / 88, nb = q % 88, e = ew >> 1, which = ew & 1, n0 = nb * 32, je = jm * 8 + e;
        xpose_item_fp8(in[which ? 26 : 25] + (size_t)je * D * DFF, DFF, kb * 64, n0, (unsigned char*)wW(C, WE_GUE + (size_t)je * 5632 * 1024), 1024, scr, lane, -1, G8_SCALE, (n0 >> 7) * 256 + which * 128 + (n0 & 127)); }
    else { const int i2 = idx - XPE_GU, e = i2 / 1408, q = i2 % 1408, kb = q / 32, nb = q % 32, je = jm * 8 + e;
        if (DOWN8_MOE) xpose_item_fp8(in[27] + (size_t)je * DFF * D, D, kb * 64, nb * 32, (unsigned char*)wW(C, WE_DE + (size_t)je * 1024 * 2816), 2816, scr, lane, -1, G8_SCALE, nb * 32);
        else xpose_item(in[27] + (size_t)je * DFF * D, D, kb * 64, nb * 32, wW(C, WE_DE + (size_t)je * 1024 * 2816), 2816, nb * 32, scr, lane); }
}
__device__ __forceinline__ void expert_convert_share(const Ctx& C, int jm, int i0, int i1, int first_blk) {
    const int blk = oblk(); if (blk < first_blk) return;
    const int wave = owave(), lane = otid() & 63; LAS float* scr = (LAS float*)(C.lds + wave * 16384);
    const int nw = (ogrid() - first_blk) * NWAVE;
    for (int idx = i0 + (blk - first_blk) * NWAVE + wave; idx < i1; idx += nw) xpose_expert(C, jm, idx, scr, lane);
}
constexpr int XPOSE_ITEMS = 4 * 768 + 16 * 512 + 16 * 128 + 4 * 512 + 4 * 1408 + 2 * 1408;

__device__ __forceinline__ void p_prologue(const Ctx& C) {
    const float* const* in = oin(C.in_); const int tid = otid();
    { LAS float* scr = (LAS float*)(C.lds + owave() * 16384);
      const int gw = oblk() * NWAVE + owave(), NGW = ogrid() * NWAVE;
      for (int it = gw; it < XPOSE_ITEMS; it += NGW) xpose_dispatch(C, it, scr);
      if (!DEFER_EXPERT_CONV) for (int it = gw; it < 2 * XPE_ALL; it += NGW) xpose_expert(C, it / XPE_ALL, it % XPE_ALL, scr, otid() & 63); }
    { const size_t gt = (size_t)oblk() * NTHR + tid, NT = (size_t)ogrid() * NTHR;
      for (size_t o = gt; o < (size_t)4 * 512 * 1024; o += NT) {
          const int l = (int)(o >> 19), n = (int)((o >> 10) & 511), k = (int)(o & 1023);
          const float* wi = in[6] + ((size_t)l * D + k) * NIN; float s = 0.f;
          if (n < 256) { const int dir = n >> 7, nn = n & 127; const float* w2 = in[7] + ((size_t)(l * 2 + dir) * 16) * 128 + nn;
              for (int c = 0; c < 16; ++c) s += wi[768 + 16 * dir + c] * w2[c * 128]; }
          else { const int nn = n - 256, gi = nn >> 6, d = nn & 63; const float* pw = in[10] + ((size_t)(l * 4 + gi) * 64) * 64 + d;
              for (int c = 0; c < 64; ++c) s += wi[800 + 64 * gi + c] * pw[c * 64]; }
          wW(C, WE_WIN + (size_t)l * 6144 * 1024)[(size_t)(768 + n) * 1024 + k] = (bf16)f2bf(s);
      } }
    { const size_t gt = (size_t)oblk() * NTHR + tid, NT = (size_t)ogrid() * NTHR;
      { int* idt = (int*)(ows(C.ws_) + WS_ROUTE) + RT_IDT; for (size_t o = gt; o < (size_t)M; o += NT) idt[o] = (int)o; }
      { bf16* sw = wsb(C, WS_SGUW); const float* src = in[14]; for (size_t o = gt; o < (size_t)4 * 4 * 128 * 128; o += NT) sw[o] = (bf16)f2bf(src[o]); }
      { bf16* TF1 = wsb(C, WS_TF1); bf16* TF2 = wsb(C, WS_TF2); float* TW = (float*)(ows(C.ws_) + WS_TW); const float sc = 0.0027621358640099515f;
        for (size_t o = gt; o < (size_t)4 * 2 * 64 * 8; o += NT) { const int x = (int)(o & 7), lane = (int)((o >> 3) & 63), ks = (int)((o >> 9) & 1), ct = (int)(o >> 10), lr = lane & 15, lq = lane >> 4;
            const int po = ct >> 1, c = 16 * (ct & 1) + lr, a = 8 * lq + x; float sn, cs; sincospif((float)((c * a) & 31) * (1.0f / 16.0f), &sn, &cs);
            const float v = po == 0 ? (ks == 0 ? cs : sn) : (ks == 0 ? -sn : cs); TF1[o] = (bf16)f2bf(v); }
        for (size_t o = gt; o < (size_t)2 * 4 * 2 * 64 * 8; o += NT) { const int x = (int)(o & 7), lane = (int)((o >> 3) & 63), ks = (int)((o >> 9) & 1), dt = (int)((o >> 10) & 3), part = (int)(o >> 12), lr = lane & 15, lq = lane >> 4;
            const int d = 16 * dt + lr, bb = 32 * ks + (x < 4 ? 4 * lq + x : 16 + 4 * lq + (x - 4)); float sn, cs; sincospif((float)((d * bb) & 63) * (1.0f / 32.0f), &sn, &cs);
            TF2[o] = (bf16)f2bf((part == 0 ? cs : sn) * sc); }
        for (size_t o = gt; o < (size_t)4 * 2 * 4 * 64; o += NT) { const int lane = (int)(o & 63), r = (int)((o >> 6) & 3), ct = (int)((o >> 8) & 1), rt = (int)(o >> 9), lr = lane & 15, lq = lane >> 4;
            const int bb = 16 * rt + 4 * lq + r, c = 16 * ct + lr; float sn, cs; sincospif((float)(c * bb) * (1.0f / 1024.0f), &sn, &cs); TW[2 * o] = cs; TW[2 * o + 1] = sn; } }
      bf16* DLC = wsb(C, WS_DLC);
      for (size_t o = gt; o < (size_t)256 * 512; o += NT) { const int k = (int)(o >> 9), kk = (int)(o & 511), t = kk & 255; const int idx = (k * t) & 255; float sn, cs; sincospif((float)idx * (1.0f / 128.0f), &sn, &cs);
          DLC[o] = (bf16)f2bf((kk < 256 ? cs : sn) * 0.0078125f); }
      bf16* CS = wsb(C, WS_CS64);
      for (size_t o = gt; o < (size_t)128 * 64; o += NT) { const int pm = (int)(o >> 6), c = (int)(o & 63), m = pm & 63; const int idx = (m * c) & 63; float sn, cs; sincospif((float)idx * (1.0f / 32.0f), &sn, &cs);
          CS[o] = (bf16)f2bf(pm < 64 ? cs : -sn); } }
    __syncthreads();
    { LAS float* S = (LAS float*)C.lds;
      LAS float* RED = (LAS float*)(C.lds + 17 * 1024 * 4);
      for (int i = tid; i < 17 * 1024; i += NTHR) { const int r = i >> 10, k = i & 1023; const float v = r < 16 ? in[1][r * 1024 + k] : in[3][k]; S[i] = siluf_(v); }
      __syncthreads();
      for (int it = oblk(); it < 4 * 96; it += ogrid()) {
          const int l = it / 96, jb = it % 96, j = tid & 63, kg = tid >> 6;
          float acc[17];
#pragma unroll
          for (int r = 0; r < 17; ++r) acc[r] = 0.f;
          const float* wp = in[4] + ((size_t)l * D + kg * 128) * 6144 + jb * 64 + j;
          for (int kk = 0; kk < 128; ++kk) { const float w = wp[(size_t)kk * 6144];
#pragma unroll
              for (int r = 0; r < 17; ++r) acc[r] += S[r * 1024 + kg * 128 + kk] * w; }
#pragma unroll
          for (int r = 0; r < 17; ++r) RED[(kg * 17 + r) * 64 + j] = acc[r];
          __syncthreads();
          for (int o = tid; o < 17 * 64; o += NTHR) { const int r = o >> 6, jj = o & 63; float s = 0.f;
              for (int g = 0; g < 8; ++g) s += RED[(g * 17 + r) * 64 + jj];
              ((float*)(ows(C.ws_) + WS_MOD))[(size_t)(l * 17 + r) * 6144 + jb * 64 + jj] = s + in[5][(size_t)l * 6144 + jb * 64 + jj]; }
          __syncthreads();
      } }
}

struct RowV { f32x4 v[4]; };
__device__ __forceinline__ void row_ln(RowV& x, int  ) {
    float s = 0.f;
#pragma unroll
    for (int j = 0; j < 4; ++j) s += (x.v[j][0] + x.v[j][1]) + (x.v[j][2] + x.v[j][3]);
    const float mean = wave_sum(s) * (1.f / D); float q = 0.f;
#pragma unroll
    for (int j = 0; j < 4; ++j) { x.v[j] = x.v[j] - mean; q += (x.v[j][0] * x.v[j][0] + x.v[j][1] * x.v[j][1]) + (x.v[j][2] * x.v[j][2] + x.v[j][3] * x.v[j][3]); }
    const float rstd = __builtin_amdgcn_rsqf(wave_sum(q) * (1.f / D) + EPS);
#pragma unroll
    for (int j = 0; j < 4; ++j) x.v[j] = x.v[j] * rstd;
}
__device__ __forceinline__ void row_load_f32(RowV& x, const float* p, int lane) {
#pragma unroll
    for (int j = 0; j < 4; ++j) x.v[j] = *(const f32x4*)(p + 4 * lane + 256 * j);
}
__device__ __forceinline__ void row_load_bf16(RowV& x, const bf16* p, int lane) {
#pragma unroll
    for (int j = 0; j < 4; ++j) { const u32x2 w = *(const u32x2*)(p + 4 * lane + 256 * j); x.v[j] = (f32x4){bflo(w.x), bfhi(w.x), bflo(w.y), bfhi(w.y)}; }
}
__device__ __forceinline__ void row_store_f32(const RowV& x, float* p, int lane) {
#pragma unroll
    for (int j = 0; j < 4; ++j) *(f32x4*)(p + 4 * lane + 256 * j) = x.v[j];
}
__device__ __forceinline__ void row_store_fp8(const RowV& x, unsigned char* p, int lane) {
#pragma unroll
    for (int j = 0; j < 4; ++j) { int w = 0; w = __builtin_amdgcn_cvt_pk_fp8_f32(x.v[j][0], x.v[j][1], w, false); w = __builtin_amdgcn_cvt_pk_fp8_f32(x.v[j][2], x.v[j][3], w, true); *(int*)(p + 4 * lane + 256 * j) = w; }
}
__device__ __forceinline__ void row_store_bf16(const RowV& x, bf16* p, int lane) {
#pragma unroll
    for (int j = 0; j < 4; ++j) { u32x2 w; w.x = pk2(x.v[j][0], x.v[j][1]); w.y = pk2(x.v[j][2], x.v[j][3]); *(u32x2*)(p + 4 * lane + 256 * j) = w; }
}
__device__ __forceinline__ void row_mod(RowV& x, const float* shift, const float* scale, int lane) {
#pragma unroll
    for (int j = 0; j < 4; ++j) { const f32x4 sh = *(const f32x4*)(shift + 4 * lane + 256 * j), sc = *(const f32x4*)(scale + 4 * lane + 256 * j); x.v[j] = x.v[j] * (sc + 1.0f) + sh; }
}
__device__ __forceinline__ void row_affine(RowV& x, const float* g, const float* b, int lane) {
#pragma unroll
    for (int j = 0; j < 4; ++j) { const f32x4 gg = *(const f32x4*)(g + 4 * lane + 256 * j), bb = *(const f32x4*)(b + 4 * lane + 256 * j); x.v[j] = x.v[j] * gg + bb; }
}
__device__ __forceinline__ void row_mod_v(RowV& x, const RowV& shift, const RowV& scale) {
#pragma unroll
    for (int j = 0; j < 4; ++j) x.v[j] = x.v[j] * (scale.v[j] + 1.0f) + shift.v[j];
}
__device__ __forceinline__ void row_affine_v(RowV& x, const RowV& g, const RowV& b) {
#pragma unroll
    for (int j = 0; j < 4; ++j) x.v[j] = x.v[j] * g.v[j] + b.v[j];
}
__device__ __forceinline__ float* xrow(const Ctx& C, int m) { return m < MLAT ? oout(C.out_) + (size_t)m * D : (float*)(ows(C.ws_) + WS_XC) + (size_t)(m - MLAT) * D; }
__device__ __forceinline__ bf16* hbuf(const Ctx& C) { return XBF16 ? (bf16*)oout(C.out_) : wsb(C, WS_H); }
__device__ __forceinline__ unsigned char* h8buf(const Ctx& C) { return (unsigned char*)oout(C.out_) + OUT_H8; }
__device__ __forceinline__ const float* x0row(const Ctx& C, int m) { return m < MLAT ? oin(C.in_)[0] + (size_t)m * D : oin(C.in_)[2] + (size_t)(m - MLAT) * D; }

typedef _Float16 h16x2 __attribute__((ext_vector_type(2)));
struct XRaw { f32x4 f[4]; u32x2 h[4]; };
__device__ __forceinline__ void xraw_load(XRaw& R, const Ctx& C, int m, int lane, bool from_input) {
    if (from_input || !XBF16) { const float* p = from_input ? x0row(C, m) : xrow(C, m);
#pragma unroll
        for (int j = 0; j < 4; ++j) R.f[j] = *(const f32x4*)(p + 4 * lane + 256 * j); }
    else { const bf16* p = wsb(C, WS_H) + (size_t)m * D;
#pragma unroll
        for (int j = 0; j < 4; ++j) R.h[j] = *(const u32x2*)(p + 4 * lane + 256 * j); }
}
__device__ __forceinline__ void xraw_get(RowV& x, const XRaw& R, bool from_input) {
    if (from_input || !XBF16) {
#pragma unroll
        for (int j = 0; j < 4; ++j) x.v[j] = R.f[j]; }
    else {
#pragma unroll
        for (int j = 0; j < 4; ++j) { const unsigned wx = R.h[j].x, wy = R.h[j].y;
            const h16x2 a = __builtin_bit_cast(h16x2, wx), b = __builtin_bit_cast(h16x2, wy); x.v[j] = (f32x4){(float)a[0], (float)a[1], (float)b[0], (float)b[1]}; } }
}
__device__ __forceinline__ void yraw_load(u32x2 (&y)[4], const bf16* p, int lane) {
#pragma unroll
    for (int j = 0; j < 4; ++j) y[j] = *(const u32x2*)(p + 4 * lane + 256 * j);
}
__device__ __forceinline__ void yraw_get(RowV& y, const u32x2 (&w)[4]) {
#pragma unroll
    for (int j = 0; j < 4; ++j) y.v[j] = (f32x4){bflo(w[j].x), bfhi(w[j].x), bflo(w[j].y), bfhi(w[j].y)};
}
__device__ __forceinline__ void x_store(const RowV& x, const Ctx& C, int m, int lane) {
    if (XBF16) { bf16* p = wsb(C, WS_H) + (size_t)m * D;
#pragma unroll
        for (int j = 0; j < 4; ++j) { h16x2 a, b; a[0] = (_Float16)x.v[j][0]; a[1] = (_Float16)x.v[j][1]; b[0] = (_Float16)x.v[j][2]; b[1] = (_Float16)x.v[j][3];
            u32x2 w; w.x = __builtin_bit_cast(unsigned, a); w.y = __builtin_bit_cast(unsigned, b); *(u32x2*)(p + 4 * lane + 256 * j) = w; } }
    else row_store_f32(x, xrow(C, m), lane);
}
__device__ __forceinline__ void p_lna(const Ctx& C) {
    const int tid = otid(), lane = tid & 63, wave = owave();
    bf16* H = hbuf(C); const int rpb = M / 256; RowV shv, scv; int rcur = -1;
    const int nrow = rpb / NWAVE, jb = (nrow - 1) * 256 + ovr(C) * NWAVE + wave;
    RowV xn; row_load_f32(xn, x0row(C, lrow(C, jb)), lane);
    for (int k = 0; k < nrow; ++k) { const int m = lrow(C, jb - k * 256), r = row_r(m);
        if (r != rcur) { row_load_f32(shv, modv(C, 0, r, 0), lane); row_load_f32(scv, modv(C, 0, r, 1), lane); rcur = r; }
        RowV x = xn; if (k + 1 < nrow) row_load_f32(xn, x0row(C, lrow(C, jb - (k + 1) * 256)), lane);
        row_ln(x, lane); row_mod_v(x, shv, scv);
        row_store_bf16(x, H + (size_t)m * D, lane); row_store_fp8(x, h8buf(C) + (size_t)m * D, lane);
    }
}
__device__ __forceinline__ void p_lnb(const Ctx& C, int l, int mrows, bool dry = false) {
    const int tid = otid(), lane = tid & 63;
    bf16* H = dry ? wsb(C, WS_R + R_BIG + 152 * MiB) : hbuf(C); const bf16* Y = wsb(C, WS_R + R_YS);
    const bool moe = (l & 1); const int jm = l >> 1;
    const int rpb = mrows / 256;
    LAS float* WR = (LAS float*)C.lds;
    LAS int* LC = (LAS int*)(C.lds + 32768);
    int* rt = (int*)(ows(C.ws_) + WS_ROUTE);
    if (moe) {
        for (int i = tid; i < 8 * 1024; i += NTHR) { const int e = i >> 10, k = i & 1023; WR[i] = oin(C.in_)[24][((size_t)jm * D + k) * NE + e]; }
        if (tid < 8) LC[tid] = 0;
        __syncthreads();
    }
    RowV g2v, shv, scv, lgv, lbv; int rcur = -1;
    row_load_f32(lgv, oin(C.in_)[19] + (size_t)(l * 2 + 0) * D, lane); row_load_f32(lbv, oin(C.in_)[20] + (size_t)(l * 2 + 0) * D, lane);
    const int w0 = owave(), nrow = rpb / NWAVE, jb = ovr(C) * NWAVE + w0, mb = lrow(C, jb); const bool fin = (l == 0);
    XRaw xa; u32x2 ya[4];
    xraw_load(xa, C, mb, lane, fin); yraw_load(ya, Y + (size_t)mb * D, lane);
    XRaw xb = xa; u32x2 yb[4] = {ya[0], ya[1], ya[2], ya[3]};
    for (int k = 0; k < nrow; ++k) {
        const int m = lrow(C, jb + k * 256), mn = lrow(C, k + 1 < nrow ? jb + (k + 1) * 256 : jb), r = row_r(m);
        if (k + 1 < nrow) { xraw_load(xb, C, mn, lane, fin); yraw_load(yb, Y + (size_t)mn * D, lane); }
        if (r != rcur) { row_load_f32(g2v, modv(C, l, r, 2), lane); row_load_f32(shv, modv(C, l, r, 3), lane); row_load_f32(scv, modv(C, l, r, 4), lane); rcur = r; }
        RowV x, y; xraw_get(x, xa, fin); yraw_get(y, ya);
#pragma unroll
        for (int j = 0; j < 4; ++j) x.v[j] = x.v[j] * ALPHA + g2v.v[j] * y.v[j];
        row_ln(x, lane); row_affine_v(x, lgv, lbv);
        if (dry) row_store_f32(x, (float*)(ows(C.ws_) + WS_R + R_BIG) + (size_t)m * D, lane); else x_store(x, C, m, lane);
        row_ln(x, lane); row_mod_v(x, shv, scv);
        row_store_fp8(x, (dry ? (unsigned char*)H : h8buf(C)) + (size_t)m * D, lane);
        if (moe) {
            float lg[8];
#pragma unroll
            for (int e = 0; e < 8; ++e) { float s = 0.f;
#pragma unroll
                for (int j = 0; j < 4; ++j) { const f32x4 w = *(const LAS f32x4*)(WR + e * 1024 + 4 * lane + 256 * j); s += (x.v[j][0] * w[0] + x.v[j][1] * w[1]) + (x.v[j][2] * w[2] + x.v[j][3] * w[3]); }
                lg[e] = wave_sum(s); }
            if (lane == 0 && !dry) {
                int e1 = 0; float v1 = lg[0];
#pragma unroll
                for (int e = 1; e < 8; ++e) if (lg[e] > v1) { v1 = lg[e]; e1 = e; }
                int e2 = -1; float v2 = -3.0e38f;
#pragma unroll
                for (int e = 0; e < 8; ++e) if (e != e1 && lg[e] > v2) { v2 = lg[e]; e2 = e; }
                const float w1 = 1.0f / (1.0f + __expf(v2 - v1)), w2 = 1.0f - w1;
                const int r1 = __hip_atomic_fetch_add(&LC[e1], 1, __ATOMIC_RELAXED, __HIP_MEMORY_SCOPE_WORKGROUP), r2 = __hip_atomic_fetch_add(&LC[e2], 1, __ATOMIC_RELAXED, __HIP_MEMORY_SCOPE_WORKGROUP);
                rt[RT_TOKE + (size_t)m * 2] = e1; rt[RT_TOKE + (size_t)m * 2 + 1] = e2;
                rt[RT_TOKR + (size_t)m * 2] = r1; rt[RT_TOKR + (size_t)m * 2 + 1] = r2;
                ((float*)rt)[RT_TOKW + (size_t)m * 2] = w1; ((float*)rt)[RT_TOKW + (size_t)m * 2 + 1] = w2;
            }
        }
        asm volatile("" ::: "memory");
        xa = xb;
#pragma unroll
        for (int j = 0; j < 4; ++j) ya[j] = yb[j];
    }
    if (moe && !dry) {
        __syncthreads();
        if (tid < 8) { unsigned* cnt = (unsigned*)(ows(C.ws_) + WS_CTL) + CW_CNT + (jm * 8 + tid) * 64;
            const unsigned base = __hip_atomic_fetch_add(cnt, (unsigned)LC[tid], __ATOMIC_RELAXED, __HIP_MEMORY_SCOPE_AGENT);
            rt[RT_BLK + (ovx(C) * 32 + ovr(C)) * 8 + tid] = (int)base; }
    }
}
struct RouteInfo { int base[9]; int cnt[8]; int npanels; };
__device__ __forceinline__ void route_info(const Ctx& C, int jm, RouteInfo& R) {
    unsigned* cnt = (unsigned*)(ows(C.ws_) + WS_CTL) + CW_CNT; int b = 0;
#pragma unroll
    for (int e = 0; e < 8; ++e) { const int c = (int)__hip_atomic_load(cnt + (jm * 8 + e) * 64, __ATOMIC_RELAXED, __HIP_MEMORY_SCOPE_AGENT); R.cnt[e] = c; R.base[e] = b; b += ((c + 255) >> 8) << 8; }
    R.base[8] = b; R.npanels = b >> 8;
}
__device__ __forceinline__ void p_route_build(const Ctx& C, int l, int mrows) {
    const int tid = otid();
    const int jm = l >> 1; RouteInfo R; route_info(C, jm, R);
    int* rt = (int*)(ows(C.ws_) + WS_ROUTE); const int rpb = mrows / 256;
    const int gt = oblk() * NTHR + tid, NT = ogrid() * NTHR;
    for (int i = gt; i < mrows * 2; i += NT) { const int m = i >> 1, e = rt[RT_TOKE + i], blk = (m < MLAT ? (m >> 12) : ((m - MLAT) >> 9)) * 32 + ((m & 255) >> 3);
        int be = 0;
#pragma unroll
        for (int q = 0; q < 8; ++q) be = (q == e) ? R.base[q] : be;
        const int slot = be + rt[RT_BLK + blk * 8 + e] + rt[RT_TOKR + i];
        rt[RT_TOKS + i] = slot; rt[RT_S2T + slot] = m; }
    for (int s = gt; s < R.base[8]; s += NT) { int e = 0;
#pragma unroll
        for (int q = 1; q < 8; ++q) e = (s >= R.base[q]) ? q : e;
        int be = 0, ce = 0;
#pragma unroll
        for (int q = 0; q < 8; ++q) { be = (q == e) ? R.base[q] : be; ce = (q == e) ? R.cnt[q] : ce; }
        if (s >= be + ce) rt[RT_S2T + s] = 0;
        if ((s & 255) == 0) rt[RT_PE + (s >> 8)] = e; }
}
__device__ __forceinline__ void p_lnc(const Ctx& C, int l, int mrows, bool dry = false) {
    const int tid = otid(), lane = tid & 63, wave = owave();
    bf16* H = dry ? wsb(C, WS_R + 350 * MiB) : hbuf(C); const bf16* Y2 = wsb(C, WS_R + R_Y2);
    const bool moe = (l & 1); const int* rt = (const int*)(ows(C.ws_) + WS_ROUTE); const int rpb = mrows / 256;
    RowV g5v, shv, scv, lgv, lbv; int rcur = -1;
    row_load_f32(lgv, oin(C.in_)[19] + (size_t)(l * 2 + 1) * D, lane); row_load_f32(lbv, oin(C.in_)[20] + (size_t)(l * 2 + 1) * D, lane);
    const int nrow = rpb / NWAVE, jb = (nrow - 1) * 256 + ovr(C) * NWAVE + wave, mb = lrow(C, jb);
    int sa1 = 0, sa2 = 0, sb1 = 0, sb2 = 0, sc1 = 0, sc2 = 0; float wa1 = 0.f, wa2 = 0.f, wb1 = 0.f, wb2 = 0.f, wc1 = 0.f, wc2 = 0.f;
    if (moe) { sa1 = rt[RT_TOKS + (size_t)mb * 2]; sa2 = rt[RT_TOKS + (size_t)mb * 2 + 1]; wa1 = ((const float*)rt)[RT_TOKW + (size_t)mb * 2]; wa2 = ((const float*)rt)[RT_TOKW + (size_t)mb * 2 + 1];
        if (nrow > 1) { const size_t q = (size_t)lrow(C, jb - 256) * 2; sb1 = rt[RT_TOKS + q]; sb2 = rt[RT_TOKS + q + 1]; wb1 = ((const float*)rt)[RT_TOKW + q]; wb2 = ((const float*)rt)[RT_TOKW + q + 1]; } }
    XRaw xa; u32x2 ya[4], za[4];
    xraw_load(xa, C, mb, lane, false); yraw_load(ya, Y2 + (size_t)(moe ? sa1 : mb) * D, lane); if (moe) yraw_load(za, Y2 + (size_t)sa2 * D, lane); else { za[0] = ya[0]; za[1] = ya[1]; za[2] = ya[2]; za[3] = ya[3]; }
    XRaw xb = xa; u32x2 yb[4] = {ya[0], ya[1], ya[2], ya[3]}, zb[4] = {za[0], za[1], za[2], za[3]};
    for (int k = 0; k < nrow; ++k) {
        const int m = lrow(C, jb - k * 256), mn = lrow(C, k + 1 < nrow ? jb - (k + 1) * 256 : jb), r = row_r(m);
        if (moe && k + 2 < nrow) { const size_t q = (size_t)lrow(C, jb - (k + 2) * 256) * 2; sc1 = rt[RT_TOKS + q]; sc2 = rt[RT_TOKS + q + 1]; wc1 = ((const float*)rt)[RT_TOKW + q]; wc2 = ((const float*)rt)[RT_TOKW + q + 1]; }
        if (k + 1 < nrow) { xraw_load(xb, C, mn, lane, false); yraw_load(yb, Y2 + (size_t)(moe ? sb1 : mn) * D, lane); if (moe) yraw_load(zb, Y2 + (size_t)sb2 * D, lane); }
        if (r != rcur) { row_load_f32(g5v, modv(C, l, r, 5), lane); if (l < DEPTH - 1) { row_load_f32(shv, modv(C, l + 1, r, 0), lane); row_load_f32(scv, modv(C, l + 1, r, 1), lane); } rcur = r; }
        RowV x, y; xraw_get(x, xa, false); yraw_get(y, ya);
        if (moe) { RowV y2; yraw_get(y2, za);
#pragma unroll
            for (int j = 0; j < 4; ++j) y.v[j] = y.v[j] * wa1 + y2.v[j] * wa2; }
#pragma unroll
        for (int j = 0; j < 4; ++j) x.v[j] = x.v[j] * ALPHA + g5v.v[j] * y.v[j];
        row_ln(x, lane); row_affine_v(x, lgv, lbv);
        if (dry) row_store_f32(x, (float*)(ows(C.ws_) + WS_R) + (size_t)m * D, lane); else if (l == DEPTH - 1) row_store_f32(x, oout(C.out_) + (size_t)m * D, lane); else x_store(x, C, m, lane);
        if (l < DEPTH - 1) { row_ln(x, lane); row_mod_v(x, shv, scv); row_store_bf16(x, H + (size_t)m * D, lane); row_store_fp8(x, h8buf(C) + (size_t)m * D, lane); }
        asm volatile("" ::: "memory");
        xa = xb; sa1 = sb1; sa2 = sb2; wa1 = wb1; wa2 = wb2; sb1 = sc1; sb2 = sc2; wb1 = wc1; wb2 = wc2;
#pragma unroll
        for (int j = 0; j < 4; ++j) { ya[j] = yb[j]; za[j] = zb[j]; }
    }
}

__device__ __forceinline__ f32x4 mm4(float a, float b, f32x4 c) { return __builtin_amdgcn_mfma_f32_16x16x4f32(a, b, c, 0, 0, 0); }
__device__ __forceinline__ int gla_row0(int b, int sc) { return sc < 4 ? MLAT + b * TC + sc * 64 : b * T + (sc - 4) * 64; }
constexpr int GL_VT = 0, GL_LA = 9216, GL_SEG = 26112, GL_QT = 28160, GL_KT = 36608, GL_KWT = 45056, GL_DC = 54272, GL_QE = 54528, GL_KE = 64768, GL_SPT = 75008, GL_AT = 85248, GL_RS = 103680;
__device__ __forceinline__ void gla_load_common(const bf16* cols, int m0, int h, LAS unsigned char* lds, int tid, bool with_q) {
    const int row = tid >> 3, seg = tid & 7; const bf16* rp = cols + (size_t)(m0 + row) * NINP;
    { const u32x4 w = *(const u32x4*)(rp + C_V + h * 64 + seg * 8); LAS bf16* vt = (LAS bf16*)(lds + GL_VT) + (seg * 8) * 72 + row;
      vt[0 * 72] = (bf16)(w.x & 0xffff); vt[1 * 72] = (bf16)(w.x >> 16); vt[2 * 72] = (bf16)(w.y & 0xffff); vt[3 * 72] = (bf16)(w.y >> 16);
      vt[4 * 72] = (bf16)(w.z & 0xffff); vt[5 * 72] = (bf16)(w.z >> 16); vt[6 * 72] = (bf16)(w.w & 0xffff); vt[7 * 72] = (bf16)(w.w >> 16); }
    const int s4 = seg & 3, dir = seg >> 2;
    { const u32x4 a = *(const u32x4*)(rp + (dir ? C_LAB : C_LAF) + h * 32 + s4 * 8); LAS float* d = (LAS float*)(lds + GL_LA) + (dir * 64 + row) * 33 + s4 * 8;
      d[0] = bflo(a.x); d[1] = bfhi(a.x); d[2] = bflo(a.y); d[3] = bfhi(a.y); d[4] = bflo(a.z); d[5] = bfhi(a.z); d[6] = bflo(a.w); d[7] = bfhi(a.w); }
    if (dir == 0 || with_q) { const u32x4 a = *(const u32x4*)(rp + (dir ? C_Q : C_K) + h * 32 + s4 * 8); LAS float* d = (LAS float*)(lds + (dir ? GL_QT : GL_KT)) + row * 33 + s4 * 8;
      d[0] = bflo(a.x); d[1] = bfhi(a.x); d[2] = bflo(a.y); d[3] = bfhi(a.y); d[4] = bflo(a.z); d[5] = bfhi(a.z); d[6] = bflo(a.w); d[7] = bfhi(a.w); }
}
__device__ __forceinline__ void gla1_item(const Ctx& C, int g) {
    const int b = g / 144, rem = g % 144, sc = rem >> 2, h = rem & 3, m0 = gla_row0(b, sc);
    const bf16* cols = wsb(C, WS_R + R_COLS); LAS unsigned char* lds = C.lds;
    const int tid = otid(), lane = tid & 63, w = owave(), lr = lane & 15, lq = lane >> 4;
    gla_load_common(cols, m0, h, lds, tid, false);
    __syncthreads();
    const int dir = tid >> 8, d = (tid >> 3) & 31, sg = tid & 7;
    LAS float* LA = (LAS float*)(lds + GL_LA) + dir * 64 * 33; LAS float* SEG = (LAS float*)(lds + GL_SEG) + (dir * 32 + d) * 8;
    float v[8], pre[8]; float run = 0.f;
#pragma unroll
    for (int x = 0; x < 8; ++x) { v[x] = LA[(sg * 8 + x) * 33 + d]; run += v[x]; pre[x] = run; }
    SEG[sg] = run;
    __syncthreads();
    { float off = 0.f, tot = 0.f;
#pragma unroll
      for (int s2 = 0; s2 < 8; ++s2) { const float t2 = SEG[s2]; tot += t2; off += (s2 < sg) ? t2 : 0.f; }
      const LAS float* KT = (const LAS float*)(lds + GL_KT);
      float kw[8];
#pragma unroll
      for (int x = 0; x < 8; ++x) { const float wt = dir == 0 ? __expf(tot - (off + pre[x])) : __expf(off + pre[x] - v[x]); kw[x] = KT[(sg * 8 + x) * 33 + d] * wt; }
      u32x4 o; o.x = pk2(kw[0], kw[1]); o.y = pk2(kw[2], kw[3]); o.z = pk2(kw[4], kw[5]); o.w = pk2(kw[6], kw[7]);
      *(LAS u32x4*)(lds + GL_KWT + ((dir * 32 + d) * 72 + sg * 8) * 2) = o;
      if (sg == 0) ((LAS float*)(lds + GL_DC))[dir * 32 + d] = __expf(tot); }
    __syncthreads();
    { const int wd = w >> 2, et = w & 3;
      f32x4 a0 = (f32x4){0.f, 0.f, 0.f, 0.f}, a1 = a0;
#pragma unroll
      for (int ks = 0; ks < 2; ++ks) { const bf16x8 av = *(const LAS bf16x8*)(lds + GL_VT + ((et * 16 + lr) * 72 + ks * 32 + lq * 8) * 2);
          const bf16x8 b0 = *(const LAS bf16x8*)(lds + GL_KWT + ((wd * 32 + lr) * 72 + ks * 32 + lq * 8) * 2), b1 = *(const LAS bf16x8*)(lds + GL_KWT + ((wd * 32 + 16 + lr) * 72 + ks * 32 + lq * 8) * 2);
          a0 = __builtin_amdgcn_mfma_f32_16x16x32_bf16(av, b0, a0, 0, 0, 0); a1 = __builtin_amdgcn_mfma_f32_16x16x32_bf16(av, b1, a1, 0, 0, 0); }
      const int cp = wd ? (sc < 4 ? 3 - sc : 39 - sc) : sc, ch = (b * 4 + h) * 2 + wd;
      float* DH = (float*)(ows(C.ws_) + WS_R + R_DH) + ((size_t)ch * 36 + cp) * 2048;
#pragma unroll
      for (int r = 0; r < 4; ++r) { const int e = et * 16 + 4 * lq + r; DH[e * 32 + lr] = a0[r]; DH[e * 32 + 16 + lr] = a1[r]; }
      if (tid < 64) { const int dd = tid >> 5, d2 = tid & 31; const int cp2 = dd ? (sc < 4 ? 3 - sc : 39 - sc) : sc;
          ((float*)(ows(C.ws_) + WS_R + R_DEC))[((size_t)((b * 4 + h) * 2 + dd) * 36 + cp2) * 32 + d2] = ((const LAS float*)(lds + GL_DC))[dd * 32 + d2]; } }
    __syncthreads();
}
__device__ __forceinline__ void gla2_all(const Ctx& C) {
    const int tid = otid();
    float* DH = (float*)(ows(C.ws_) + WS_R + R_DH); const float* DEC = (const float*)(ows(C.ws_) + WS_R + R_DEC);
    for (int il = ovr(C) * NTHR + tid; il < 16 * 2048; il += 32 * NTHR) { const int i = ovx(C) * 16 * 2048 + il, ch = i >> 11, el = i & 2047, d = el & 31;
        float* p = DH + (size_t)ch * 36 * 2048 + el; const float* dc = DEC + (size_t)ch * 36 * 32 + d;
        float dh[36], de[36];
#pragma unroll
        for (int cp = 0; cp < 36; ++cp) { dh[cp] = p[(size_t)cp * 2048]; de[cp] = dc[cp * 32]; }
        float S = 0.f;
#pragma unroll
        for (int cp = 0; cp < 36; ++cp) { p[(size_t)cp * 2048] = S; S = de[cp] * S + dh[cp]; } }
}
__device__ __forceinline__ void gla3_item(const Ctx& C, int l, int g) {
    const int b = g / 144, rem = g % 144, sc = rem >> 2, h = rem & 3, m0 = gla_row0(b, sc);
    const bf16* cols = wsb(C, WS_R + R_COLS); bf16* YS = wsb(C, WS_R + R_YS); LAS unsigned char* lds = C.lds;
    const int tid = otid(), lane = tid & 63, w = owave(), lr = lane & 15, lq = lane >> 4;
    gla_load_common(cols, m0, h, lds, tid, true);
    { const int dir = tid >> 8, e = (tid >> 2) & 63, dq = tid & 3; const int cp = dir ? (sc < 4 ? 3 - sc : 39 - sc) : sc, ch = (b * 4 + h) * 2 + dir;
      const float* sp = (const float*)(ows(C.ws_) + WS_R + R_DH) + ((size_t)ch * 36 + cp) * 2048 + e * 32 + dq * 8;
      const f32x4 s0 = *(const f32x4*)sp, s1 = *(const f32x4*)(sp + 4);
      u32x4 o; o.x = pk2(s0[0], s0[1]); o.y = pk2(s0[2], s0[3]); o.z = pk2(s1[0], s1[1]); o.w = pk2(s1[2], s1[3]);
      *(LAS u32x4*)(lds + GL_SPT + ((dir * 64 + e) * 40 + dq * 8) * 2) = o; }
    __syncthreads();
    { const int dir = tid >> 8, d = (tid >> 3) & 31, sg = tid & 7;
      LAS float* LA = (LAS float*)(lds + GL_LA) + dir * 64 * 33; LAS float* SEG = (LAS float*)(lds + GL_SEG) + (dir * 32 + d) * 8;
      float v[8], pre[8]; float run = 0.f;
#pragma unroll
      for (int x = 0; x < 8; ++x) { v[x] = LA[(sg * 8 + x) * 33 + d]; run += v[x]; pre[x] = run; }
      SEG[sg] = run;
      __syncthreads();
      float off = 0.f, tot = 0.f;
#pragma unroll
      for (int s2 = 0; s2 < 8; ++s2) { const float t2 = SEG[s2]; tot += t2; off += (s2 < sg) ? t2 : 0.f; }
      const LAS float* QT = (const LAS float*)(lds + GL_QT); const LAS float* KT = (const LAS float*)(lds + GL_KT);
      LAS bf16* QE = (LAS bf16*)(lds + GL_QE) + dir * 64 * 40 + d; LAS bf16* KE = (LAS bf16*)(lds + GL_KE) + dir * 64 * 40 + d;
#pragma unroll
      for (int x = 0; x < 8; ++x) { const int i = sg * 8 + x;
          const float bb = dir == 0 ? (off + pre[x]) : (tot - (off + pre[x] - v[x]));
          QE[i * 40] = (bf16)f2bf(QT[i * 33 + d] * __expf(bb)); KE[i * 40] = (bf16)f2bf(KT[i * 33 + d] * __expf(-bb)); } }
    __syncthreads();
    { const int dir = w >> 2, jt = w & 3;
      const bf16x8 bq = *(const LAS bf16x8*)(lds + GL_QE + ((dir * 64 + jt * 16 + lr) * 40 + lq * 8) * 2);
#pragma unroll
      for (int it = 0; it < 4; ++it) { const bf16x8 ak = *(const LAS bf16x8*)(lds + GL_KE + ((dir * 64 + it * 16 + lr) * 40 + lq * 8) * 2);
          const f32x4 a = __builtin_amdgcn_mfma_f32_16x16x32_bf16(ak, bq, (f32x4){0.f, 0.f, 0.f, 0.f}, 0, 0, 0);
          const int j = jt * 16 + lr, i0 = it * 16 + 4 * lq; float m4[4];
#pragma unroll
          for (int r = 0; r < 4; ++r) { const int i = i0 + r; const bool keep = dir ? (i > j) : (i <= j); m4[r] = keep ? a[r] : 0.f; }
          u32x2 o; o.x = pk2(m4[0], m4[1]); o.y = pk2(m4[2], m4[3]);
          *(LAS u32x2*)(lds + GL_AT + ((dir * 64 + j) * 72 + i0) * 2) = o; } }
    __syncthreads();
    const int jt = w >> 1, et0 = 2 * (w & 1);
    f32x4 o0 = (f32x4){0.f, 0.f, 0.f, 0.f}, o1 = o0;
#pragma unroll
    for (int dir = 0; dir < 2; ++dir) {
#pragma unroll
        for (int ks = 0; ks < 2; ++ks) { const bf16x8 ba = *(const LAS bf16x8*)(lds + GL_AT + ((dir * 64 + jt * 16 + lr) * 72 + ks * 32 + lq * 8) * 2);
            o0 = __builtin_amdgcn_mfma_f32_16x16x32_bf16(*(const LAS bf16x8*)(lds + GL_VT + ((et0 * 16 + lr) * 72 + ks * 32 + lq * 8) * 2), ba, o0, 0, 0, 0);
            o1 = __builtin_amdgcn_mfma_f32_16x16x32_bf16(*(const LAS bf16x8*)(lds + GL_VT + (((et0 + 1) * 16 + lr) * 72 + ks * 32 + lq * 8) * 2), ba, o1, 0, 0, 0); }
        const bf16x8 bq = *(const LAS bf16x8*)(lds + GL_QE + ((dir * 64 + jt * 16 + lr) * 40 + lq * 8) * 2);
        o0 = __builtin_amdgcn_mfma_f32_16x16x32_bf16(*(const LAS bf16x8*)(lds + GL_SPT + ((dir * 64 + et0 * 16 + lr) * 40 + lq * 8) * 2), bq, o0, 0, 0, 0);
        o1 = __builtin_amdgcn_mfma_f32_16x16x32_bf16(*(const LAS bf16x8*)(lds + GL_SPT + ((dir * 64 + (et0 + 1) * 16 + lr) * 40 + lq * 8) * 2), bq, o1, 0, 0, 0);
    }
    { float ss = (o0[0] * o0[0] + o0[1] * o0[1]) + (o0[2] * o0[2] + o0[3] * o0[3]) + (o1[0] * o1[0] + o1[1] * o1[1]) + (o1[2] * o1[2] + o1[3] * o1[3]);
      ss += __shfl_xor(ss, 16); ss += __shfl_xor(ss, 32);
      if (lq == 0) ((LAS float*)(lds + GL_RS))[(jt * 16 + lr) * 2 + (w & 1)] = ss; }
    __syncthreads();
    { const int j = jt * 16 + lr; const LAS float* RS = (const LAS float*)(lds + GL_RS);
      const float rs = 1.0f / sqrtf((RS[j * 2] + RS[j * 2 + 1]) * (1.0f / 64.0f) + EPS);
      const size_t rowo = (size_t)(m0 + j);
#pragma unroll
      for (int q = 0; q < 2; ++q) { const int e = (et0 + q) * 16 + 4 * lq; const f32x4 o = q ? o1 : o0;
          const u32x2 rw = *(const u32x2*)(cols + rowo * NINP + C_R + h * 64 + e); const f32x4 gg = *(const f32x4*)(oin(C.in_)[9] + (size_t)l * 256 + h * 64 + e);
          u32x2 ow; ow.x = pk2(o[0] * rs * gg[0] * bflo(rw.x), o[1] * rs * gg[1] * bfhi(rw.x)); ow.y = pk2(o[2] * rs * gg[2] * bflo(rw.y), o[3] * rs * gg[3] * bfhi(rw.y));
          *(u32x2*)(YS + rowo * D + h * 64 + e) = ow; } }
    __syncthreads();
}

template <int GI> __device__ __forceinline__ void pool_lat_item_t(const Ctx& C, int l, int b, int slab) {
    constexpr int HW = 1 << GI; constexpr int RS = 64 * 16 + 16;
    const int ch0 = slab * 16;
    const bf16* cols = wsb(C, WS_R + R_COLS); bf16* YS = wsb(C, WS_R + R_YS);
    LAS float* G = (LAS float*)C.lds;
    const int tid = otid(), hf = tid & 1;
    u32x4 xin[8];
#pragma unroll
    for (int k = 0; k < 8; ++k) { const int t = (tid + k * NTHR) >> 1; xin[k] = *(const u32x4*)(cols + (size_t)(b * T + t) * NINP + C_POOL + ch0 + hf * 8); }
#pragma unroll
    for (int k = 0; k < 8; ++k) { const int t = (tid + k * NTHR) >> 1; LAS float* d = G + (t >> 6) * RS + (t & 63) * 16 + hf * 8; const u32x4 w = xin[k];
        *(LAS f32x4*)d = (f32x4){bflo(w.x), bfhi(w.x), bflo(w.y), bfhi(w.y)}; *(LAS f32x4*)(d + 4) = (f32x4){bflo(w.z), bfhi(w.z), bflo(w.w), bfhi(w.w)}; }
    __syncthreads();
#pragma unroll 1
    for (int q = 0; q < 2; ++q) { const int cix = tid + q * NTHR; float p[33]; p[0] = 0.f;
#pragma unroll
        for (int gr = 0; gr < 32; ++gr) p[gr + 1] = p[gr] + G[gr * RS + cix];
#pragma unroll
        for (int gr = 0; gr < 32; ++gr) { const int lo = gr - HW < 0 ? 0 : gr - HW, hi = gr + HW > 32 ? 32 : gr + HW;
            G[gr * RS + cix] = (p[hi] - p[lo]) * (1.0f / (float)(hi - lo)); } }
    __syncthreads();
    { const int gr = tid >> 4, ch = tid & 15; LAS float* Gr = G + gr * RS + ch; float p[65]; p[0] = 0.f;
#pragma unroll
      for (int gc = 0; gc < 64; ++gc) p[gc + 1] = p[gc] + Gr[gc * 16];
#pragma unroll
      for (int gc = 0; gc < 64; ++gc) { const int lo = gc - HW < 0 ? 0 : gc - HW, hi = gc + HW > 64 ? 64 : gc + HW;
          Gr[gc * 16] = (p[hi] - p[lo]) * (1.0f / (float)(hi - lo)); } }
    __syncthreads();
    { const float* ps = oin(C.in_)[11] + (size_t)l * 256 + ch0 + hf * 8; const f32x4 s0 = *(const f32x4*)ps, s1 = *(const f32x4*)(ps + 4);
#pragma unroll
      for (int k = 0; k < 8; ++k) { const int t = (tid + k * NTHR) >> 1; const LAS float* d = G + (t >> 6) * RS + (t & 63) * 16 + hf * 8; const f32x4 m0 = *(const LAS f32x4*)d, m1 = *(const LAS f32x4*)(d + 4); const u32x4 w = xin[k];
          u32x4 o; o.x = pk2((m0[0] - bflo(w.x)) * s0[0], (m0[1] - bfhi(w.x)) * s0[1]); o.y = pk2((m0[2] - bflo(w.y)) * s0[2], (m0[3] - bfhi(w.y)) * s0[3]);
          o.z = pk2((m1[0] - bflo(w.z)) * s1[0], (m1[1] - bfhi(w.z)) * s1[1]); o.w = pk2((m1[2] - bflo(w.w)) * s1[2], (m1[3] - bfhi(w.w)) * s1[3]);
          *(u32x4*)(YS + (size_t)(b * T + t) * D + 256 + ch0 + hf * 8) = o; } }
    __syncthreads();
}
__device__ __forceinline__ void pool_lat_item(const Ctx& C, int l, int p) {
    const int b = p >> 4, slab = p & 15, gi = slab >> 2;
    if (gi == 0) pool_lat_item_t<0>(C, l, b, slab); else if (gi == 1) pool_lat_item_t<1>(C, l, b, slab); else if (gi == 2) pool_lat_item_t<2>(C, l, b, slab); else pool_lat_item_t<3>(C, l, b, slab);
}
__device__ __forceinline__ void pool_ctx_item(const Ctx& C, int l, int p) {
    const int b = p >> 2, gi = p & 3, hw = 1 << gi;
    const bf16* cols = wsb(C, WS_R + R_COLS); bf16* YS = wsb(C, WS_R + R_YS);
    LAS float* G = (LAS float*)C.lds;
    const int tid = otid(), sg = tid & 7;
    u32x4 xin[4];
#pragma unroll
    for (int k = 0; k < 4; ++k) { const int t = (tid + k * NTHR) >> 3; xin[k] = *(const u32x4*)(cols + (size_t)(MLAT + b * TC + t) * NINP + C_POOL + gi * 64 + sg * 8); }
#pragma unroll
    for (int k = 0; k < 4; ++k) { const int t = (tid + k * NTHR) >> 3; LAS float* d = G + t * 64 + sg * 8; const u32x4 w = xin[k];
        *(LAS f32x4*)d = (f32x4){bflo(w.x), bfhi(w.x), bflo(w.y), bfhi(w.y)}; *(LAS f32x4*)(d + 4) = (f32x4){bflo(w.z), bfhi(w.z), bflo(w.w), bfhi(w.w)}; }
    __syncthreads();
    { const float* ps = oin(C.in_)[11] + (size_t)l * 256 + gi * 64 + sg * 8; const f32x4 s0 = *(const f32x4*)ps, s1 = *(const f32x4*)(ps + 4);
#pragma unroll
      for (int k = 0; k < 4; ++k) { const int t = (tid + k * NTHR) >> 3, lo = t - hw < 0 ? 0 : t - hw, hi = t + hw > 256 ? 256 : t + hw;
          f32x4 a0 = (f32x4){0.f, 0.f, 0.f, 0.f}, a1 = a0;
          for (int t2 = lo; t2 < hi; ++t2) { const LAS float* d = G + t2 * 64 + sg * 8; a0 += *(const LAS f32x4*)d; a1 += *(const LAS f32x4*)(d + 4); }
          const float inv = 1.0f / (float)(hi - lo); const u32x4 w = xin[k];
          u32x4 o; o.x = pk2((a0[0] * inv - bflo(w.x)) * s0[0], (a0[1] * inv - bfhi(w.x)) * s0[1]); o.y = pk2((a0[2] * inv - bflo(w.y)) * s0[2], (a0[3] * inv - bfhi(w.y)) * s0[3]);
          o.z = pk2((a1[0] * inv - bflo(w.z)) * s1[0], (a1[1] * inv - bfhi(w.z)) * s1[1]); o.w = pk2((a1[2] * inv - bflo(w.w)) * s1[2], (a1[3] * inv - bfhi(w.w)) * s1[3]);
          *(u32x4*)(YS + (size_t)(MLAT + b * TC + t) * D + 256 + gi * 64 + sg * 8) = o; } }
    __syncthreads();
}
__device__ __forceinline__ void sgu_item(const Ctx& C, int l, int s, bool loadw) {
    int m0, g;
    if (s < 1024) { const int b = s >> 6, n = (s >> 2) & 15; g = s & 3; m0 = b * T + n * 128; }
    else { const int s2 = s - 1024, b = s2 >> 3, n = (s2 >> 2) & 1; g = s2 & 3; m0 = MLAT + b * TC + n * 128; }
    const bf16* cols = wsb(C, WS_R + R_COLS); bf16* YS = wsb(C, WS_R + R_YS); LAS unsigned char* lds = C.lds;
    constexpr int SG_W = 0, SG_V = 34816;
    const int tid = otid(), lane = tid & 63, w = owave(), lr = lane & 15, lq = lane >> 4;
    if (loadw) { const bf16* wg = wsb(C, WS_SGUW) + (size_t)(l * 4 + g) * 128 * 128;
#pragma unroll
      for (int q = 0; q < 4; ++q) { const int i = tid + q * NTHR, r = i >> 4, c16 = i & 15; *(LAS u32x4*)(lds + SG_W + (r * 136 + c16 * 8) * 2) = *(const u32x4*)(wg + r * 128 + c16 * 8); } }
    const int srow = w * 16 + lr; const size_t rowo = (size_t)(m0 + srow); u32x2 uw[4];
#pragma unroll
    for (int ct = 0; ct < 4; ++ct) uw[ct] = *(const u32x2*)(cols + rowo * NINP + C_SU + g * 64 + ct * 16 + 4 * lq);
    const float bias = oin(C.in_)[15][(size_t)(l * 4 + g) * 128 + srow];
    { const int row = tid >> 2, q = tid & 3; const bf16* rp = cols + (size_t)(m0 + row) * NINP + C_SV + q * 64; float v[64]; float sm4[4] = {0.f, 0.f, 0.f, 0.f};
#pragma unroll
      for (int i = 0; i < 8; ++i) { const u32x4 x = *(const u32x4*)(rp + i * 8); v[8 * i] = bflo(x.x); v[8 * i + 1] = bfhi(x.x); v[8 * i + 2] = bflo(x.y); v[8 * i + 3] = bfhi(x.y); v[8 * i + 4] = bflo(x.z); v[8 * i + 5] = bfhi(x.z); v[8 * i + 6] = bflo(x.w); v[8 * i + 7] = bfhi(x.w); }
#pragma unroll
      for (int i = 0; i < 64; ++i) sm4[i & 3] += v[i];
      float sm = (sm4[0] + sm4[1]) + (sm4[2] + sm4[3]);
      sm += __shfl_xor(sm, 1); sm += __shfl_xor(sm, 2); const float mean = sm * (1.0f / 256.0f); float sq4[4] = {0.f, 0.f, 0.f, 0.f};
#pragma unroll
      for (int i = 0; i < 64; ++i) { v[i] -= mean; sq4[i & 3] += v[i] * v[i]; }
      float sq = (sq4[0] + sq4[1]) + (sq4[2] + sq4[3]);
      sq += __shfl_xor(sq, 1); sq += __shfl_xor(sq, 2); const float rstd = __builtin_amdgcn_rsqf(sq * (1.0f / 256.0f) + EPS);
      if (q == g) { const float* lg = oin(C.in_)[12] + (size_t)l * 256 + g * 64; const float* lb = oin(C.in_)[13] + (size_t)l * 256 + g * 64; LAS bf16* vt = (LAS bf16*)(lds + SG_V) + row;
#pragma unroll
          for (int i = 0; i < 64; ++i) vt[i * 136] = (bf16)f2bf(v[i] * rstd * lg[i] + lb[i]); } }
    __syncthreads();
    f32x4 a[4];
#pragma unroll
    for (int ct = 0; ct < 4; ++ct) a[ct] = (f32x4){0.f, 0.f, 0.f, 0.f};
#pragma unroll
    for (int ks = 0; ks < 4; ++ks) { const bf16x8 bw = *(const LAS bf16x8*)(lds + SG_W + ((w * 16 + lr) * 136 + ks * 32 + lq * 8) * 2);
#pragma unroll
        for (int ct = 0; ct < 4; ++ct) a[ct] = __builtin_amdgcn_mfma_f32_16x16x32_bf16(*(const LAS bf16x8*)(lds + SG_V + ((ct * 16 + lr) * 136 + ks * 32 + lq * 8) * 2), bw, a[ct], 0, 0, 0); }
#pragma unroll
    for (int ct = 0; ct < 4; ++ct) { const int c = ct * 16 + 4 * lq;
        u32x2 o; o.x = pk2(bflo(uw[ct].x) * (a[ct][0] + bias), bfhi(uw[ct].x) * (a[ct][1] + bias)); o.y = pk2(bflo(uw[ct].y) * (a[ct][2] + bias), bfhi(uw[ct].y) * (a[ct][3] + bias));
        *(u32x2*)(YS + rowo * D + 768 + g * 64 + c) = o; }
    __syncthreads();
}
__device__ __forceinline__ void cdft_tile(const Ctx& C, int c) {
    const bf16* cols = wsb(C, WS_R + R_COLS); const bf16* CS = wsb(C, WS_CS64);
    const int tid = otid(), lane = tid & 63, wave = owave(), wr = wave >> 2, wc = wave & 3, fr = lane & 15, fq = lane >> 4;
    const bf16* pa0 = CS + (size_t)(tid >> 3) * 64 + (tid & 7) * 8; const bf16* pa1 = pa0 + 64 * 64;
    if (c < 1024) {
        const int b = c >> 6, g = (c >> 4) & 3, bq = c & 15; bf16* ZT = wsb(C, WS_R + R_ZT) + (size_t)b * 256 * 4096;
        const int n0 = tid >> 3, n1 = n0 + 64;
        const int t0 = 64 * (n0 & 31) + 4 * bq + (n0 >> 5), t1 = 64 * (n1 & 31) + 4 * bq + (n1 >> 5);
        const bf16* pb0 = cols + (size_t)(b * T + t0) * NINP + C_FFT + g * 64 + (tid & 7) * 8; const bf16* pb1 = cols + (size_t)(b * T + t1) * NINP + C_FFT + g * 64 + (tid & 7) * 8;
        f32x4 acc[4][2]; tg_zero(acc); tg_tile(acc, C.lds, pa0, pa1, pb0, pb1, 1);
#pragma unroll
        for (int m = 0; m < 4; ++m)
#pragma unroll
            for (int n = 0; n < 2; ++n) { const int row = wr * 64 + m * 16 + fr, col = wc * 32 + n * 16 + 4 * fq;
                const int p = row >> 6, mm = row & 63, j = col >> 5, a = col & 31; u32x2 w; w.x = pk2(acc[m][n][0], acc[m][n][1]); w.y = pk2(acc[m][n][2], acc[m][n][3]);
                *(u32x2*)(ZT + ((size_t)((g * 64 + mm) * 2 + p) * 64 + 4 * bq + j) * 32 + a) = w; }
    } else {
        const int c2 = c - 1024, b = c2 >> 3, g = (c2 >> 1) & 3, tt = c2 & 1, m0 = MLAT + b * TC + tt * 128; bf16* ZT = wsb(C, WS_R + R_ZTC) + (size_t)b * 256 * 512;
        const bf16* pb0 = cols + (size_t)(m0 + (tid >> 3)) * NINP + C_FFT + g * 64 + (tid & 7) * 8; const bf16* pb1 = pb0 + (size_t)64 * NINP;
        f32x4 acc[4][2]; tg_zero(acc); tg_tile(acc, C.lds, pa0, pa1, pb0, pb1, 1);
#pragma unroll
        for (int m = 0; m < 4; ++m)
#pragma unroll
            for (int n = 0; n < 2; ++n) { const int row = wr * 64 + m * 16 + fr, col = wc * 32 + n * 16 + 4 * fq;
                const int p = row >> 6, mm = row & 63; u32x2 w; w.x = pk2(acc[m][n][0], acc[m][n][1]); w.y = pk2(acc[m][n][2], acc[m][n][3]);
                *(u32x2*)(ZT + (size_t)(g * 64 + mm) * (2 * TC) + p * TC + tt * 128 + col) = w; }
    }
}
constexpr int FF_X = 0, FF_T1 = 81920, FF_T2 = 90112, FF_TW = 106496, FF_OUT = 0;
__device__ __forceinline__ void fft_load_tables(const Ctx& C) {
    const int tid = otid(); const u32x4* src = (const u32x4*)(ows(C.ws_) + WS_TF1);
#pragma unroll
    for (int q = 0; q < 5; ++q) { const int i = tid + q * NTHR; *(LAS u32x4*)(C.lds + FF_T1 + i * 16) = src[i]; }
    __syncthreads();
}
__device__ __forceinline__ void fft_item(const Ctx& C, int item) {
    const int b = item >> 5, ch0 = (item & 31) * 8; LAS unsigned char* lds = C.lds;
    const int tid = otid(), lane = tid & 63, w = owave(), lr = lane & 15, lq = lane >> 4;
    LAS unsigned char* fx = lds + FF_X + w * 10240;
    { const u32x4* src = (const u32x4*)(wsb(C, WS_R + R_ZT) + ((size_t)(b * 256 + ch0 + w)) * 4096);
#pragma unroll
      for (int i = 0; i < 8; ++i) { const int q = lane + 64 * i; *(LAS u32x4*)(fx + (q >> 2) * 80 + (q & 3) * 16) = src[q]; } }
    f32x4 acc1[4][4];
#pragma unroll
    for (int rt = 0; rt < 4; ++rt)
#pragma unroll
        for (int ct = 0; ct < 4; ++ct) acc1[rt][ct] = (f32x4){0.f, 0.f, 0.f, 0.f};
#pragma unroll
    for (int ks = 0; ks < 2; ++ks) { bf16x8 af[4];
#pragma unroll
        for (int rt = 0; rt < 4; ++rt) af[rt] = *(const LAS bf16x8*)(fx + (ks * 64 + 16 * rt + lr) * 80 + lq * 16);
#pragma unroll
        for (int ct = 0; ct < 4; ++ct) { const bf16x8 bfr = *(const LAS bf16x8*)(lds + FF_T1 + ((ct * 2 + ks) * 64 + lane) * 16);
#pragma unroll
            for (int rt = 0; rt < 4; ++rt) acc1[rt][ct] = __builtin_amdgcn_mfma_f32_16x16x32_bf16(af[rt], bfr, acc1[rt][ct], 0, 0, 0); } }
    bf16x8 VR[2][2], VI[2][2];
#pragma unroll
    for (int ct = 0; ct < 2; ++ct)
#pragma unroll
        for (int ks = 0; ks < 2; ++ks) { float vr[8], vi[8];
#pragma unroll
            for (int hf = 0; hf < 2; ++hf) { const int rt = 2 * ks + hf;
#pragma unroll
                for (int r = 0; r < 4; ++r) { const f32x2 tw = *(const LAS f32x2*)(lds + FF_TW + (((rt * 2 + ct) * 4 + r) * 64 + lane) * 8);
                    const float ur = acc1[rt][ct][r], ui = acc1[rt][ct + 2][r]; vr[hf * 4 + r] = ur * tw.x + ui * tw.y; vi[hf * 4 + r] = ui * tw.x - ur * tw.y; } }
            u32x4 pr, pi; pr.x = pk2(vr[0], vr[1]); pr.y = pk2(vr[2], vr[3]); pr.z = pk2(vr[4], vr[5]); pr.w = pk2(vr[6], vr[7]);
            pi.x = pk2(vi[0], vi[1]); pi.y = pk2(vi[2], vi[3]); pi.z = pk2(vi[4], vi[5]); pi.w = pk2(vi[6], vi[7]);
            VR[ct][ks] = __builtin_bit_cast(bf16x8, pr); VI[ct][ks] = __builtin_bit_cast(bf16x8, pi); }
    __syncthreads();
#pragma unroll
    for (int dt = 0; dt < 4; ++dt) { bf16x8 fc[2], fs[2];
#pragma unroll
        for (int ks = 0; ks < 2; ++ks) { fc[ks] = *(const LAS bf16x8*)(lds + FF_T2 + (((0 * 4 + dt) * 2 + ks) * 64 + lane) * 16); fs[ks] = *(const LAS bf16x8*)(lds + FF_T2 + (((1 * 4 + dt) * 2 + ks) * 64 + lane) * 16); }
#pragma unroll
        for (int ct = 0; ct < 2; ++ct) { f32x4 o = (f32x4){0.f, 0.f, 0.f, 0.f};
#pragma unroll
            for (int ks = 0; ks < 2; ++ks) { o = __builtin_amdgcn_mfma_f32_16x16x32_bf16(fc[ks], VR[ct][ks], o, 0, 0, 0); o = __builtin_amdgcn_mfma_f32_16x16x32_bf16(fs[ks], VI[ct][ks], o, 0, 0, 0); }
#pragma unroll
            for (int r = 0; r < 4; ++r) { const int d = 16 * dt + 4 * lq + r, c = 16 * ct + lr, k = c + 32 * d; *(LAS bf16*)(lds + FF_OUT + (k * 8 + w) * 2) = (bf16)f2bf(o[r]); } } }
    __syncthreads();
    { bf16* YS = wsb(C, WS_R + R_YS);
#pragma unroll
      for (int i = 0; i < 4; ++i) { const int k = tid + NTHR * i; *(u32x4*)(YS + (size_t)(b * T + k) * D + 512 + ch0) = *(const LAS u32x4*)(lds + FF_OUT + k * 16); } }
    __syncthreads();
}

constexpr bool LOCAL_BARS = true;
__global__ void __launch_bounds__(NTHR, 2) fwd_kernel(Params prm) {
    extern __shared__ __attribute__((aligned(16))) unsigned char lds_raw[];
    Ctx C; C.lds = (LAS unsigned char*)lds_raw; C.ws_ = prm.ws; C.in_ = prm.in; C.out_ = prm.out; C.vx = 0; C.vr = 0; C.loc = 0;

    volatile LAS unsigned* MISC = (volatile LAS unsigned*)(C.lds + LDS_MISC);
    if (threadIdx.x < 16) MISC[threadIdx.x] = 0u;
    __syncthreads();
    (void)xcd_barrier_post((unsigned*)(ows(C.ws_) + WS_CTL) + CW_BAR, MISC + 8);
#define BAR_(rel) do { XcdBarrier b_; b_.bar = (unsigned*)(ows(C.ws_) + WS_CTL) + CW_BAR; b_.x = (unsigned)__builtin_amdgcn_readfirstlane((int)xb_xcc_id()); b_.st = MISC + 8; xcd_barrier(b_, rel); } while (0)
#define GRID_BAR() BAR_(true)
#define BAR_X() BAR_(oloc(C) == 0)
#define BAR_L() do { if (LOCAL_BARS && oloc(C)) xcd_local_barrier((unsigned*)(ows(C.ws_) + WS_CTL) + CW_BAR, (unsigned)__builtin_amdgcn_readfirstlane((int)xb_xcc_id())); else BAR_(oloc(C) == 0); } while (0)

    p_prologue(C); GRID_BAR();
    { const int ok = (int)MISC[8 + 2];
      C.loc = __builtin_amdgcn_readfirstlane(ok); C.vx = __builtin_amdgcn_readfirstlane(ok ? (int)MISC[8 + 4] : (oblk() >> 5)); C.vr = __builtin_amdgcn_readfirstlane(ok ? (int)MISC[8 + 3] : (oblk() & 31)); }
    p_lna(C); BAR_L();

#pragma unroll 1
    for (int l = 0; l < DEPTH; ++l) {
        const bool last = (l == DEPTH - 1); const int mrows = last ? MLAT : M;
        const int nMl = last ? 16 : 18;
        const bf16* H = hbuf(C);
        { pg8::Gemm g{H, wW(C, WE_WIN + (size_t)l * 6144 * 1024), D, nullptr, D}; pg8::Sched<0> S; S.go.init_l(18, NINP / 256, ovr(C), ovx(C)); S.bp0 = 0; S.p0 = 0; S.pe = nullptr;
          { const int tid = otid(); if (tid < 64) *(LAS f32x4*)(C.lds + 131072 + tid * 16) = *(const f32x4*)(oin(C.in_)[8] + (size_t)l * 256 + tid * 4); __syncthreads(); }
          pg8::EpiCols E{wsb(C, WS_R + R_COLS)};
          pg8::gemm_phase<pg8::EpiCols, pg8::Sched<0>, false>(C.lds, g, S, E); }
        BAR_L();
        { const int nG = 288, nPL = 32, nPC = last ? 0 : 8, nSl = 128, nSc = last ? 0 : 16, nDl = 128, nDc = last ? 0 : 16;
          const int tot = nG + nPL + nPC + nSl + nSc + nDl + nDc, vx = ovx(C);
          for (int it = ovr(C); it < tot; it += 32) { int i = it;
              if (i < nG) { gla1_item(C, 288 * vx + i); continue; } i -= nG;
              if (i < nPL) { pool_lat_item(C, l, 32 * vx + i); continue; } i -= nPL;
              if (i < nPC) { pool_ctx_item(C, l, 8 * vx + i); continue; } i -= nPC;
              if (i < nSl + nSc) { sgu_item(C, l, i < nSl ? 128 * vx + i : 1024 + 16 * vx + (i - nSl), i < 32); continue; } i -= nSl + nSc;
              cdft_tile(C, i < nDl ? 128 * vx + i : 1024 + 16 * vx + (i - nDl)); } }
        BAR_L();
        gla2_all(C);
        fft_load_tables(C);
        for (int it = ovr(C); it < 64; it += 32) fft_item(C, 64 * ovx(C) + it);
        BAR_L();
        { for (int it = ovr(C); it < 288; it += 32) { const int gi = 288 * ovx(C) + it, rem = gi % 144; if (last && rem < 16) continue; gla3_item(C, l, gi); }
          bf16* YS = wsb(C, WS_R + R_YS);
          const int tid = otid(), lane = tid & 63, wave = owave(), wr = wave >> 2, wc = wave & 3, fr = lane & 15, fq = lane >> 4;
          const int nctx = last ? 0 : 8;
          for (int t2l = ovr(C); t2l < nctx; t2l += 32) { const int t2 = 8 * ovx(C) + t2l;
              const int b = t2 >> 2, tm = (t2 >> 1) & 1, tn = t2 & 1, K = 2 * TC, mrow0 = MLAT + b * TC; const bf16* A = wsb(C, WS_DLC); const bf16* Bt = wsb(C, WS_R + R_ZTC) + (size_t)b * 256 * 512;
              const bf16* pa0 = A + (size_t)(tm * 128 + (tid >> 3)) * K + (tid & 7) * 8; const bf16* pa1 = pa0 + (size_t)64 * K;
              const bf16* pb0 = Bt + (size_t)(tn * 128 + (tid >> 3)) * K + (tid & 7) * 8; const bf16* pb1 = pb0 + (size_t)64 * K;
              f32x4 acc[4][2]; tg_zero(acc); tg_tile(acc, C.lds, pa0, pa1, pb0, pb1, K / 64);
#pragma unroll
              for (int m = 0; m < 4; ++m)
#pragma unroll
                  for (int n = 0; n < 2; ++n) { const int row = mrow0 + tm * 128 + wr * 64 + m * 16 + fr, col = tn * 128 + wc * 32 + n * 16 + 4 * fq;
                      u32x2 w; w.x = pk2(acc[m][n][0], acc[m][n][1]); w.y = pk2(acc[m][n][2], acc[m][n][3]); *(u32x2*)(YS + (size_t)row * D + 512 + col) = w; }
          }
        }
        BAR_X();
        { pg8::Gemm g{wsb(C, WS_R + R_YS), wW(C, WE_WBR + (size_t)l * 4 * 1024 * 256), 256, nullptr, D}; pg8::Sched<4> S; S.go.init_l(nMl, 16, ovr(C), ovx(C), 1); S.bp0 = 0; S.p0 = 0; S.pe = nullptr;
          pg8::EpiP E{wsb(C, WS_R + R_G)};
          pg8::gemm_phase<pg8::EpiP, pg8::Sched<4>, false>(C.lds, g, S, E); }
        BAR_L();
        { pg8::Gemm g{(const bf16*)h8buf(C), (const bf16*)(ows(C.ws_) + WS_G8 + (size_t)l * 4096 * 1024), D / 2, nullptr, D / 2}; pg8::Sched<0> S; S.go.init_l(nMl, 16, ovr(C), ovx(C)); S.bp0 = 0; S.p0 = 0; S.pe = nullptr;
          pg8::EpiGateMix E{wsb(C, WS_R + R_G), wsb(C, WS_R + R_MM), 1.0f / G8_SCALE};
          pg8::gemm_phase<pg8::EpiGateMix, pg8::Sched<0>, false, true>(C.lds, g, S, E); }
        BAR_L();
        { pg8::Gemm g{wsb(C, WS_R + R_MM), wW(C, WE_WO + (size_t)l * D * D), D, nullptr, D}; pg8::Sched<0> S; S.go.init_l(nMl, 4, ovr(C), ovx(C), 1); S.bp0 = 0; S.p0 = 0; S.pe = nullptr;
          pg8::EpiAct E{wsb(C, WS_R + R_YS), D, EM_NONE, nullptr};
          pg8::gemm_phase<pg8::EpiAct, pg8::Sched<0>, false>(C.lds, g, S, E); }
        BAR_L();
        p_lnb(C, l, mrows);
        const bool moe = (l & 1); const int jm = l >> 1;
        if (moe) GRID_BAR(); else BAR_X();
        int npanels = mrows / 256;
        if (moe) { p_route_build(C, l, mrows); GRID_BAR(); RouteInfo R; route_info(C, jm, R); npanels = R.npanels; }
        { const int* rt = (const int*)(ows(C.ws_) + WS_ROUTE); const int* s2t = moe ? rt + RT_S2T : rt + RT_IDT; const int* pe = rt + RT_PE;
          const bf16* WGU = moe ? wW(C, WE_GUE + (size_t)jm * 8 * 5632 * 1024) : wW(C, WE_GUD + (size_t)jm * 5632 * 1024);
          const bf16* WDN = moe ? wW(C, WE_DE + (size_t)jm * 8 * 1024 * 2816) : wW(C, WE_DD + (size_t)jm * 1024 * 2816);
          bf16* ACT = wsb(C, WS_R + R_ACT); bf16* Y2 = wsb(C, WS_R + R_Y2);
          const int pcap = moe ? (DOWN8_MOE ? 296 : 128) : 144;
#pragma unroll 1
          for (int p0 = 0; p0 < npanels; p0 += pcap) { const int np = (npanels - p0) < pcap ? (npanels - p0) : pcap;
              const bool own = moe && oloc(C);
              const int plo = (np * ovx(C)) >> 3, phi = (np * (ovx(C) + 1)) >> 3;
              { pg8::Gemm g{(const bf16*)h8buf(C), WGU, D / 2, s2t, D / 2}; pg8::Sched<2> S; if (own) S.go.init_p(phi - plo, 22, ovr(C), plo); else if (moe) S.go.init(np, 22, ogrid(), oblk()); else S.go.init_l(nMl, 22, ovr(C), ovx(C), 1); S.bp0 = 0; S.p0 = p0; S.pe = moe ? pe : nullptr;
                const bool f8down = moe ? DOWN8_MOE : DOWN8_DENSE;
                pg8::EpiSwiGLU E{ACT, DFF, 1.0f / G8_SCALE, f8down ? ACT8_SCALE : 0.f};
                pg8::gemm_phase<pg8::EpiSwiGLU, pg8::Sched<2>, true, true>(C.lds, g, S, E); }
              if (moe && !own) GRID_BAR(); else BAR_L();
              if (moe ? DOWN8_MOE : DOWN8_DENSE) { pg8::Gemm g{ACT, WDN, DFF / 2, nullptr, DFF / 2}; pg8::Sched<3> S; if (own) S.go.init_p(phi - plo, 4, ovr(C), plo, 1); else if (moe) S.go.init(np, 4, ogrid(), oblk()); else S.go.init_l(nMl, 4, ovr(C), ovx(C)); S.bp0 = 8; S.p0 = p0; S.pe = moe ? pe : nullptr;
                pg8::EpiScale E{Y2, D, 1.0f / (G8_SCALE * ACT8_SCALE)};
                pg8::gemm_phase<pg8::EpiScale, pg8::Sched<3>, false, true>(C.lds, g, S, E); }
              else { pg8::Gemm g{ACT, WDN, DFF, nullptr, DFF}; pg8::Sched<3> S; if (own) S.go.init_p(phi - plo, 4, ovr(C), plo, 1); else if (moe) S.go.init(np, 4, ogrid(), oblk()); else S.go.init_l(nMl, 4, ovr(C), ovx(C)); S.bp0 = 4; S.p0 = p0; S.pe = moe ? pe : nullptr;
                pg8::EpiAct E{Y2, D, EM_NONE, nullptr};
                pg8::gemm_phase<pg8::EpiAct, pg8::Sched<3>, false>(C.lds, g, S, E); }
              if (!moe) BAR_L(); else if (own && p0 + np < npanels) BAR_X(); else GRID_BAR();
          } }
        p_lnc(C, l, mrows);
        if (!last) BAR_X();
    }
}

extern "C" void kernel_launch(void* const* d_in, const int* in_sizes, int n_in, void* d_out, int out_size, void* d_ws, size_t ws_size, hipStream_t stream) {
    static int grid = 0;
    if (grid == 0) {
        if (n_in != 28 || out_size != MLAT * D || ws_size < WS_END) { fprintf(stderr, "kernel_launch: unexpected shapes (n_in %d, out %d, ws %zu < %zu)\n", n_in, out_size, ws_size, (size_t)WS_END); grid = -1; return; }
        int dev = 0, cus = 0, per_cu = 0;
        if (hipGetDevice(&dev) != hipSuccess || hipDeviceGetAttribute(&cus, hipDeviceAttributeMultiprocessorCount, dev) != hipSuccess) { grid = -1; return; }
        if (hipFuncSetAttribute((const void*)fwd_kernel, hipFuncAttributeMaxDynamicSharedMemorySize, LDS_BYTES) != hipSuccess) { fprintf(stderr, "kernel_launch: hipFuncSetAttribute failed\n"); grid = -1; return; }
        if (hipOccupancyMaxActiveBlocksPerMultiprocessor(&per_cu, (const void*)fwd_kernel, NTHR, LDS_BYTES) != hipSuccess || per_cu < 1) fprintf(stderr, "kernel_launch: occupancy query says %d\n", per_cu);
        (void)hipGetLastError();
        grid = cus;
        if (grid != 256) { fprintf(stderr, "kernel_launch: built for 256 CUs, device has %d\n", cus); grid = -1; return; }
    }
    if (grid < 0) return;
    if (hipMemsetAsync((char*)d_ws + WS_CTL, 0, CTL_BYTES, stream) != hipSuccess) return;
    Params p{};
    for (int i = 0; i < 28; ++i) p.in[i] = (const float*)d_in[i];
    p.out = (float*)d_out; p.ws = (unsigned char*)d_ws;
    hipLaunchKernelGGL(fwd_kernel, dim3(grid), dim3(NTHR), LDS_BYTES, stream, p);
}
```

```cpp
#include <hip/hip_runtime.h>
#include <cstdio>
#include <cstdint>

#define GAS __attribute__((address_space(1)))
#define LAS __attribute__((address_space(3)))
typedef unsigned short bf16;
typedef short bf16x8 __attribute__((ext_vector_type(8)));
typedef float f32x4 __attribute__((ext_vector_type(4)));
typedef unsigned u32x4 __attribute__((ext_vector_type(4)));
typedef unsigned u32x2 __attribute__((ext_vector_type(2)));
typedef float f32x2 __attribute__((ext_vector_type(2)));

#ifndef PROBE
#define PROBE 0
#endif
constexpr int NB = 16, T = 2048, TC = 256, D = 1024, DEPTH = 4;
constexpr int MLAT = NB * T, MCTX = NB * TC, M = MLAT + MCTX;
constexpr int NIN = 1824, NINP = 2048, DFF = 2816, NE = 8;
constexpr int NTHR = 512, NWAVE = 8;
constexpr float ALPHA = 1.6817928305074290f;
constexpr float EPS = 1e-6f;
constexpr int C_Q = 0, C_K = 128, C_V = 256, C_R = 512, C_LAF = 768, C_LAB = 896, C_POOL = 1024, C_FFT = 1280, C_SU = 1536, C_SV = 1792;

constexpr size_t MiB = 1u << 20;
constexpr size_t WS_CTL = 0, CTL_BYTES = 1 * MiB;
constexpr size_t WS_MOD = 1 * MiB;
constexpr size_t WS_CS64 = 3 * MiB;
constexpr size_t WS_DLC = 3 * MiB + 65536;
constexpr size_t WS_SGUW = 3 * MiB + 512 * 1024;
constexpr size_t WS_TF1 = 4 * MiB;
constexpr size_t WS_TF2 = 4 * MiB + 8192;
constexpr size_t WS_TW = 4 * MiB + 24576;
constexpr size_t WS_ROUTE = 20 * MiB;
constexpr size_t WS_W = 22 * MiB;
constexpr size_t WS_XC = 384 * MiB;
constexpr size_t WS_G8 = WS_XC;
constexpr size_t OUT_H8 = 72 * MiB;
constexpr bool DOWN8_DENSE = true;
constexpr bool DOWN8_MOE = true;
constexpr float ACT8_SCALE = 2.0f;
constexpr float G8_SCALE = 32.0f;
constexpr size_t WS_H = 400 * MiB;
constexpr bool XBF16 = true;
constexpr size_t WS_R = 472 * MiB;
constexpr size_t WS_END = 904 * MiB;
constexpr size_t R_YS = 0, R_MM = 72 * MiB, R_BIG = 144 * MiB;
constexpr size_t R_COLS = R_BIG, R_SCR = R_BIG + 144 * MiB;
constexpr size_t R_ZT = R_SCR, R_ZTC = R_SCR + 32 * MiB, R_DH = R_SCR + 36 * MiB, R_DEC = R_SCR + 72 * MiB;
constexpr size_t R_G = R_BIG;
constexpr size_t R_ACT = 0, R_Y2 = 204 * MiB;
constexpr size_t WE_WIN = 0;
constexpr size_t WE_WBR = WE_WIN + (size_t)4 * 6144 * 1024;
constexpr size_t WE_WO = WE_WBR + (size_t)4 * 4 * 1024 * 256;
constexpr size_t WE_GUD = WE_WO + (size_t)4 * 1024 * 1024;
constexpr size_t WE_DD = WE_GUD + (size_t)2 * 5632 * 1024;
constexpr size_t WE_GUE = WE_DD + (size_t)2 * 1024 * 2816;
constexpr size_t WE_DE = WE_GUE + (size_t)2 * 8 * 5632 * 1024;
constexpr size_t WE_END = WE_DE + (size_t)2 * 8 * 1024 * 2816;
static_assert(WE_END * 2 <= 362 * MiB, "weights fit");
constexpr int MAXP = 296;
constexpr size_t RT_TOKE = 0, RT_TOKR = (size_t)M * 2, RT_TOKW = (size_t)M * 4, RT_TOKS = (size_t)M * 6, RT_S2T = (size_t)M * 8, RT_PE = RT_S2T + (size_t)MAXP * 256, RT_BLK = RT_PE + 512, RT_IDT = RT_BLK + 2048;
static_assert((RT_IDT + M) * 4 <= 2 * MiB, "route tables fit");
constexpr int CW_BAR = 4096;
constexpr int CW_CNT = 16384;
constexpr int LDS_BYTES = 147456;
constexpr int LDS_MISC = 147456 - 256;

typedef __bf16 hwbf2 __attribute__((ext_vector_type(2)));
__device__ __forceinline__ unsigned pk2(float lo, float hi) { hwbf2 v; v[0] = (__bf16)lo; v[1] = (__bf16)hi; return __builtin_bit_cast(unsigned, v); }
__device__ __forceinline__ unsigned f2bf(float f) { return (unsigned)__builtin_bit_cast(unsigned short, (__bf16)f); }
__device__ __forceinline__ unsigned pk4_fp8(float a, float b, float c, float d) { int w = 0; w = __builtin_amdgcn_cvt_pk_fp8_f32(a, b, w, false); w = __builtin_amdgcn_cvt_pk_fp8_f32(c, d, w, true); return (unsigned)w; }
__device__ __forceinline__ float bf2f(unsigned b) { return __builtin_bit_cast(float, b << 16); }
__device__ __forceinline__ float bflo(unsigned w) { return __builtin_bit_cast(float, w << 16); }
__device__ __forceinline__ float bfhi(unsigned w) { return __builtin_bit_cast(float, w & 0xffff0000u); }
typedef float f32x2 __attribute__((ext_vector_type(2)));
__device__ __forceinline__ float sigmoidf_(float x) { return __builtin_amdgcn_rcpf(1.0f + __expf(-x)); }
__device__ __forceinline__ float siluf_(float x) { return x * __builtin_amdgcn_rcpf(1.0f + __expf(-x)); }
__device__ __forceinline__ float gelu_tanh_(float x) { const float u = 0.7978845608028654f * (x + 0.044715f * x * x * x); return x * __builtin_amdgcn_rcpf(1.0f + __expf(-2.0f * u)); }
__device__ __forceinline__ float logsigmoidf_(float z) { return fminf(z, 0.f) - __logf(1.0f + __expf(-fabsf(z))); }
template <int CTRL, int RMASK> __device__ __forceinline__ float dpp_get(float v) { return __builtin_bit_cast(float, __builtin_amdgcn_update_dpp(0, __builtin_bit_cast(int, v), CTRL, RMASK, 0xF, true)); }
__device__ __forceinline__ float wave_sum(float v) {
    v += dpp_get<0xB1, 0xF>(v); v += dpp_get<0x4E, 0xF>(v); v += dpp_get<0x141, 0xF>(v); v += dpp_get<0x140, 0xF>(v);
    v += dpp_get<0x142, 0xA>(v); v += dpp_get<0x143, 0xC>(v);
    return __builtin_bit_cast(float, __builtin_amdgcn_readlane(__builtin_bit_cast(int, v), 63));
}

__device__ __forceinline__ int otid() { int t = threadIdx.x; asm volatile("" : "+v"(t)); return t; }
__device__ __forceinline__ int oblk() { int b = blockIdx.x; asm volatile("" : "+s"(b)); return b; }
__device__ __forceinline__ int ogrid() { int g = gridDim.x; asm volatile("" : "+s"(g)); return g; }
__device__ __forceinline__ int owave() { return __builtin_amdgcn_readfirstlane(otid() >> 6); }
__device__ __forceinline__ unsigned ozero() { unsigned z; asm volatile("s_mov_b32 %0, 0" : "=s"(z)); return z; }
__device__ __forceinline__ unsigned char* ows(unsigned char* p) { return p + ozero(); }
__device__ __forceinline__ const float* const* oin(const float* const* p) { return p; }
__device__ __forceinline__ float* oout(float* p) { return p + ozero(); }

#define XB_TMO      128
#define XB_XCNT(j)  (256  + 64 * (j))
#define XB_XSUB(j)  (1280 + 64 * (j))
#define XB_XGEN(j)  (2304 + 64 * (j))
#define XB_TOP      3328
#define XB_TOPGEN   3392
#define XB_LSUB(j)  (3456 + 64 * (j))
#define XB_LGEN(j)  (4480 + 64 * (j))
#define XCD_BAR_WORDS 3456
#define XB_SPIN_CAP (1u << 22)
__device__ __forceinline__ unsigned xb_ld(unsigned* p)              { return __hip_atomic_load(p, __ATOMIC_RELAXED, __HIP_MEMORY_SCOPE_AGENT); }
__device__ __forceinline__ unsigned xb_add(unsigned* p, unsigned v) { return __hip_atomic_fetch_add(p, v, __ATOMIC_RELAXED, __HIP_MEMORY_SCOPE_AGENT); }
__device__ __forceinline__ unsigned xb_xcc_id() { return (unsigned)__builtin_amdgcn_s_getreg((3 << 11) | 20) & 0xFu; }
#define XB_SPIN(cond, bar) do { unsigned _sp = 0; while (cond) { __builtin_amdgcn_s_sleep(1); \
    if ((++_sp & 255u) == 0u) { if (xb_ld(&(bar)[XB_TMO])) break; if (_sp > XB_SPIN_CAP) { atomicAdd(&(bar)[XB_TMO], 1u); break; } } } } while (0)
struct XcdBarrier { unsigned* bar; unsigned x; volatile LAS unsigned* st; };
__device__ __forceinline__ XcdBarrier xcd_barrier_post(unsigned* bar, volatile LAS unsigned* st) {
    XcdBarrier b; b.bar = bar; b.x = xb_xcc_id(); b.st = st;
    if (threadIdx.x == 0) { st[3] = xb_add(&bar[XB_XCNT(b.x)], 1u); st[4] = b.x; }
    return b;
}
__device__ __forceinline__ void xcd_barrier_complete(unsigned* bar, unsigned x, unsigned& nloc, unsigned& nx, unsigned& even) {
    const unsigned G = gridDim.x * gridDim.y * gridDim.z;
    unsigned sum, cnt, mine, odd, sp = 0u;
    for (;;) {
        sum = 0u; cnt = 0u; mine = 0u; odd = 0u;
#pragma unroll
        for (unsigned j = 0; j < 16; ++j) { const unsigned c = xb_ld(&bar[XB_XCNT(j)]); sum += c; cnt += (c > 0u) ? 1u : 0u; mine = (j == x) ? c : mine; odd += (j < 8u ? c != 32u : c != 0u) ? 1u : 0u; }
        if (sum == G) break;
        __builtin_amdgcn_s_sleep(1);
        if ((++sp & 255u) == 0u) { if (xb_ld(&bar[XB_TMO])) break; if (sp > XB_SPIN_CAP) { atomicAdd(&bar[XB_TMO], 1u); break; } }
    }
    nloc = mine > 0u ? mine : 1u; nx = cnt > 0u ? cnt : 1u; even = (odd == 0u && sum == 256u) ? 1u : 0u;
}
__device__ __forceinline__ void xcd_barrier(const XcdBarrier& b, bool rel) {
    asm volatile("s_waitcnt vmcnt(0)" ::: "memory");
    __syncthreads();
    if (otid() == 0) {
        unsigned* bar = b.bar;
        __builtin_amdgcn_s_waitcnt(0);
        unsigned nloc = b.st[0], nx = b.st[1];
        if (nloc == 0u) { unsigned even; xcd_barrier_complete(bar, b.x, nloc, nx, even); b.st[0] = nloc; b.st[1] = nx; b.st[2] = even; }
        const unsigned old = xb_add(&bar[XB_XSUB(b.x)], 1u);
        const unsigned gen = old / nloc;
        if (old + 1u == (gen + 1u) * nloc) {
            if (rel) __builtin_amdgcn_fence(__ATOMIC_RELEASE, "agent");
            asm volatile("s_waitcnt vmcnt(0)" ::: "memory");
            const unsigned og = xb_add(&bar[XB_TOP], 1u);
            const unsigned tg = og / nx;
            if (og + 1u == (tg + 1u) * nx) xb_add(&bar[XB_TOPGEN], 1u);
            else XB_SPIN(xb_ld(&bar[XB_TOPGEN]) == tg, bar);
            __builtin_amdgcn_fence(__ATOMIC_ACQUIRE, "agent");
            xb_add(&bar[XB_XGEN(b.x)], 1u);
            asm volatile("s_waitcnt vmcnt(0)" ::: "memory");
        } else {
            XB_SPIN(xb_ld(&bar[XB_XGEN(b.x)]) == gen, bar);
            __builtin_amdgcn_fence(__ATOMIC_ACQUIRE, "agent");
            asm volatile("s_waitcnt vmcnt(0)" ::: "memory");
        }
    }
    __syncthreads();
}

__device__ __forceinline__ void xcd_local_barrier(unsigned* bar, unsigned x) {
    asm volatile("s_waitcnt vmcnt(0)" ::: "memory");
    __syncthreads();
    if (otid() == 0) {
        __builtin_amdgcn_s_waitcnt(0);
        const unsigned old = xb_add(&bar[XB_LSUB(x)], 1u);
        const unsigned gen = old / 32u;
        if (old + 1u == (gen + 1u) * 32u) xb_add(&bar[XB_LGEN(x)], 1u);
        else XB_SPIN(xb_ld(&bar[XB_LGEN(x)]) == gen, bar);
        __builtin_amdgcn_fence(__ATOMIC_ACQUIRE, "agent");
        asm volatile("s_waitcnt vmcnt(0)" ::: "memory");
    }
    __syncthreads();
}

struct Params { const float* in[28]; float* out; unsigned char* ws; };
struct Ctx {
    LAS unsigned char* lds;
    unsigned char* ws_;
    const float* const* in_;
    float* out_;
    int vx, vr, loc;
};
__device__ __forceinline__ int ovx(const Ctx& C) { int v = C.vx; asm volatile("" : "+s"(v)); return v; }
__device__ __forceinline__ int ovr(const Ctx& C) { int v = C.vr; asm volatile("" : "+s"(v)); return v; }
__device__ __forceinline__ int oloc(const Ctx& C) { int v = C.loc; asm volatile("" : "+s"(v)); return v; }
__device__ __forceinline__ int lrow(const Ctx& C, int j) { const int vx = ovx(C); return j < 4096 ? 4096 * vx + j : MLAT + 512 * vx + (j - 4096); }
__device__ __forceinline__ bf16* wsb(const Ctx& C, size_t off) { return (bf16*)(ows(C.ws_) + off); }
__device__ __forceinline__ bf16* wW(const Ctx& C, size_t eoff) { return (bf16*)(ows(C.ws_) + WS_W) + eoff; }
__device__ __forceinline__ const float* modv(const Ctx& C, int l, int r, int part) { return (const float*)(ows(C.ws_) + WS_MOD) + ((size_t)(l * 17 + r) * 6144 + part * 1024); }
__device__ __forceinline__ int row_r(int m) { return m < MLAT ? (m >> 11) : 16; }

constexpr int TG_ROWB = 144;
constexpr int TG_OPB = 128 * TG_ROWB;
__device__ __forceinline__ void tg_tile(f32x4 (&acc)[4][2], LAS unsigned char* lds, const bf16* pa0, const bf16* pa1, const bf16* pb0, const bf16* pb1, int nk) {
    const int tid = otid(), lane = tid & 63, wave = tid >> 6, wr = wave >> 2, wc = wave & 3, fr = lane & 15, fq = lane >> 4;
    const int so0 = (tid >> 3) * TG_ROWB + (tid & 7) * 16, so1 = so0 + 64 * TG_ROWB;
    u32x4 ra0 = *(const u32x4*)pa0, ra1 = *(const u32x4*)pa1, rb0 = *(const u32x4*)pb0, rb1 = *(const u32x4*)pb1;
    *(LAS u32x4*)(lds + so0) = ra0; *(LAS u32x4*)(lds + so1) = ra1; *(LAS u32x4*)(lds + TG_OPB + so0) = rb0; *(LAS u32x4*)(lds + TG_OPB + so1) = rb1;
    __syncthreads();
    for (int kt = 0; kt < nk; ++kt) {
        const bool more = kt + 1 < nk;
        if (more) { const int ko = (kt + 1) * 64; ra0 = *(const u32x4*)(pa0 + ko); ra1 = *(const u32x4*)(pa1 + ko); rb0 = *(const u32x4*)(pb0 + ko); rb1 = *(const u32x4*)(pb1 + ko); }
        LAS unsigned char* cur = lds + (kt & 1) * (2 * TG_OPB);
#pragma unroll
        for (int ks = 0; ks < 2; ++ks) {
            bf16x8 af[4], bfr[2];
#pragma unroll
            for (int m = 0; m < 4; ++m) af[m] = *(const LAS bf16x8*)(cur + (wr * 64 + m * 16 + fr) * TG_ROWB + ks * 64 + fq * 16);
#pragma unroll
            for (int n = 0; n < 2; ++n) bfr[n] = *(const LAS bf16x8*)(cur + TG_OPB + (wc * 32 + n * 16 + fr) * TG_ROWB + ks * 64 + fq * 16);
#pragma unroll
            for (int m = 0; m < 4; ++m)
#pragma unroll
                for (int n = 0; n < 2; ++n) acc[m][n] = __builtin_amdgcn_mfma_f32_16x16x32_bf16(bfr[n], af[m], acc[m][n], 0, 0, 0);
        }
        if (more) { LAS unsigned char* nxt = lds + ((kt + 1) & 1) * (2 * TG_OPB);
            *(LAS u32x4*)(nxt + so0) = ra0; *(LAS u32x4*)(nxt + so1) = ra1; *(LAS u32x4*)(nxt + TG_OPB + so0) = rb0; *(LAS u32x4*)(nxt + TG_OPB + so1) = rb1; }
        __syncthreads();
    }
}
__device__ __forceinline__ void tg_zero(f32x4 (&acc)[4][2]) {
#pragma unroll
    for (int m = 0; m < 4; ++m)
#pragma unroll
        for (int n = 0; n < 2; ++n) acc[m][n] = (f32x4){0.f, 0.f, 0.f, 0.f};
}

enum { EM_NONE = 0, EM_SIGMOID = 1, EM_COLS = 2 };
__device__ __forceinline__ f32x4 epi_apply(f32x4 v, int mode, int col, const float* bgk) {
    if (mode == EM_NONE) return v;
    if (mode == EM_SIGMOID) { for (int j = 0; j < 4; ++j) v[j] = sigmoidf_(v[j]); return v; }
    if (col < C_K) { for (int j = 0; j < 4; ++j) v[j] *= 0.17677669529663689f; }
    else if (col < C_R) {}
    else if (col < C_LAF) { for (int j = 0; j < 4; ++j) v[j] = siluf_(v[j]); }
    else if (col < C_POOL) { for (int j = 0; j < 4; ++j) v[j] = logsigmoidf_(v[j] + bgk[col - C_LAF + j]) * 0.0625f; }
    else if (col < C_SU) {}
    else { for (int j = 0; j < 4; ++j) v[j] = gelu_tanh_(v[j]); }
    return v;
}
__device__ __forceinline__ void tg_gemm_plain(const Ctx& C, const bf16* A, int lda, const int* rowmap, int mrows, const bf16* Bt, int ldb, int ncols, int K,
                                              bf16* O, int ldo, int mode, const float* bgk) {
    const int tid = otid(), lane = tid & 63, wave = owave(), wr = wave >> 2, wc = wave & 3, fr = lane & 15, fq = lane >> 4;
    const int ntn = ncols / 128, ntiles = (mrows / 128) * ntn;
    for (int t = oblk(); t < ntiles; t += ogrid()) {
        const int tm = t / ntn, tn = t % ntn;
        const int r0 = tm * 128 + (tid >> 3), r1 = r0 + 64;
        const size_t ar0 = rowmap ? (size_t)rowmap[r0] : (size_t)r0, ar1 = rowmap ? (size_t)rowmap[r1] : (size_t)r1;
        const bf16* pa0 = A + ar0 * lda + (tid & 7) * 8; const bf16* pa1 = A + ar1 * lda + (tid & 7) * 8;
        const bf16* pb0 = Bt + (size_t)(tn * 128 + (tid >> 3)) * ldb + (tid & 7) * 8; const bf16* pb1 = pb0 + (size_t)64 * ldb;
        f32x4 acc[4][2]; tg_zero(acc);
        tg_tile(acc, C.lds, pa0, pa1, pb0, pb1, K / 64);
#pragma unroll
        for (int m = 0; m < 4; ++m)
#pragma unroll
            for (int n = 0; n < 2; ++n) {
                const int row = tm * 128 + wr * 64 + m * 16 + fr, col = tn * 128 + wc * 32 + n * 16 + 4 * fq;
                const f32x4 v = epi_apply(acc[m][n], mode, col, bgk);
                u32x2 w; w.x = pk2(v[0], v[1]); w.y = pk2(v[2], v[3]);
                *(u32x2*)(O + (size_t)row * ldo + col) = w;
            }
    }
}


namespace pg8 {
constexpr int BM = 256, BK = 64, HALF = 128, HTB = HALF * BK * 2, STAGE_BYTES = 8 * HTB;
__device__ __forceinline__ int lds_byte(int r, int c) { return r * 128 + ((((c >> 3) ^ (r >> 1)) & 7) << 4) + (c & 7) * 2; }
__device__ __forceinline__ void stage_rc(int b, int& R, int& C) { R = b >> 7; C = ((((b >> 4) ^ (R >> 1)) & 7) << 3) + ((b & 15) >> 1); }
__device__ __forceinline__ int perm32(int rho) { const int n = rho >> 4, i = rho & 15; return 8 * (i >> 2) + 4 * n + (i & 3); }
struct Unit { int ap, bp, orow, ocol, akb; };
struct Gemm { const bf16* A; const bf16* Bt; int K; const int* rowmap; int lda; };
struct GridOrder {
    int nM, nN, nwg, G, c, vx, pb, rev;
    __device__ __forceinline__ void init(int nM_, int nN_, int G_, int c_) { nM = nM_; nN = nN_; nwg = nM * nN; G = G_; c = c_; vx = -1; pb = 0; rev = 0; }
    __device__ __forceinline__ void init_l(int nMl, int nN_, int vr_, int vx_, int rev_ = 0) { nM = nMl; nN = nN_; nwg = nM * nN; G = 32; c = vr_; vx = vx_; pb = 0; rev = rev_; }
    __device__ __forceinline__ void init_p(int nMl, int nN_, int vr_, int pb_, int rev_ = 0) { nM = nMl; nN = nN_; nwg = nM * nN; G = 32; c = vr_; vx = -2; pb = pb_; rev = rev_; }
    __device__ __forceinline__ bool mn(int i, int& pm, int& pn) const {
        const long L = (long)i * G + c; if (L >= nwg) return false;
        int wgid = (int)L; if (vx == -1) { const int q = nwg / 8, r = nwg % 8, xcd = wgid % 8, off = wgid / 8; wgid = (xcd < r ? xcd * (q + 1) : r * (q + 1) + (xcd - r) * q) + off; }
        const int nig = 8 * nN, gid = wgid / nig, fm = gid * 8, gsz = (nM - fm) < 8 ? (nM - fm) : 8;
        pm = fm + ((wgid % nig) % gsz); pn = (wgid % nig) / gsz;
        if (rev) pm = nM - 1 - pm;
        if (vx >= 0) pm = pm < 16 ? 16 * vx + pm : 128 + 2 * vx + (pm - 16); else if (vx == -2) pm += pb;
        return true;
    }
};
__device__ __forceinline__ unsigned cvt_pk_bf16(float lo, float hi) { unsigned r; asm volatile("v_cvt_pk_bf16_f32 %0, %1, %2" : "=v"(r) : "v"(lo), "v"(hi)); return r; }

typedef int i32x4 __attribute__((ext_vector_type(4)));
template <class Epi, class Sched, bool GATHER, bool F8 = false>
__device__ __forceinline__ void gemm_phase(LAS unsigned char* lds, const Gemm g, const Sched& S, const Epi& E) {
    const int tid = otid(), wid = __builtin_amdgcn_readfirstlane(tid >> 6), lane = tid & 63, wr = wid >> 2, wc = wid & 3, fr = lane & 15, fq = lane >> 4;
    const int K = g.K, nt = K / BK;
    int Rl[2]; unsigned Cb[2], voffB[2];
#pragma unroll
    for (int i = 0; i < 2; ++i) { int R, Cc; stage_rc(tid * 16 + i * 8192, R, Cc); const int Rb = (R & ~31) + perm32(R & 31); Rl[i] = R; Cb[i] = (unsigned)Cc * 2u; voffB[i] = (unsigned)(Rb * K + Cc) * 2u; }
    const size_t kstep = (size_t)(BK * 2), hstep = (size_t)HALF * K * 2, tstep = 2 * hstep;
    const unsigned ldsw = (unsigned)wid * 1024u;
    const int aoff0 = lds_byte(wr * 64 + fr, fq * 8), aoff1 = lds_byte(wr * 64 + fr, 32 + fq * 8), boff0 = lds_byte(wc * 32 + fr, fq * 8), boff1 = lds_byte(wc * 32 + fr, 32 + fq * 8);
#define PG8_SA(b, h) (((b) * 2 + (h)) * HTB)
#define PG8_SB(b, h) ((4 + (b) * 2 + (h)) * HTB)
#define PG8_STAGE(bufoff, gbase, voff) do { _Pragma("unroll") for (int _i = 0; _i < 2; ++_i) \
        __builtin_amdgcn_global_load_lds((const unsigned*)((const char*)(gbase) + (voff)[_i]), (LAS unsigned*)(lds + (bufoff) + ldsw + _i * 8192), 16, 0, 0); } while (0)
#define PG8_LDA(dst, b, h) do { _Pragma("unroll") for (int m = 0; m < 4; ++m) { dst[m][0] = *(const LAS bf16x8*)(lds + PG8_SA(b, h) + aoff0 + m * 2048); dst[m][1] = *(const LAS bf16x8*)(lds + PG8_SA(b, h) + aoff1 + m * 2048); } } while (0)
#define PG8_LDB(dst, b, h) do { _Pragma("unroll") for (int n = 0; n < 2; ++n) { dst[n][0] = *(const LAS bf16x8*)(lds + PG8_SB(b, h) + boff0 + n * 2048); dst[n][1] = *(const LAS bf16x8*)(lds + PG8_SB(b, h) + boff1 + n * 2048); } } while (0)
#define PG8_MMA(ai, bj, At, Bt) do { __builtin_amdgcn_s_setprio(1); _Pragma("unroll") for (int m = 0; m < 4; ++m) _Pragma("unroll") for (int n = 0; n < 2; ++n) { \
        if (F8) { const i32x4 b0_ = __builtin_bit_cast(i32x4, Bt[n][0]), b1_ = __builtin_bit_cast(i32x4, Bt[n][1]), a0_ = __builtin_bit_cast(i32x4, At[m][0]), a1_ = __builtin_bit_cast(i32x4, At[m][1]); \
            acc[ai][bj][m][n] = __builtin_amdgcn_mfma_scale_f32_16x16x128_f8f6f4(__builtin_shufflevector(b0_, b1_, 0, 1, 2, 3, 4, 5, 6, 7), __builtin_shufflevector(a0_, a1_, 0, 1, 2, 3, 4, 5, 6, 7), acc[ai][bj][m][n], 0, 0, 0, 0x7F7F7F7F, 0, 0x7F7F7F7F); } \
        else { _Pragma("unroll") for (int k = 0; k < 2; ++k) acc[ai][bj][m][n] = __builtin_amdgcn_mfma_f32_16x16x32_bf16(Bt[n][k], At[m][k], acc[ai][bj][m][n], 0, 0, 0); } } __builtin_amdgcn_s_setprio(0); } while (0)
#define PG8_WAIT_V(n) asm volatile("s_waitcnt vmcnt(" #n ")" ::: "memory")
#define PG8_WAIT_L(n) asm volatile("s_waitcnt lgkmcnt(" #n ")" ::: "memory")
#define PG8_WAIT_VF() do { (void)fresh; PG8_WAIT_V(8); } while (0)
#define PG8_BAR __builtin_amdgcn_s_barrier()
#define PG8_SCHED __builtin_amdgcn_sched_barrier(0)
#define PG8_AOFF(dst, u) do { _Pragma("unroll") for (int _h = 0; _h < 2; ++_h) _Pragma("unroll") for (int _i = 0; _i < 2; ++_i) { \
        const int _r = (u).ap * BM + _h * HALF + Rl[_i]; const unsigned _row = GATHER ? (unsigned)g.rowmap[_r] : (unsigned)_r; dst[_h][_i] = _row * (unsigned)(g.lda * 2) + Cb[_i] + (unsigned)(u).akb; } } while (0)
    Unit cur, nxt; int ui = 0;
    if (!S.next(0, cur)) return;
    f32x4 acc[2][2][4][2];
#pragma unroll
    for (int a = 0; a < 2; ++a)
#pragma unroll
        for (int b = 0; b < 2; ++b)
#pragma unroll
            for (int m = 0; m < 4; ++m)
#pragma unroll
                for (int n = 0; n < 2; ++n) acc[a][b][m][n] = (f32x4){0.f, 0.f, 0.f, 0.f};
    bf16x8 At[4][2], B0[2][2], B1[2][2];
    unsigned ao[2][2], nao[2][2]; bool fresh = false;
    PG8_AOFF(ao, cur);
    const char* Ab = (const char*)g.A;
    const char* cB = (const char*)g.Bt + (size_t)cur.bp * tstep;
    PG8_STAGE(PG8_SB(0, 0), cB, voffB); PG8_STAGE(PG8_SB(0, 1), cB + hstep, voffB); PG8_STAGE(PG8_SA(0, 0), Ab, ao[0]); PG8_STAGE(PG8_SA(0, 1), Ab, ao[1]);
    if (wr == 1) PG8_BAR;
    PG8_WAIT_V(2); PG8_BAR;
    PG8_STAGE(PG8_SB(1, 0), cB + kstep, voffB); PG8_STAGE(PG8_SA(1, 0), Ab + kstep, ao[0]); PG8_STAGE(PG8_SB(1, 1), cB + hstep + kstep, voffB);
    PG8_WAIT_V(6); PG8_BAR;
    for (;;) {
        const bool has_next = S.next(ui + 1, nxt);
        if (has_next) { PG8_AOFF(nao, nxt); }
        else {
#pragma unroll
            for (int _h = 0; _h < 2; ++_h)
#pragma unroll
                for (int _i = 0; _i < 2; ++_i) nao[_h][_i] = ao[_h][_i]; }
        const char* nB = has_next ? (const char*)g.Bt + (size_t)nxt.bp * tstep : cB;
#pragma unroll 1
        for (int t = 0; t < nt; t += 2) {
            const bool last = (t == nt - 2);
            const char* a1 = Ab + (size_t)(t + 1) * kstep;
            const char* a2 = last ? Ab : Ab + (size_t)(t + 2) * kstep; const char* b2 = last ? nB : cB + (size_t)(t + 2) * kstep;
            const char* a3 = a2 + kstep; const char* b3 = b2 + kstep;
            PG8_LDB(B0, 0, 0); PG8_LDB(B1, 0, 1); PG8_SCHED; PG8_LDA(At, 0, 0); PG8_STAGE(PG8_SA(1, 1), a1, ao[1]);
            if (last) {
#pragma unroll
                for (int _h = 0; _h < 2; ++_h)
#pragma unroll
                    for (int _i = 0; _i < 2; ++_i) ao[_h][_i] = nao[_h][_i]; }
            PG8_WAIT_VF(); PG8_WAIT_L(0); PG8_BAR; PG8_MMA(0, 0, At, B0); PG8_MMA(0, 1, At, B1); PG8_BAR; PG8_SCHED;
            PG8_LDA(At, 0, 1); PG8_STAGE(PG8_SB(0, 0), b2, voffB); PG8_STAGE(PG8_SB(0, 1), b2 + hstep, voffB); PG8_STAGE(PG8_SA(0, 0), a2, ao[0]);
            PG8_WAIT_VF(); PG8_WAIT_L(0); PG8_BAR; PG8_MMA(1, 0, At, B0); PG8_MMA(1, 1, At, B1); PG8_BAR; PG8_SCHED;
            fresh = false;
            PG8_LDB(B0, 1, 0); PG8_LDB(B1, 1, 1); PG8_SCHED; PG8_LDA(At, 1, 0); PG8_STAGE(PG8_SA(0, 1), a2, ao[1]);
            PG8_WAIT_V(8); PG8_WAIT_L(0); PG8_BAR; PG8_MMA(0, 0, At, B0); PG8_MMA(0, 1, At, B1); PG8_BAR; PG8_SCHED;
            PG8_LDA(At, 1, 1); PG8_STAGE(PG8_SB(1, 0), b3, voffB); PG8_STAGE(PG8_SB(1, 1), b3 + hstep, voffB); PG8_STAGE(PG8_SA(1, 0), a3, ao[0]);
            PG8_WAIT_V(8); PG8_WAIT_L(0); PG8_BAR; PG8_MMA(1, 0, At, B0); PG8_MMA(1, 1, At, B1); PG8_BAR; PG8_SCHED;
        }
        if (wr == 0) PG8_BAR;
        E(acc, cur, wr, wc, fr, fq);
        if (PROBE == 12) { asm volatile("" ::: "memory"); E(acc, cur, wr, wc, fr, fq); }
        if (!has_next) break;
#pragma unroll
        for (int a = 0; a < 2; ++a)
#pragma unroll
            for (int b = 0; b < 2; ++b)
#pragma unroll
                for (int m = 0; m < 4; ++m)
#pragma unroll
                    for (int n = 0; n < 2; ++n) acc[a][b][m][n] = (f32x4){0.f, 0.f, 0.f, 0.f};
        cur = nxt; cB = nB; ++ui; fresh = true;
        if (wr == 1) PG8_BAR;
    }
    PG8_WAIT_V(0);
    PG8_BAR;
#undef PG8_SA
#undef PG8_SB
#undef PG8_STAGE
#undef PG8_LDA
#undef PG8_LDB
#undef PG8_MMA
#undef PG8_WAIT_V
#undef PG8_WAIT_L
#undef PG8_WAIT_VF
#undef PG8_BAR
#undef PG8_SCHED
#undef PG8_AOFF
}
struct EpiAct {
    static constexpr int NVM = 16;
    bf16* O; int ldo; int mode; const float* bgk;
    __device__ __forceinline__ void operator()(const f32x4 (&acc)[2][2][4][2], const Unit& u, int wr, int wc, int fr, int fq) const {
#pragma unroll
        for (int ai = 0; ai < 2; ++ai)
#pragma unroll
            for (int m = 0; m < 4; ++m) { bf16* rowp = O + (size_t)(u.orow + ai * HALF + wr * 64 + m * 16 + fr) * ldo + u.ocol + wc * 32 + 8 * fq;
#pragma unroll
                for (int bj = 0; bj < 2; ++bj) { const int col = u.ocol + bj * HALF + wc * 32 + 8 * fq;
                    const f32x4 v0 = epi_apply(acc[ai][bj][m][0], mode, col, bgk), v1 = epi_apply(acc[ai][bj][m][1], mode, col + 4, bgk);
                    u32x4 w; w.x = cvt_pk_bf16(v0[0], v0[1]); w.y = cvt_pk_bf16(v0[2], v0[3]); w.z = cvt_pk_bf16(v1[0], v1[1]); w.w = cvt_pk_bf16(v1[2], v1[3]);
                    *(u32x4*)(rowp + bj * HALF) = w; } }
    }
};
__device__ __forceinline__ size_t p_index(size_t row, int i, int c) { return row * 4096 + (size_t)((c >> 6) * 256 + ((c >> 5) & 1) * 128 + i * 32 + (c & 31)); }
struct EpiP {
    static constexpr int NVM = 16;
    bf16* O;
    __device__ __forceinline__ void operator()(const f32x4 (&acc)[2][2][4][2], const Unit& u, int wr, int wc, int fr, int fq) const {
        const int i = u.ocol >> 10, c0 = (u.ocol & 1023) + wc * 32 + 8 * fq;
#pragma unroll
        for (int ai = 0; ai < 2; ++ai)
#pragma unroll
            for (int m = 0; m < 4; ++m) { const size_t row = (size_t)(u.orow + ai * HALF + wr * 64 + m * 16 + fr);
#pragma unroll
                for (int bj = 0; bj < 2; ++bj) { const f32x4 v0 = acc[ai][bj][m][0], v1 = acc[ai][bj][m][1];
                    u32x4 w; w.x = cvt_pk_bf16(v0[0], v0[1]); w.y = cvt_pk_bf16(v0[2], v0[3]); w.z = cvt_pk_bf16(v1[0], v1[1]); w.w = cvt_pk_bf16(v1[2], v1[3]);
                    *(u32x4*)(O + p_index(row, i, c0 + bj * HALF)) = w; } }
    }
};
struct EpiCols {
    static constexpr int NVM = 16;
    bf16* O;
    __device__ __forceinline__ void operator()(const f32x4 (&acc)[2][2][4][2], const Unit& u, int wr, int wc, int fr, int fq) const {
        const int tile = __builtin_amdgcn_readfirstlane(u.ocol >> 8);
        f32x4 bv[2][2];
        if (tile == 3) {
#pragma unroll
            for (int bj = 0; bj < 2; ++bj)
#pragma unroll
                for (int n = 0; n < 2; ++n) bv[bj][n] = *(const LAS f32x4*)((LAS unsigned char*)131072 + (bj * HALF + wc * 32 + 8 * fq + 4 * n) * 4);
        }
#pragma unroll
        for (int ai = 0; ai < 2; ++ai)
#pragma unroll
            for (int m = 0; m < 4; ++m) { bf16* rowp = O + (size_t)(u.orow + ai * HALF + wr * 64 + m * 16 + fr) * NINP + u.ocol + wc * 32 + 8 * fq;
#pragma unroll
                for (int bj = 0; bj < 2; ++bj) { f32x4 v0 = acc[ai][bj][m][0], v1 = acc[ai][bj][m][1];
                    if (tile == 0) { if (bj == 0) { v0 = v0 * 0.17677669529663689f; v1 = v1 * 0.17677669529663689f; } }
                    else if (tile == 2) {
#pragma unroll
                        for (int j = 0; j < 4; ++j) { v0[j] = siluf_(v0[j]); v1[j] = siluf_(v1[j]); } }
                    else if (tile == 3) {
#pragma unroll
                        for (int j = 0; j < 4; ++j) { v0[j] = logsigmoidf_(v0[j] + bv[bj][0][j]) * 0.0625f; v1[j] = logsigmoidf_(v1[j] + bv[bj][1][j]) * 0.0625f; } }
                    else if (tile >= 6) {
#pragma unroll
                        for (int j = 0; j < 4; ++j) { v0[j] = gelu_tanh_(v0[j]); v1[j] = gelu_tanh_(v1[j]); } }
                    u32x4 w; w.x = cvt_pk_bf16(v0[0], v0[1]); w.y = cvt_pk_bf16(v0[2], v0[3]); w.z = cvt_pk_bf16(v1[0], v1[1]); w.w = cvt_pk_bf16(v1[2], v1[3]);
                    *(u32x4*)(rowp + bj * HALF) = w; } }
    }
};
struct EpiGateMix {
    static constexpr int NVM = 8;
    const bf16* P; bf16* MMo; float gs;
    __device__ __forceinline__ void operator()(const f32x4 (&acc)[2][2][4][2], const Unit& u, int wr, int wc, int fr, int fq) const {
        const int col = (u.ocol >> 2) + wc * 16 + 4 * fq;
#pragma unroll
        for (int ai = 0; ai < 2; ++ai) {
            u32x2 pw[4][4];
#pragma unroll
            for (int m = 0; m < 4; ++m) { const size_t row = (size_t)(u.orow + ai * HALF + wr * 64 + m * 16 + fr);
#pragma unroll
                for (int i = 0; i < 4; ++i) pw[m][i] = *(const u32x2*)(P + p_index(row, i, col)); }
#pragma unroll
            for (int m = 0; m < 4; ++m) { const size_t row = (size_t)(u.orow + ai * HALF + wr * 64 + m * 16 + fr);
                f32x2 s01 = (f32x2){0.f, 0.f}, s23 = s01; const float kc = -1.4426950408889634f * gs;
#pragma unroll
                for (int i = 0; i < 4; ++i) { const f32x4 g = acc[ai][i >> 1][m][i & 1];
                    f32x2 d01 = (f32x2){__builtin_amdgcn_exp2f(g[0] * kc), __builtin_amdgcn_exp2f(g[1] * kc)}, d23 = (f32x2){__builtin_amdgcn_exp2f(g[2] * kc), __builtin_amdgcn_exp2f(g[3] * kc)};
                    d01 = d01 + 1.0f; d23 = d23 + 1.0f;
                    const f32x2 r01 = (f32x2){__builtin_amdgcn_rcpf(d01[0]), __builtin_amdgcn_rcpf(d01[1])}, r23 = (f32x2){__builtin_amdgcn_rcpf(d23[0]), __builtin_amdgcn_rcpf(d23[1])};
                    const f32x2 p01 = (f32x2){bflo(pw[m][i].x), bfhi(pw[m][i].x)}, p23 = (f32x2){bflo(pw[m][i].y), bfhi(pw[m][i].y)};
                    s01 = r01 * p01 + s01; s23 = r23 * p23 + s23; }
                f32x4 s; s[0] = s01[0]; s[1] = s01[1]; s[2] = s23[0]; s[3] = s23[1];
                u32x2 w; w.x = cvt_pk_bf16(s[0], s[1]); w.y = cvt_pk_bf16(s[2], s[3]);
                *(u32x2*)(MMo + row * D + col) = w; } }
    }
};
struct EpiSwiGLU {
    static constexpr int NVM = 8;
    bf16* O; int ldo; float gs; float o8;
    __device__ __forceinline__ void operator()(const f32x4 (&acc)[2][2][4][2], const Unit& u, int wr, int wc, int fr, int fq) const {
#pragma unroll
        for (int ai = 0; ai < 2; ++ai)
#pragma unroll
            for (int m = 0; m < 4; ++m) { bf16* rowp = O + (size_t)(u.orow + ai * HALF + wr * 64 + m * 16 + fr) * ldo + u.ocol + wc * 32 + 8 * fq;
                f32x4 v0, v1;
                { const float kc = -1.4426950408889634f * gs, g2 = gs * gs;
                  const f32x4 ga = acc[ai][0][m][0], gb = acc[ai][0][m][1], ua = acc[ai][1][m][0], ub = acc[ai][1][m][1];
                  f32x4 da, db;
#pragma unroll
                  for (int j = 0; j < 4; ++j) { da[j] = __builtin_amdgcn_exp2f(ga[j] * kc); db[j] = __builtin_amdgcn_exp2f(gb[j] * kc); }
                  da = da + 1.0f; db = db + 1.0f;
#pragma unroll
                  for (int j = 0; j < 4; ++j) { da[j] = __builtin_amdgcn_rcpf(da[j]); db[j] = __builtin_amdgcn_rcpf(db[j]); }
                  v0 = (ga * ua) * (da * g2); v1 = (gb * ub) * (db * g2); }
                if (o8 > 0.f) { u32x2 w; w.x = pk4_fp8(v0[0] * o8, v0[1] * o8, v0[2] * o8, v0[3] * o8); w.y = pk4_fp8(v1[0] * o8, v1[1] * o8, v1[2] * o8, v1[3] * o8);
                    *(u32x2*)((unsigned char*)O + (size_t)(u.orow + ai * HALF + wr * 64 + m * 16 + fr) * ldo + u.ocol + wc * 32 + 8 * fq) = w; }
                else { u32x4 w; w.x = cvt_pk_bf16(v0[0], v0[1]); w.y = cvt_pk_bf16(v0[2], v0[3]); w.z = cvt_pk_bf16(v1[0], v1[1]); w.w = cvt_pk_bf16(v1[2], v1[3]);
                    *(u32x4*)rowp = w; } }
    }
};
struct EpiScale {
    static constexpr int NVM = 16;
    bf16* O; int ldo; float gs;
    __device__ __forceinline__ void operator()(const f32x4 (&acc)[2][2][4][2], const Unit& u, int wr, int wc, int fr, int fq) const {
#pragma unroll
        for (int ai = 0; ai < 2; ++ai)
#pragma unroll
            for (int m = 0; m < 4; ++m) { bf16* rowp = O + (size_t)(u.orow + ai * HALF + wr * 64 + m * 16 + fr) * ldo + u.ocol + wc * 32 + 8 * fq;
#pragma unroll
                for (int bj = 0; bj < 2; ++bj) { const f32x4 v0 = acc[ai][bj][m][0] * gs, v1 = acc[ai][bj][m][1] * gs;
                    u32x4 w; w.x = cvt_pk_bf16(v0[0], v0[1]); w.y = cvt_pk_bf16(v0[2], v0[3]); w.z = cvt_pk_bf16(v1[0], v1[1]); w.w = cvt_pk_bf16(v1[2], v1[3]);
                    *(u32x4*)(rowp + bj * HALF) = w; } }
    }
};
template <int KIND> struct Sched {
    GridOrder go; int bp0, p0; const int* pe;
    __device__ __forceinline__ bool next(int i, Unit& u) const {
        int pm, pn; if (!go.mn(i, pm, pn)) return false;
        u.akb = 0;
        if (KIND == 0) { u.ap = pm; u.bp = bp0 + pn; u.orow = pm * BM; u.ocol = pn * BM; }
        else if (KIND == 4) { const int i = pn & 3, cp = pn >> 2; u.ap = pm; u.bp = i * 4 + cp; u.orow = pm * BM; u.ocol = i * 1024 + cp * BM; u.akb = i * 512; }
        else if (KIND == 1) { u.ap = pm; u.bp = pn; u.orow = pn * 2048 + pm * BM; u.ocol = 512; }
        else if (KIND == 2) { const int e = pe ? pe[p0 + pm] : 0; u.ap = p0 + pm; u.bp = e * 44 + pn; u.orow = pm * BM; u.ocol = pn * HALF; }
        else { const int e = pe ? pe[p0 + pm] : 0; u.ap = pm; u.bp = e * bp0 + pn; u.orow = (p0 + pm) * BM; u.ocol = pn * BM; }
        return true;
    }
};
}

__device__ __forceinline__ int gate_row(int i, int cc) { return 256 * (cc >> 6) + 128 * (i >> 1) + 32 * ((cc >> 4) & 3) + 8 * ((cc >> 2) & 3) + 4 * (i & 1) + (cc & 3); }
__device__ __forceinline__ void xpose_item(const float* W, int ldw, int k0, int n0, bf16* WT, int ldk, int drow0, LAS float* scr, int lane, int gate_i = -1) {
#pragma unroll 8
    for (int i = 0; i < 32; ++i) { const int kk = 2 * i + (lane >> 5); scr[kk * 33 + (lane & 31)] = W[(size_t)(k0 + kk) * ldw + n0 + (lane & 31)]; }
    asm volatile("s_waitcnt lgkmcnt(0)" ::: "memory");
    const int c = lane & 7;
#pragma unroll
    for (int j = 0; j < 4; ++j) { const int n = (lane >> 3) + 8 * j; const LAS float* s = scr + (8 * c) * 33 + n;
        u32x4 o; o.x = pk2(s[0 * 33], s[1 * 33]); o.y = pk2(s[2 * 33], s[3 * 33]); o.z = pk2(s[4 * 33], s[5 * 33]); o.w = pk2(s[6 * 33], s[7 * 33]);
        const int drow = gate_i < 0 ? drow0 + n : drow0 + gate_row(gate_i, n0 + n);
        *(u32x4*)(WT + (size_t)drow * ldk + k0 + 8 * c) = o; }
    asm volatile("s_waitcnt lgkmcnt(0)" ::: "memory");
}
__device__ __forceinline__ void xpose_item_fp8(const float* W, int ldw, int k0, int n0, unsigned char* WT, int ldk, LAS float* scr, int lane, int gate_i, float scale, int drow0 = 0) {
#pragma unroll 8
    for (int i = 0; i < 32; ++i) { const int kk = 2 * i + (lane >> 5); scr[kk * 33 + (lane & 31)] = W[(size_t)(k0 + kk) * ldw + n0 + (lane & 31)]; }
    asm volatile("s_waitcnt lgkmcnt(0)" ::: "memory");
    const int c = lane & 7;
#pragma unroll
    for (int j = 0; j < 4; ++j) { const int n = (lane >> 3) + 8 * j; const LAS float* s = scr + (8 * c) * 33 + n;
        u32x2 o; o.x = pk4_fp8(s[0 * 33] * scale, s[1 * 33] * scale, s[2 * 33] * scale, s[3 * 33] * scale); o.y = pk4_fp8(s[4 * 33] * scale, s[5 * 33] * scale, s[6 * 33] * scale, s[7 * 33] * scale);
        const int drow = gate_i < 0 ? drow0 + n : gate_row(gate_i, n0 + n);
        *(u32x2*)(WT + (size_t)drow * ldk + k0 + 8 * c) = o; }
    asm volatile("s_waitcnt lgkmcnt(0)" ::: "memory");
}
__device__ __forceinline__ void xpose_dispatch(const Ctx& C, int it, LAS float* scr) {
    const float* const* in = oin(C.in_); const int lane = otid() & 63;
    if (it < 4 * 768) { const int l = it / 768, r = it % 768, part = r / 384, q = r % 384, kb = q / 24, nb = q % 24;
        const int n0 = (part ? 1056 : 0) + nb * 32, drow = (part ? 1280 : 0) + nb * 32;
        xpose_item(in[6] + (size_t)l * D * NIN, NIN, kb * 64, n0, wW(C, WE_WIN + (size_t)l * 6144 * 1024), 1024, drow, scr, lane); return; }
    it -= 4 * 768;
    if (it < 16 * 512) { const int li = it / 512, q = it % 512, kb = q / 32, nb = q % 32, l = li >> 2, i = li & 3;
        xpose_item_fp8(in[16] + (size_t)li * D * D, D, kb * 64, nb * 32, ows(C.ws_) + WS_G8 + (size_t)l * 4096 * 1024, 1024, scr, lane, i, G8_SCALE); return; }
    it -= 16 * 512;
    if (it < 16 * 128) { const int li = it / 128, q = it % 128, kb = q / 32, nb = q % 32;
        xpose_item(in[17] + (size_t)li * 256 * D, D, kb * 64, nb * 32, wW(C, WE_WBR + (size_t)li * 1024 * 256), 256, nb * 32, scr, lane); return; }
    it -= 16 * 128;
    if (it < 4 * 512) { const int l = it / 512, q = it % 512, kb = q / 32, nb = q % 32;
        xpose_item(in[18] + (size_t)l * D * D, D, kb * 64, nb * 32, wW(C, WE_WO + (size_t)l * D * D), 1024, nb * 32, scr, lane); return; }
    it -= 4 * 512;
    if (it < 4 * 1408) { const int jw = it / 1408, q = it % 1408, kb = q / 88, nb = q % 88, j = jw >> 1, which = jw & 1, n0 = nb * 32;
        xpose_item_fp8(in[which ? 22 : 21] + (size_t)j * D * DFF, DFF, kb * 64, n0, (unsigned char*)wW(C, WE_GUD + (size_t)j * 5632 * 1024), 1024, scr, lane, -1, G8_SCALE, (n0 >> 7) * 256 + which * 128 + (n0 & 127)); return; }
    it -= 4 * 1408;
    if (it < 2 * 1408) { const int j = it / 1408, q = it % 1408, kb = q / 32, nb = q % 32;
        if (DOWN8_DENSE) xpose_item_fp8(in[23] + (size_t)j * DFF * D, D, kb * 64, nb * 32, (unsigned char*)wW(C, WE_DD + (size_t)j * 1024 * 2816), 2816, scr, lane, -1, G8_SCALE, nb * 32);
        else xpose_item(in[23] + (size_t)j * DFF * D, D, kb * 64, nb * 32, wW(C, WE_DD + (size_t)j * 1024 * 2816), 2816, nb * 32, scr, lane); return; }
    it -= 2 * 1408;
    (void)it;
}
constexpr int XPE_GU = 16 * 1408, XPE_ALL = 24 * 1408;
constexpr bool DEFER_EXPERT_CONV = false;
__device__ __forceinline__ void xpose_expert(const Ctx& C, int jm, int idx, LAS float* scr, int lane) {
    const float* const* in = oin(C.in_);
    if (idx < XPE_GU) { const int ew = idx / 1408, q = idx % 1408, kb = q / 88, nb = q % 88, e = ew >> 1, which = ew & 1, n0 = nb * 32, je = jm * 8 + e;
        xpose_item_fp8(in[which ? 26 : 25] + (size_t)je * D * DFF, DFF, kb * 64, n0, (unsigned char*)wW(C, WE_GUE + (size_t)je * 5632 * 1024), 1024, scr, lane, -1, G8_SCALE, (n0 >> 7) * 256 + which * 128 + (n0 & 127)); }
    else { const int i2 = idx - XPE_GU, e = i2 / 1408, q = i2 % 1408, kb = q / 32, nb = q % 32, je = jm * 8 + e;
        if (DOWN8_MOE) xpose_item_fp8(in[27] + (size_t)je * DFF * D, D, kb * 64, nb * 32, (unsigned char*)wW(C, WE_DE + (size_t)je * 1024 * 2816), 2816, scr, lane, -1, G8_SCALE, nb * 32);
        else xpose_item(in[27] + (size_t)je * DFF * D, D, kb * 64, nb * 32, wW(C, WE_DE + (size_t)je * 1024 * 2816), 2816, nb * 32, scr, lane); }
}
__device__ __forceinline__ void expert_convert_share(const Ctx& C, int jm, int i0, int i1, int first_blk) {
    const int blk = oblk(); if (blk < first_blk) return;
    const int wave = owave(), lane = otid() & 63; LAS float* scr = (LAS float*)(C.lds + wave * 16384);
    const int nw = (ogrid() - first_blk) * NWAVE;
    for (int idx = i0 + (blk - first_blk) * NWAVE + wave; idx < i1; idx += nw) xpose_expert(C, jm, idx, scr, lane);
}
constexpr int XPOSE_ITEMS = 4 * 768 + 16 * 512 + 16 * 128 + 4 * 512 + 4 * 1408 + 2 * 1408;

__device__ __forceinline__ void p_prologue(const Ctx& C) {
    const float* const* in = oin(C.in_); const int tid = otid();
    { LAS float* scr = (LAS float*)(C.lds + owave() * 16384);
      const int gw = oblk() * NWAVE + owave(), NGW = ogrid() * NWAVE;
      for (int it = gw; it < XPOSE_ITEMS; it += NGW) xpose_dispatch(C, it, scr);
      if (!DEFER_EXPERT_CONV) for (int it = gw; it < 2 * XPE_ALL; it += NGW) xpose_expert(C, it / XPE_ALL, it % XPE_ALL, scr, otid() & 63); }
    { const size_t gt = (size_t)oblk() * NTHR + tid, NT = (size_t)ogrid() * NTHR;
      for (size_t o = gt; o < (size_t)4 * 512 * 1024; o += NT) {
          const int l = (int)(o >> 19), n = (int)((o >> 10) & 511), k = (int)(o & 1023);
          const float* wi = in[6] + ((size_t)l * D + k) * NIN; float s = 0.f;
          if (n < 256) { const int dir = n >> 7, nn = n & 127; const float* w2 = in[7] + ((size_t)(l * 2 + dir) * 16) * 128 + nn;
              for (int c = 0; c < 16; ++c) s += wi[768 + 16 * dir + c] * w2[c * 128]; }
          else { const int nn = n - 256, gi = nn >> 6, d = nn & 63; const float* pw = in[10] + ((size_t)(l * 4 + gi) * 64) * 64 + d;
              for (int c = 0; c < 64; ++c) s += wi[800 + 64 * gi + c] * pw[c * 64]; }
          wW(C, WE_WIN + (size_t)l * 6144 * 1024)[(size_t)(768 + n) * 1024 + k] = (bf16)f2bf(s);
      } }
    { const size_t gt = (size_t)oblk() * NTHR + tid, NT = (size_t)ogrid() * NTHR;
      { int* idt = (int*)(ows(C.ws_) + WS_ROUTE) + RT_IDT; for (size_t o = gt; o < (size_t)M; o += NT) idt[o] = (int)o; }
      { bf16* sw = wsb(C, WS_SGUW); const float* src = in[14]; for (size_t o = gt; o < (size_t)4 * 4 * 128 * 128; o += NT) sw[o] = (bf16)f2bf(src[o]); }
      { bf16* TF1 = wsb(C, WS_TF1); bf16* TF2 = wsb(C, WS_TF2); float* TW = (float*)(ows(C.ws_) + WS_TW); const float sc = 0.0027621358640099515f;
        for (size_t o = gt; o < (size_t)4 * 2 * 64 * 8; o += NT) { const int x = (int)(o & 7), lane = (int)((o >> 3) & 63), ks = (int)((o >> 9) & 1), ct = (int)(o >> 10), lr = lane & 15, lq = lane >> 4;
            const int po = ct >> 1, c = 16 * (ct & 1) + lr, a = 8 * lq + x; float sn, cs; sincospif((float)((c * a) & 31) * (1.0f / 16.0f), &sn, &cs);
            const float v = po == 0 ? (ks == 0 ? cs : sn) : (ks == 0 ? -sn : cs); TF1[o] = (bf16)f2bf(v); }
        for (size_t o = gt; o < (size_t)2 * 4 * 2 * 64 * 8; o += NT) { const int x = (int)(o & 7), lane = (int)((o >> 3) & 63), ks = (int)((o >> 9) & 1), dt = (int)((o >> 10) & 3), part = (int)(o >> 12), lr = lane & 15, lq = lane >> 4;
            const int d = 16 * dt + lr, bb = 32 * ks + (x < 4 ? 4 * lq + x : 16 + 4 * lq + (x - 4)); float sn, cs; sincospif((float)((d * bb) & 63) * (1.0f / 32.0f), &sn, &cs);
            TF2[o] = (bf16)f2bf((part == 0 ? cs : sn) * sc); }
        for (size_t o = gt; o < (size_t)4 * 2 * 4 * 64; o += NT) { const int lane = (int)(o & 63), r = (int)((o >> 6) & 3), ct = (int)((o >> 8) & 1), rt = (int)(o >> 9), lr = lane & 15, lq = lane >> 4;
            const int bb = 16 * rt + 4 * lq + r, c = 16 * ct + lr; float sn, cs; sincospif((float)(c * bb) * (1.0f / 1024.0f), &sn, &cs); TW[2 * o] = cs; TW[2 * o + 1] = sn; } }
      bf16* DLC = wsb(C, WS_DLC);
      for (size_t o = gt; o < (size_t)256 * 512; o += NT) { const int k = (int)(o >> 9), kk = (int)(o & 511), t = kk & 255; const int idx = (k * t) & 255; float sn, cs; sincospif((float)idx * (1.0f / 128.0f), &sn, &cs);
          DLC[o] = (bf16)f2bf((kk < 256 ? cs : sn) * 0.0078125f); }
      bf16* CS = wsb(C, WS_CS64);
      for (size_t o = gt; o < (size_t)128 * 64; o += NT) { const int pm = (int)(o >> 6), c = (int)(o & 63), m = pm & 63; const int idx = (m * c) & 63; float sn, cs; sincospif((float)idx * (1.0f / 32.0f), &sn, &cs);
          CS[o] = (bf16)f2bf(pm < 64 ? cs : -sn); } }
    __syncthreads();
    { LAS float* S = (LAS float*)C.lds;
      LAS float* RED = (LAS float*)(C.lds + 17 * 1024 * 4);
      for (int i = tid; i < 17 * 1024; i += NTHR) { const int r = i >> 10, k = i & 1023; const float v = r < 16 ? in[1][r * 1024 + k] : in[3][k]; S[i] = siluf_(v); }
      __syncthreads();
      for (int it = oblk(); it < 4 * 96; it += ogrid()) {
          const int l = it / 96, jb = it % 96, j = tid & 63, kg = tid >> 6;
          float acc[17];
#pragma unroll
          for (int r = 0; r < 17; ++r) acc[r] = 0.f;
          const float* wp = in[4] + ((size_t)l * D + kg * 128) * 6144 + jb * 64 + j;
          for (int kk = 0; kk < 128; ++kk) { const float w = wp[(size_t)kk * 6144];
#pragma unroll
              for (int r = 0; r < 17; ++r) acc[r] += S[r * 1024 + kg * 128 + kk] * w; }
#pragma unroll
          for (int r = 0; r < 17; ++r) RED[(kg * 17 + r) * 64 + j] = acc[r];
          __syncthreads();
          for (int o = tid; o < 17 * 64; o += NTHR) { const int r = o >> 6, jj = o & 63; float s = 0.f;
              for (int g = 0; g < 8; ++g) s += RED[(g * 17 + r) * 64 + jj];
              ((float*)(ows(C.ws_) + WS_MOD))[(size_t)(l * 17 + r) * 6144 + jb * 64 + jj] = s + in[5][(size_t)l * 6144 + jb * 64 + jj]; }
          __syncthreads();
      } }
}

struct RowV { f32x4 v[4]; };
__device__ __forceinline__ void row_ln(RowV& x, int  ) {
    float s = 0.f;
#pragma unroll
    for (int j = 0; j < 4; ++j) s += (x.v[j][0] + x.v[j][1]) + (x.v[j][2] + x.v[j][3]);
    const float mean = wave_sum(s) * (1.f / D); float q = 0.f;
#pragma unroll
    for (int j = 0; j < 4; ++j) { x.v[j] = x.v[j] - mean; q += (x.v[j][0] * x.v[j][0] + x.v[j][1] * x.v[j][1]) + (x.v[j][2] * x.v[j][2] + x.v[j][3] * x.v[j][3]); }
    const float rstd = __builtin_amdgcn_rsqf(wave_sum(q) * (1.f / D) + EPS);
#pragma unroll
    for (int j = 0; j < 4; ++j) x.v[j] = x.v[j] * rstd;
}
__device__ __forceinline__ void row_load_f32(RowV& x, const float* p, int lane) {
#pragma unroll
    for (int j = 0; j < 4; ++j) x.v[j] = *(const f32x4*)(p + 4 * lane + 256 * j);
}
__device__ __forceinline__ void row_load_bf16(RowV& x, const bf16* p, int lane) {
#pragma unroll
    for (int j = 0; j < 4; ++j) { const u32x2 w = *(const u32x2*)(p + 4 * lane + 256 * j); x.v[j] = (f32x4){bflo(w.x), bfhi(w.x), bflo(w.y), bfhi(w.y)}; }
}
__device__ __forceinline__ void row_store_f32(const RowV& x, float* p, int lane) {
#pragma unroll
    for (int j = 0; j < 4; ++j) *(f32x4*)(p + 4 * lane + 256 * j) = x.v[j];
}
__device__ __forceinline__ void row_store_fp8(const RowV& x, unsigned char* p, int lane) {
#pragma unroll
    for (int j = 0; j < 4; ++j) { int w = 0; w = __builtin_amdgcn_cvt_pk_fp8_f32(x.v[j][0], x.v[j][1], w, false); w = __builtin_amdgcn_cvt_pk_fp8_f32(x.v[j][2], x.v[j][3], w, true); *(int*)(p + 4 * lane + 256 * j) = w; }
}
__device__ __forceinline__ void row_store_bf16(const RowV& x, bf16* p, int lane) {
#pragma unroll
    for (int j = 0; j < 4; ++j) { u32x2 w; w.x = pk2(x.v[j][0], x.v[j][1]); w.y = pk2(x.v[j][2], x.v[j][3]); *(u32x2*)(p + 4 * lane + 256 * j) = w; }
}
__device__ __forceinline__ void row_mod(RowV& x, const float* shift, const float* scale, int lane) {
#pragma unroll
    for (int j = 0; j < 4; ++j) { const f32x4 sh = *(const f32x4*)(shift + 4 * lane + 256 * j), sc = *(const f32x4*)(scale + 4 * lane + 256 * j); x.v[j] = x.v[j] * (sc + 1.0f) + sh; }
}
__device__ __forceinline__ void row_affine(RowV& x, const float* g, const float* b, int lane) {
#pragma unroll
    for (int j = 0; j < 4; ++j) { const f32x4 gg = *(const f32x4*)(g + 4 * lane + 256 * j), bb = *(const f32x4*)(b + 4 * lane + 256 * j); x.v[j] = x.v[j] * gg + bb; }
}
__device__ __forceinline__ void row_mod_v(RowV& x, const RowV& shift, const RowV& scale) {
#pragma unroll
    for (int j = 0; j < 4; ++j) x.v[j] = x.v[j] * (scale.v[j] + 1.0f) + shift.v[j];
}
__device__ __forceinline__ void row_affine_v(RowV& x, const RowV& g, const RowV& b) {
#pragma unroll
    for (int j = 0; j < 4; ++j) x.v[j] = x.v[j] * g.v[j] + b.v[j];
}
__device__ __forceinline__ float* xrow(const Ctx& C, int m) { return m < MLAT ? oout(C.out_) + (size_t)m * D : (float*)(ows(C.ws_) + WS_XC) + (size_t)(m - MLAT) * D; }
__device__ __forceinline__ bf16* hbuf(const Ctx& C) { return XBF16 ? (bf16*)oout(C.out_) : wsb(C, WS_H); }
__device__ __forceinline__ unsigned char* h8buf(const Ctx& C) { return (unsigned char*)oout(C.out_) + OUT_H8; }
__device__ __forceinline__ const float* x0row(const Ctx& C, int m) { return m < MLAT ? oin(C.in_)[0] + (size_t)m * D : oin(C.in_)[2] + (size_t)(m - MLAT) * D; }

typedef _Float16 h16x2 __attribute__((ext_vector_type(2)));
struct XRaw { f32x4 f[4]; u32x2 h[4]; };
__device__ __forceinline__ void xraw_load(XRaw& R, const Ctx& C, int m, int lane, bool from_input) {
    if (from_input || !XBF16) { const float* p = from_input ? x0row(C, m) : xrow(C, m);
#pragma unroll
        for (int j = 0; j < 4; ++j) R.f[j] = *(const f32x4*)(p + 4 * lane + 256 * j); }
    else { const bf16* p = wsb(C, WS_H) + (size_t)m * D;
#pragma unroll
        for (int j = 0; j < 4; ++j) R.h[j] = *(const u32x2*)(p + 4 * lane + 256 * j); }
}
__device__ __forceinline__ void xraw_get(RowV& x, const XRaw& R, bool from_input) {
    if (from_input || !XBF16) {
#pragma unroll
        for (int j = 0; j < 4; ++j) x.v[j] = R.f[j]; }
    else {
#pragma unroll
        for (int j = 0; j < 4; ++j) { const unsigned wx = R.h[j].x, wy = R.h[j].y;
            const h16x2 a = __builtin_bit_cast(h16x2, wx), b = __builtin_bit_cast(h16x2, wy); x.v[j] = (f32x4){(float)a[0], (float)a[1], (float)b[0], (float)b[1]}; } }
}
__device__ __forceinline__ void yraw_load(u32x2 (&y)[4], const bf16* p, int lane) {
#pragma unroll
    for (int j = 0; j < 4; ++j) y[j] = *(const u32x2*)(p + 4 * lane + 256 * j);
}
__device__ __forceinline__ void yraw_get(RowV& y, const u32x2 (&w)[4]) {
#pragma unroll
    for (int j = 0; j < 4; ++j) y.v[j] = (f32x4){bflo(w[j].x), bfhi(w[j].x), bflo(w[j].y), bfhi(w[j].y)};
}
__device__ __forceinline__ void x_store(const RowV& x, const Ctx& C, int m, int lane) {
    if (XBF16) { bf16* p = wsb(C, WS_H) + (size_t)m * D;
#pragma unroll
        for (int j = 0; j < 4; ++j) { h16x2 a, b; a[0] = (_Float16)x.v[j][0]; a[1] = (_Float16)x.v[j][1]; b[0] = (_Float16)x.v[j][2]; b[1] = (_Float16)x.v[j][3];
            u32x2 w; w.x = __builtin_bit_cast(unsigned, a); w.y = __builtin_bit_cast(unsigned, b); *(u32x2*)(p + 4 * lane + 256 * j) = w; } }
    else row_store_f32(x, xrow(C, m), lane);
}
__device__ __forceinline__ void p_lna(const Ctx& C) {
    const int tid = otid(), lane = tid & 63, wave = owave();
    bf16* H = hbuf(C); const int rpb = M / 256; RowV shv, scv; int rcur = -1;
    const int nrow = rpb / NWAVE, jb = (nrow - 1) * 256 + ovr(C) * NWAVE + wave;
    RowV xn; row_load_f32(xn, x0row(C, lrow(C, jb)), lane);
    for (int k = 0; k < nrow; ++k) { const int m = lrow(C, jb - k * 256), r = row_r(m);
        if (r != rcur) { row_load_f32(shv, modv(C, 0, r, 0), lane); row_load_f32(scv, modv(C, 0, r, 1), lane); rcur = r; }
        RowV x = xn; if (k + 1 < nrow) row_load_f32(xn, x0row(C, lrow(C, jb - (k + 1) * 256)), lane);
        row_ln(x, lane); row_mod_v(x, shv, scv);
        row_store_bf16(x, H + (size_t)m * D, lane); row_store_fp8(x, h8buf(C) + (size_t)m * D, lane);
    }
}
__device__ __forceinline__ void p_lnb(const Ctx& C, int l, int mrows, bool dry = false) {
    const int tid = otid(), lane = tid & 63;
    bf16* H = dry ? wsb(C, WS_R + R_BIG + 152 * MiB) : hbuf(C); const bf16* Y = wsb(C, WS_R + R_YS);
    const bool moe = (l & 1); const int jm = l >> 1;
    const int rpb = mrows / 256;
    LAS float* WR = (LAS float*)C.lds;
    LAS int* LC = (LAS int*)(C.lds + 32768);
    int* rt = (int*)(ows(C.ws_) + WS_ROUTE);
    if (moe) {
        for (int i = tid; i < 8 * 1024; i += NTHR) { const int e = i >> 10, k = i & 1023; WR[i] = oin(C.in_)[24][((size_t)jm * D + k) * NE + e]; }
        if (tid < 8) LC[tid] = 0;
        __syncthreads();
    }
    RowV g2v, shv, scv, lgv, lbv; int rcur = -1;
    row_load_f32(lgv, oin(C.in_)[19] + (size_t)(l * 2 + 0) * D, lane); row_load_f32(lbv, oin(C.in_)[20] + (size_t)(l * 2 + 0) * D, lane);
    const int w0 = owave(), nrow = rpb / NWAVE, jb = ovr(C) * NWAVE + w0, mb = lrow(C, jb); const bool fin = (l == 0);
    XRaw xa; u32x2 ya[4];
    xraw_load(xa, C, mb, lane, fin); yraw_load(ya, Y + (size_t)mb * D, lane);
    XRaw xb = xa; u32x2 yb[4] = {ya[0], ya[1], ya[2], ya[3]};
    for (int k = 0; k < nrow; ++k) {
        const int m = lrow(C, jb + k * 256), mn = lrow(C, k + 1 < nrow ? jb + (k + 1) * 256 : jb), r = row_r(m);
        if (k + 1 < nrow) { xraw_load(xb, C, mn, lane, fin); yraw_load(yb, Y + (size_t)mn * D, lane); }
        if (r != rcur) { row_load_f32(g2v, modv(C, l, r, 2), lane); row_load_f32(shv, modv(C, l, r, 3), lane); row_load_f32(scv, modv(C, l, r, 4), lane); rcur = r; }
        RowV x, y; xraw_get(x, xa, fin); yraw_get(y, ya);
#pragma unroll
        for (int j = 0; j < 4; ++j) x.v[j] = x.v[j] * ALPHA + g2v.v[j] * y.v[j];
        row_ln(x, lane); row_affine_v(x, lgv, lbv);
        if (dry) row_store_f32(x, (float*)(ows(C.ws_) + WS_R + R_BIG) + (size_t)m * D, lane); else x_store(x, C, m, lane);
        row_ln(x, lane); row_mod_v(x, shv, scv);
        row_store_fp8(x, (dry ? (unsigned char*)H : h8buf(C)) + (size_t)m * D, lane);
        if (moe) {
            float lg[8];
#pragma unroll
            for (int e = 0; e < 8; ++e) { float s = 0.f;
#pragma unroll
                for (int j = 0; j < 4; ++j) { const f32x4 w = *(const LAS f32x4*)(WR + e * 1024 + 4 * lane + 256 * j); s += (x.v[j][0] * w[0] + x.v[j][1] * w[1]) + (x.v[j][2] * w[2] + x.v[j][3] * w[3]); }
                lg[e] = wave_sum(s); }
            if (lane == 0 && !dry) {
                int e1 = 0; float v1 = lg[0];
#pragma unroll
                for (int e = 1; e < 8; ++e) if (lg[e] > v1) { v1 = lg[e]; e1 = e; }
                int e2 = -1; float v2 = -3.0e38f;
#pragma unroll
                for (int e = 0; e < 8; ++e) if (e != e1 && lg[e] > v2) { v2 = lg[e]; e2 = e; }
                const float w1 = 1.0f / (1.0f + __expf(v2 - v1)), w2 = 1.0f - w1;
                const int r1 = __hip_atomic_fetch_add(&LC[e1], 1, __ATOMIC_RELAXED, __HIP_MEMORY_SCOPE_WORKGROUP), r2 = __hip_atomic_fetch_add(&LC[e2], 1, __ATOMIC_RELAXED, __HIP_MEMORY_SCOPE_WORKGROUP);
                rt[RT_TOKE + (size_t)m * 2] = e1; rt[RT_TOKE + (size_t)m * 2 + 1] = e2;
                rt[RT_TOKR + (size_t)m * 2] = r1; rt[RT_TOKR + (size_t)m * 2 + 1] = r2;
                ((float*)rt)[RT_TOKW + (size_t)m * 2] = w1; ((float*)rt)[RT_TOKW + (size_t)m * 2 + 1] = w2;
            }
        }
        asm volatile("" ::: "memory");
        xa = xb;
#pragma unroll
        for (int j = 0; j < 4; ++j) ya[j] = yb[j];
    }
    if (moe && !dry) {
        __syncthreads();
        if (tid < 8) { unsigned* cnt = (unsigned*)(ows(C.ws_) + WS_CTL) + CW_CNT + (jm * 8 + tid) * 64;
            const unsigned base = __hip_atomic_fetch_add(cnt, (unsigned)LC[tid], __ATOMIC_RELAXED, __HIP_MEMORY_SCOPE_AGENT);
            rt[RT_BLK + (ovx(C) * 32 + ovr(C)) * 8 + tid] = (int)base; }
    }
}
struct RouteInfo { int base[9]; int cnt[8]; int npanels; };
__device__ __forceinline__ void route_info(const Ctx& C, int jm, RouteInfo& R) {
    unsigned* cnt = (unsigned*)(ows(C.ws_) + WS_CTL) + CW_CNT; int b = 0;
#pragma unroll
    for (int e = 0; e < 8; ++e) { const int c = (int)__hip_atomic_load(cnt + (jm * 8 + e) * 64, __ATOMIC_RELAXED, __HIP_MEMORY_SCOPE_AGENT); R.cnt[e] = c; R.base[e] = b; b += ((c + 255) >> 8) << 8; }
    R.base[8] = b; R.npanels = b >> 8;
}
__device__ __forceinline__ void p_route_build(const Ctx& C, int l, int mrows) {
    const int tid = otid();
    const int jm = l >> 1; RouteInfo R; route_info(C, jm, R);
    int* rt = (int*)(ows(C.ws_) + WS_ROUTE); const int rpb = mrows / 256;
    const int gt = oblk() * NTHR + tid, NT = ogrid() * NTHR;
    for (int i = gt; i < mrows * 2; i += NT) { const int m = i >> 1, e = rt[RT_TOKE + i], blk = (m < MLAT ? (m >> 12) : ((m - MLAT) >> 9)) * 32 + ((m & 255) >> 3);
        int be = 0;
#pragma unroll
        for (int q = 0; q < 8; ++q) be = (q == e) ? R.base[q] : be;
        const int slot = be + rt[RT_BLK + blk * 8 + e] + rt[RT_TOKR + i];
        rt[RT_TOKS + i] = slot; rt[RT_S2T + slot] = m; }
    for (int s = gt; s < R.base[8]; s += NT) { int e = 0;
#pragma unroll
        for (int q = 1; q < 8; ++q) e = (s >= R.base[q]) ? q : e;
        int be = 0, ce = 0;
#pragma unroll
        for (int q = 0; q < 8; ++q) { be = (q == e) ? R.base[q] : be; ce = (q == e) ? R.cnt[q] : ce; }
        if (s >= be + ce) rt[RT_S2T + s] = 0;
        if ((s & 255) == 0) rt[RT_PE + (s >> 8)] = e; }
}
__device__ __forceinline__ void p_lnc(const Ctx& C, int l, int mrows, bool dry = false) {
    const int tid = otid(), lane = tid & 63, wave = owave();
    bf16* H = dry ? wsb(C, WS_R + 350 * MiB) : hbuf(C); const bf16* Y2 = wsb(C, WS_R + R_Y2);
    const bool moe = (l & 1); const int* rt = (const int*)(ows(C.ws_) + WS_ROUTE); const int rpb = mrows / 256;
    RowV g5v, shv, scv, lgv, lbv; int rcur = -1;
    row_load_f32(lgv, oin(C.in_)[19] + (size_t)(l * 2 + 1) * D, lane); row_load_f32(lbv, oin(C.in_)[20] + (size_t)(l * 2 + 1) * D, lane);
    const int nrow = rpb / NWAVE, jb = (nrow - 1) * 256 + ovr(C) * NWAVE + wave, mb = lrow(C, jb);
    int sa1 = 0, sa2 = 0, sb1 = 0, sb2 = 0, sc1 = 0, sc2 = 0; float wa1 = 0.f, wa2 = 0.f, wb1 = 0.f, wb2 = 0.f, wc1 = 0.f, wc2 = 0.f;
    if (moe) { sa1 = rt[RT_TOKS + (size_t)mb * 2]; sa2 = rt[RT_TOKS + (size_t)mb * 2 + 1]; wa1 = ((const float*)rt)[RT_TOKW + (size_t)mb * 2]; wa2 = ((const float*)rt)[RT_TOKW + (size_t)mb * 2 + 1];
        if (nrow > 1) { const size_t q = (size_t)lrow(C, jb - 256) * 2; sb1 = rt[RT_TOKS + q]; sb2 = rt[RT_TOKS + q + 1]; wb1 = ((const float*)rt)[RT_TOKW + q]; wb2 = ((const float*)rt)[RT_TOKW + q + 1]; } }
    XRaw xa; u32x2 ya[4], za[4];
    xraw_load(xa, C, mb, lane, false); yraw_load(ya, Y2 + (size_t)(moe ? sa1 : mb) * D, lane); if (moe) yraw_load(za, Y2 + (size_t)sa2 * D, lane); else { za[0] = ya[0]; za[1] = ya[1]; za[2] = ya[2]; za[3] = ya[3]; }
    XRaw xb = xa; u32x2 yb[4] = {ya[0], ya[1], ya[2], ya[3]}, zb[4] = {za[0], za[1], za[2], za[3]};
    for (int k = 0; k < nrow; ++k) {
        const int m = lrow(C, jb - k * 256), mn = lrow(C, k + 1 < nrow ? jb - (k + 1) * 256 : jb), r = row_r(m);
        if (moe && k + 2 < nrow) { const size_t q = (size_t)lrow(C, jb - (k + 2) * 256) * 2; sc1 = rt[RT_TOKS + q]; sc2 = rt[RT_TOKS + q + 1]; wc1 = ((const float*)rt)[RT_TOKW + q]; wc2 = ((const float*)rt)[RT_TOKW + q + 1]; }
        if (k + 1 < nrow) { xraw_load(xb, C, mn, lane, false); yraw_load(yb, Y2 + (size_t)(moe ? sb1 : mn) * D, lane); if (moe) yraw_load(zb, Y2 + (size_t)sb2 * D, lane); }
        if (r != rcur) { row_load_f32(g5v, modv(C, l, r, 5), lane); if (l < DEPTH - 1) { row_load_f32(shv, modv(C, l + 1, r, 0), lane); row_load_f32(scv, modv(C, l + 1, r, 1), lane); } rcur = r; }
        RowV x, y; xraw_get(x, xa, false); yraw_get(y, ya);
        if (moe) { RowV y2; yraw_get(y2, za);
#pragma unroll
            for (int j = 0; j < 4; ++j) y.v[j] = y.v[j] * wa1 + y2.v[j] * wa2; }
#pragma unroll
        for (int j = 0; j < 4; ++j) x.v[j] = x.v[j] * ALPHA + g5v.v[j] * y.v[j];
        row_ln(x, lane); row_affine_v(x, lgv, lbv);
        if (dry) row_store_f32(x, (float*)(ows(C.ws_) + WS_R) + (size_t)m * D, lane); else if (l == DEPTH - 1) row_store_f32(x, oout(C.out_) + (size_t)m * D, lane); else x_store(x, C, m, lane);
        if (l < DEPTH - 1) { row_ln(x, lane); row_mod_v(x, shv, scv); row_store_bf16(x, H + (size_t)m * D, lane); row_store_fp8(x, h8buf(C) + (size_t)m * D, lane); }
        asm volatile("" ::: "memory");
        xa = xb; sa1 = sb1; sa2 = sb2; wa1 = wb1; wa2 = wb2; sb1 = sc1; sb2 = sc2; wb1 = wc1; wb2 = wc2;
#pragma unroll
        for (int j = 0; j < 4; ++j) { ya[j] = yb[j]; za[j] = zb[j]; }
    }
}

__device__ __forceinline__ f32x4 mm4(float a, float b, f32x4 c) { return __builtin_amdgcn_mfma_f32_16x16x4f32(a, b, c, 0, 0, 0); }
__device__ __forceinline__ int gla_row0(int b, int sc) { return sc < 4 ? MLAT + b * TC + sc * 64 : b * T + (sc - 4) * 64; }
constexpr int GL_VT = 0, GL_LA = 9216, GL_SEG = 26112, GL_QT = 28160, GL_KT = 36608, GL_KWT = 45056, GL_DC = 54272, GL_QE = 54528, GL_KE = 64768, GL_SPT = 75008, GL_AT = 85248, GL_RS = 103680;
__device__ __forceinline__ void gla_load_common(const bf16* cols, int m0, int h, LAS unsigned char* lds, int tid, bool with_q) {
    const int row = tid >> 3, seg = tid & 7; const bf16* rp = cols + (size_t)(m0 + row) * NINP;
    { const u32x4 w = *(const u32x4*)(rp + C_V + h * 64 + seg * 8); LAS bf16* vt = (LAS bf16*)(lds + GL_VT) + (seg * 8) * 72 + row;
      vt[0 * 72] = (bf16)(w.x & 0xffff); vt[1 * 72] = (bf16)(w.x >> 16); vt[2 * 72] = (bf16)(w.y & 0xffff); vt[3 * 72] = (bf16)(w.y >> 16);
      vt[4 * 72] = (bf16)(w.z & 0xffff); vt[5 * 72] = (bf16)(w.z >> 16); vt[6 * 72] = (bf16)(w.w & 0xffff); vt[7 * 72] = (bf16)(w.w >> 16); }
    const int s4 = seg & 3, dir = seg >> 2;
    { const u32x4 a = *(const u32x4*)(rp + (dir ? C_LAB : C_LAF) + h * 32 + s4 * 8); LAS float* d = (LAS float*)(lds + GL_LA) + (dir * 64 + row) * 33 + s4 * 8;
      d[0] = bflo(a.x); d[1] = bfhi(a.x); d[2] = bflo(a.y); d[3] = bfhi(a.y); d[4] = bflo(a.z); d[5] = bfhi(a.z); d[6] = bflo(a.w); d[7] = bfhi(a.w); }
    if (dir == 0 || with_q) { const u32x4 a = *(const u32x4*)(rp + (dir ? C_Q : C_K) + h * 32 + s4 * 8); LAS float* d = (LAS float*)(lds + (dir ? GL_QT : GL_KT)) + row * 33 + s4 * 8;
      d[0] = bflo(a.x); d[1] = bfhi(a.x); d[2] = bflo(a.y); d[3] = bfhi(a.y); d[4] = bflo(a.z); d[5] = bfhi(a.z); d[6] = bflo(a.w); d[7] = bfhi(a.w); }
}
__device__ __forceinline__ void gla1_item(const Ctx& C, int g) {
    const int b = g / 144, rem = g % 144, sc = rem >> 2, h = rem & 3, m0 = gla_row0(b, sc);
    const bf16* cols = wsb(C, WS_R + R_COLS); LAS unsigned char* lds = C.lds;
    const int tid = otid(), lane = tid & 63, w = owave(), lr = lane & 15, lq = lane >> 4;
    gla_load_common(cols, m0, h, lds, tid, false);
    __syncthreads();
    const int dir = tid >> 8, d = (tid >> 3) & 31, sg = tid & 7;
    LAS float* LA = (LAS float*)(lds + GL_LA) + dir * 64 * 33; LAS float* SEG = (LAS float*)(lds + GL_SEG) + (dir * 32 + d) * 8;
    float v[8], pre[8]; float run = 0.f;
#pragma unroll
    for (int x = 0; x < 8; ++x) { v[x] = LA[(sg * 8 + x) * 33 + d]; run += v[x]; pre[x] = run; }
    SEG[sg] = run;
    __syncthreads();
    { float off = 0.f, tot = 0.f;
#pragma unroll
      for (int s2 = 0; s2 < 8; ++s2) { const float t2 = SEG[s2]; tot += t2; off += (s2 < sg) ? t2 : 0.f; }
      const LAS float* KT = (const LAS float*)(lds + GL_KT);
      float kw[8];
#pragma unroll
      for (int x = 0; x < 8; ++x) { const float wt = dir == 0 ? __expf(tot - (off + pre[x])) : __expf(off + pre[x] - v[x]); kw[x] = KT[(sg * 8 + x) * 33 + d] * wt; }
      u32x4 o; o.x = pk2(kw[0], kw[1]); o.y = pk2(kw[2], kw[3]); o.z = pk2(kw[4], kw[5]); o.w = pk2(kw[6], kw[7]);
      *(LAS u32x4*)(lds + GL_KWT + ((dir * 32 + d) * 72 + sg * 8) * 2) = o;
      if (sg == 0) ((LAS float*)(lds + GL_DC))[dir * 32 + d] = __expf(tot); }
    __syncthreads();
    { const int wd = w >> 2, et = w & 3;
      f32x4 a0 = (f32x4){0.f, 0.f, 0.f, 0.f}, a1 = a0;
#pragma unroll
      for (int ks = 0; ks < 2; ++ks) { const bf16x8 av = *(const LAS bf16x8*)(lds + GL_VT + ((et * 16 + lr) * 72 + ks * 32 + lq * 8) * 2);
          const bf16x8 b0 = *(const LAS bf16x8*)(lds + GL_KWT + ((wd * 32 + lr) * 72 + ks * 32 + lq * 8) * 2), b1 = *(const LAS bf16x8*)(lds + GL_KWT + ((wd * 32 + 16 + lr) * 72 + ks * 32 + lq * 8) * 2);
          a0 = __builtin_amdgcn_mfma_f32_16x16x32_bf16(av, b0, a0, 0, 0, 0); a1 = __builtin_amdgcn_mfma_f32_16x16x32_bf16(av, b1, a1, 0, 0, 0); }
      const int cp = wd ? (sc < 4 ? 3 - sc : 39 - sc) : sc, ch = (b * 4 + h) * 2 + wd;
      float* DH = (float*)(ows(C.ws_) + WS_R + R_DH) + ((size_t)ch * 36 + cp) * 2048;
#pragma unroll
      for (int r = 0; r < 4; ++r) { const int e = et * 16 + 4 * lq + r; DH[e * 32 + lr] = a0[r]; DH[e * 32 + 16 + lr] = a1[r]; }
      if (tid < 64) { const int dd = tid >> 5, d2 = tid & 31; const int cp2 = dd ? (sc < 4 ? 3 - sc : 39 - sc) : sc;
          ((float*)(ows(C.ws_) + WS_R + R_DEC))[((size_t)((b * 4 + h) * 2 + dd) * 36 + cp2) * 32 + d2] = ((const LAS float*)(lds + GL_DC))[dd * 32 + d2]; } }
    __syncthreads();
}
__device__ __forceinline__ void gla2_all(const Ctx& C) {
    const int tid = otid();
    float* DH = (float*)(ows(C.ws_) + WS_R + R_DH); const float* DEC = (const float*)(ows(C.ws_) + WS_R + R_DEC);
    for (int il = ovr(C) * NTHR + tid; il < 16 * 2048; il += 32 * NTHR) { const int i = ovx(C) * 16 * 2048 + il, ch = i >> 11, el = i & 2047, d = el & 31;
        float* p = DH + (size_t)ch * 36 * 2048 + el; const float* dc = DEC + (size_t)ch * 36 * 32 + d;
        float dh[36], de[36];
#pragma unroll
        for (int cp = 0; cp < 36; ++cp) { dh[cp] = p[(size_t)cp * 2048]; de[cp] = dc[cp * 32]; }
        float S = 0.f;
#pragma unroll
        for (int cp = 0; cp < 36; ++cp) { p[(size_t)cp * 2048] = S; S = de[cp] * S + dh[cp]; } }
}
__device__ __forceinline__ void gla3_item(const Ctx& C, int l, int g) {
    const int b = g / 144, rem = g % 144, sc = rem >> 2, h = rem & 3, m0 = gla_row0(b, sc);
    const bf16* cols = wsb(C, WS_R + R_COLS); bf16* YS = wsb(C, WS_R + R_YS); LAS unsigned char* lds = C.lds;
    const int tid = otid(), lane = tid & 63, w = owave(), lr = lane & 15, lq = lane >> 4;
    gla_load_common(cols, m0, h, lds, tid, true);
    { const int dir = tid >> 8, e = (tid >> 2) & 63, dq = tid & 3; const int cp = dir ? (sc < 4 ? 3 - sc : 39 - sc) : sc, ch = (b * 4 + h) * 2 + dir;
      const float* sp = (const float*)(ows(C.ws_) + WS_R + R_DH) + ((size_t)ch * 36 + cp) * 2048 + e * 32 + dq * 8;
      const f32x4 s0 = *(const f32x4*)sp, s1 = *(const f32x4*)(sp + 4);
      u32x4 o; o.x = pk2(s0[0], s0[1]); o.y = pk2(s0[2], s0[3]); o.z = pk2(s1[0], s1[1]); o.w = pk2(s1[2], s1[3]);
      *(LAS u32x4*)(lds + GL_SPT + ((dir * 64 + e) * 40 + dq * 8) * 2) = o; }
    __syncthreads();
    { const int dir = tid >> 8, d = (tid >> 3) & 31, sg = tid & 7;
      LAS float* LA = (LAS float*)(lds + GL_LA) + dir * 64 * 33; LAS float* SEG = (LAS float*)(lds + GL_SEG) + (dir * 32 + d) * 8;
      float v[8], pre[8]; float run = 0.f;
#pragma unroll
      for (int x = 0; x < 8; ++x) { v[x] = LA[(sg * 8 + x) * 33 + d]; run += v[x]; pre[x] = run; }
      SEG[sg] = run;
      __syncthreads();
      float off = 0.f, tot = 0.f;
#pragma unroll
      for (int s2 = 0; s2 < 8; ++s2) { const float t2 = SEG[s2]; tot += t2; off += (s2 < sg) ? t2 : 0.f; }
      const LAS float* QT = (const LAS float*)(lds + GL_QT); const LAS float* KT = (const LAS float*)(lds + GL_KT);
      LAS bf16* QE = (LAS bf16*)(lds + GL_QE) + dir * 64 * 40 + d; LAS bf16* KE = (LAS bf16*)(lds + GL_KE) + dir * 64 * 40 + d;
#pragma unroll
      for (int x = 0; x < 8; ++x) { const int i = sg * 8 + x;
          const float bb = dir == 0 ? (off + pre[x]) : (tot - (off + pre[x] - v[x]));
          QE[i * 40] = (bf16)f2bf(QT[i * 33 + d] * __expf(bb)); KE[i * 40] = (bf16)f2bf(KT[i * 33 + d] * __expf(-bb)); } }
    __syncthreads();
    { const int dir = w >> 2, jt = w & 3;
      const bf16x8 bq = *(const LAS bf16x8*)(lds + GL_QE + ((dir * 64 + jt * 16 + lr) * 40 + lq * 8) * 2);
#pragma unroll
      for (int it = 0; it < 4; ++it) { const bf16x8 ak = *(const LAS bf16x8*)(lds + GL_KE + ((dir * 64 + it * 16 + lr) * 40 + lq * 8) * 2);
          const f32x4 a = __builtin_amdgcn_mfma_f32_16x16x32_bf16(ak, bq, (f32x4){0.f, 0.f, 0.f, 0.f}, 0, 0, 0);
          const int j = jt * 16 + lr, i0 = it * 16 + 4 * lq; float m4[4];
#pragma unroll
          for (int r = 0; r < 4; ++r) { const int i = i0 + r; const bool keep = dir ? (i > j) : (i <= j); m4[r] = keep ? a[r] : 0.f; }
          u32x2 o; o.x = pk2(m4[0], m4[1]); o.y = pk2(m4[2], m4[3]);
          *(LAS u32x2*)(lds + GL_AT + ((dir * 64 + j) * 72 + i0) * 2) = o; } }
    __syncthreads();
    const int jt = w >> 1, et0 = 2 * (w & 1);
    f32x4 o0 = (f32x4){0.f, 0.f, 0.f, 0.f}, o1 = o0;
#pragma unroll
    for (int dir = 0; dir < 2; ++dir) {
#pragma unroll
        for (int ks = 0; ks < 2; ++ks) { const bf16x8 ba = *(const LAS bf16x8*)(lds + GL_AT + ((dir * 64 + jt * 16 + lr) * 72 + ks * 32 + lq * 8) * 2);
            o0 = __builtin_amdgcn_mfma_f32_16x16x32_bf16(*(const LAS bf16x8*)(lds + GL_VT + ((et0 * 16 + lr) * 72 + ks * 32 + lq * 8) * 2), ba, o0, 0, 0, 0);
            o1 = __builtin_amdgcn_mfma_f32_16x16x32_bf16(*(const LAS bf16x8*)(lds + GL_VT + (((et0 + 1) * 16 + lr) * 72 + ks * 32 + lq * 8) * 2), ba, o1, 0, 0, 0); }
        const bf16x8 bq = *(const LAS bf16x8*)(lds + GL_QE + ((dir * 64 + jt * 16 + lr) * 40 + lq * 8) * 2);
        o0 = __builtin_amdgcn_mfma_f32_16x16x32_bf16(*(const LAS bf16x8*)(lds + GL_SPT + ((dir * 64 + et0 * 16 + lr) * 40 + lq * 8) * 2), bq, o0, 0, 0, 0);
        o1 = __builtin_amdgcn_mfma_f32_16x16x32_bf16(*(const LAS bf16x8*)(lds + GL_SPT + ((dir * 64 + (et0 + 1) * 16 + lr) * 40 + lq * 8) * 2), bq, o1, 0, 0, 0);
    }
    { float ss = (o0[0] * o0[0] + o0[1] * o0[1]) + (o0[2] * o0[2] + o0[3] * o0[3]) + (o1[0] * o1[0] + o1[1] * o1[1]) + (o1[2] * o1[2] + o1[3] * o1[3]);
      ss += __shfl_xor(ss, 16); ss += __shfl_xor(ss, 32);
      if (lq == 0) ((LAS float*)(lds + GL_RS))[(jt * 16 + lr) * 2 + (w & 1)] = ss; }
    __syncthreads();
    { const int j = jt * 16 + lr; const LAS float* RS = (const LAS float*)(lds + GL_RS);
      const float rs = 1.0f / sqrtf((RS[j * 2] + RS[j * 2 + 1]) * (1.0f / 64.0f) + EPS);
      const size_t rowo = (size_t)(m0 + j);
#pragma unroll
      for (int q = 0; q < 2; ++q) { const int e = (et0 + q) * 16 + 4 * lq; const f32x4 o = q ? o1 : o0;
          const u32x2 rw = *(const u32x2*)(cols + rowo * NINP + C_R + h * 64 + e); const f32x4 gg = *(const f32x4*)(oin(C.in_)[9] + (size_t)l * 256 + h * 64 + e);
          u32x2 ow; ow.x = pk2(o[0] * rs * gg[0] * bflo(rw.x), o[1] * rs * gg[1] * bfhi(rw.x)); ow.y = pk2(o[2] * rs * gg[2] * bflo(rw.y), o[3] * rs * gg[3] * bfhi(rw.y));
          *(u32x2*)(YS + rowo * D + h * 64 + e) = ow; } }
    __syncthreads();
}

template <int GI> __device__ __forceinline__ void pool_lat_item_t(const Ctx& C, int l, int b, int slab) {
    constexpr int HW = 1 << GI; constexpr int RS = 64 * 16 + 16;
    const int ch0 = slab * 16;
    const bf16* cols = wsb(C, WS_R + R_COLS); bf16* YS = wsb(C, WS_R + R_YS);
    LAS float* G = (LAS float*)C.lds;
    const int tid = otid(), hf = tid & 1;
    u32x4 xin[8];
#pragma unroll
    for (int k = 0; k < 8; ++k) { const int t = (tid + k * NTHR) >> 1; xin[k] = *(const u32x4*)(cols + (size_t)(b * T + t) * NINP + C_POOL + ch0 + hf * 8); }
#pragma unroll
    for (int k = 0; k < 8; ++k) { const int t = (tid + k * NTHR) >> 1; LAS float* d = G + (t >> 6) * RS + (t & 63) * 16 + hf * 8; const u32x4 w = xin[k];
        *(LAS f32x4*)d = (f32x4){bflo(w.x), bfhi(w.x), bflo(w.y), bfhi(w.y)}; *(LAS f32x4*)(d + 4) = (f32x4){bflo(w.z), bfhi(w.z), bflo(w.w), bfhi(w.w)}; }
    __syncthreads();
#pragma unroll 1
    for (int q = 0; q < 2; ++q) { const int cix = tid + q * NTHR; float p[33]; p[0] = 0.f;
#pragma unroll
        for (int gr = 0; gr < 32; ++gr) p[gr + 1] = p[gr] + G[gr * RS + cix];
#pragma unroll
        for (int gr = 0; gr < 32; ++gr) { const int lo = gr - HW < 0 ? 0 : gr - HW, hi = gr + HW > 32 ? 32 : gr + HW;
            G[gr * RS + cix] = (p[hi] - p[lo]) * (1.0f / (float)(hi - lo)); } }
    __syncthreads();
    { const int gr = tid >> 4, ch = tid & 15; LAS float* Gr = G + gr * RS + ch; float p[65]; p[0] = 0.f;
#pragma unroll
      for (int gc = 0; gc < 64; ++gc) p[gc + 1] = p[gc] + Gr[gc * 16];
#pragma unroll
      for (int gc = 0; gc < 64; ++gc) { const int lo = gc - HW < 0 ? 0 : gc - HW, hi = gc + HW > 64 ? 64 : gc + HW;
          Gr[gc * 16] = (p[hi] - p[lo]) * (1.0f / (float)(hi - lo)); } }
    __syncthreads();
    { const float* ps = oin(C.in_)[11] + (size_t)l * 256 + ch0 + hf * 8; const f32x4 s0 = *(const f32x4*)ps, s1 = *(const f32x4*)(ps + 4);
#pragma unroll
      for (int k = 0; k < 8; ++k) { const int t = (tid + k * NTHR) >> 1; const LAS float* d = G + (t >> 6) * RS + (t & 63) * 16 + hf * 8; const f32x4 m0 = *(const LAS f32x4*)d, m1 = *(const LAS f32x4*)(d + 4); const u32x4 w = xin[k];
          u32x4 o; o.x = pk2((m0[0] - bflo(w.x)) * s0[0], (m0[1] - bfhi(w.x)) * s0[1]); o.y = pk2((m0[2] - bflo(w.y)) * s0[2], (m0[3] - bfhi(w.y)) * s0[3]);
          o.z = pk2((m1[0] - bflo(w.z)) * s1[0], (m1[1] - bfhi(w.z)) * s1[1]); o.w = pk2((m1[2] - bflo(w.w)) * s1[2], (m1[3] - bfhi(w.w)) * s1[3]);
          *(u32x4*)(YS + (size_t)(b * T + t) * D + 256 + ch0 + hf * 8) = o; } }
    __syncthreads();
}
__device__ __forceinline__ void pool_lat_item(const Ctx& C, int l, int p) {
    const int b = p >> 4, slab = p & 15, gi = slab >> 2;
    if (gi == 0) pool_lat_item_t<0>(C, l, b, slab); else if (gi == 1) pool_lat_item_t<1>(C, l, b, slab); else if (gi == 2) pool_lat_item_t<2>(C, l, b, slab); else pool_lat_item_t<3>(C, l, b, slab);
}
__device__ __forceinline__ void pool_ctx_item(const Ctx& C, int l, int p) {
    const int b = p >> 2, gi = p & 3, hw = 1 << gi;
    const bf16* cols = wsb(C, WS_R + R_COLS); bf16* YS = wsb(C, WS_R + R_YS);
    LAS float* G = (LAS float*)C.lds;
    const int tid = otid(), sg = tid & 7;
    u32x4 xin[4];
#pragma unroll
    for (int k = 0; k < 4; ++k) { const int t = (tid + k * NTHR) >> 3; xin[k] = *(const u32x4*)(cols + (size_t)(MLAT + b * TC + t) * NINP + C_POOL + gi * 64 + sg * 8); }
#pragma unroll
    for (int k = 0; k < 4; ++k) { const int t = (tid + k * NTHR) >> 3; LAS float* d = G + t * 64 + sg * 8; const u32x4 w = xin[k];
        *(LAS f32x4*)d = (f32x4){bflo(w.x), bfhi(w.x), bflo(w.y), bfhi(w.y)}; *(LAS f32x4*)(d + 4) = (f32x4){bflo(w.z), bfhi(w.z), bflo(w.w), bfhi(w.w)}; }
    __syncthreads();
    { const float* ps = oin(C.in_)[11] + (size_t)l * 256 + gi * 64 + sg * 8; const f32x4 s0 = *(const f32x4*)ps, s1 = *(const f32x4*)(ps + 4);
#pragma unroll
      for (int k = 0; k < 4; ++k) { const int t = (tid + k * NTHR) >> 3, lo = t - hw < 0 ? 0 : t - hw, hi = t + hw > 256 ? 256 : t + hw;
          f32x4 a0 = (f32x4){0.f, 0.f, 0.f, 0.f}, a1 = a0;
          for (int t2 = lo; t2 < hi; ++t2) { const LAS float* d = G + t2 * 64 + sg * 8; a0 += *(const LAS f32x4*)d; a1 += *(const LAS f32x4*)(d + 4); }
          const float inv = 1.0f / (float)(hi - lo); const u32x4 w = xin[k];
          u32x4 o; o.x = pk2((a0[0] * inv - bflo(w.x)) * s0[0], (a0[1] * inv - bfhi(w.x)) * s0[1]); o.y = pk2((a0[2] * inv - bflo(w.y)) * s0[2], (a0[3] * inv - bfhi(w.y)) * s0[3]);
          o.z = pk2((a1[0] * inv - bflo(w.z)) * s1[0], (a1[1] * inv - bfhi(w.z)) * s1[1]); o.w = pk2((a1[2] * inv - bflo(w.w)) * s1[2], (a1[3] * inv - bfhi(w.w)) * s1[3]);
          *(u32x4*)(YS + (size_t)(MLAT + b * TC + t) * D + 256 + gi * 64 + sg * 8) = o; } }
    __syncthreads();
}
__device__ __forceinline__ void sgu_item(const Ctx& C, int l, int s, bool loadw) {
    int m0, g;
    if (s < 1024) { const int b = s >> 6, n = (s >> 2) & 15; g = s & 3; m0 = b * T + n * 128; }
    else { const int s2 = s - 1024, b = s2 >> 3, n = (s2 >> 2) & 1; g = s2 & 3; m0 = MLAT + b * TC + n * 128; }
    const bf16* cols = wsb(C, WS_R + R_COLS); bf16* YS = wsb(C, WS_R + R_YS); LAS unsigned char* lds = C.lds;
    constexpr int SG_W = 0, SG_V = 34816;
    const int tid = otid(), lane = tid & 63, w = owave(), lr = lane & 15, lq = lane >> 4;
    if (loadw) { const bf16* wg = wsb(C, WS_SGUW) + (size_t)(l * 4 + g) * 128 * 128;
#pragma unroll
      for (int q = 0; q < 4; ++q) { const int i = tid + q * NTHR, r = i >> 4, c16 = i & 15; *(LAS u32x4*)(lds + SG_W + (r * 136 + c16 * 8) * 2) = *(const u32x4*)(wg + r * 128 + c16 * 8); } }
    const int srow = w * 16 + lr; const size_t rowo = (size_t)(m0 + srow); u32x2 uw[4];
#pragma unroll
    for (int ct = 0; ct < 4; ++ct) uw[ct] = *(const u32x2*)(cols + rowo * NINP + C_SU + g * 64 + ct * 16 + 4 * lq);
    const float bias = oin(C.in_)[15][(size_t)(l * 4 + g) * 128 + srow];
    { const int row = tid >> 2, q = tid & 3; const bf16* rp = cols + (size_t)(m0 + row) * NINP + C_SV + q * 64; float v[64]; float sm4[4] = {0.f, 0.f, 0.f, 0.f};
#pragma unroll
      for (int i = 0; i < 8; ++i) { const u32x4 x = *(const u32x4*)(rp + i * 8); v[8 * i] = bflo(x.x); v[8 * i + 1] = bfhi(x.x); v[8 * i + 2] = bflo(x.y); v[8 * i + 3] = bfhi(x.y); v[8 * i + 4] = bflo(x.z); v[8 * i + 5] = bfhi(x.z); v[8 * i + 6] = bflo(x.w); v[8 * i + 7] = bfhi(x.w); }
#pragma unroll
      for (int i = 0; i < 64; ++i) sm4[i & 3] += v[i];
      float sm = (sm4[0] + sm4[1]) + (sm4[2] + sm4[3]);
      sm += __shfl_xor(sm, 1); sm += __shfl_xor(sm, 2); const float mean = sm * (1.0f / 256.0f); float sq4[4] = {0.f, 0.f, 0.f, 0.f};
#pragma unroll
      for (int i = 0; i < 64; ++i) { v[i] -= mean; sq4[i & 3] += v[i] * v[i]; }
      float sq = (sq4[0] + sq4[1]) + (sq4[2] + sq4[3]);
      sq += __shfl_xor(sq, 1); sq += __shfl_xor(sq, 2); const float rstd = __builtin_amdgcn_rsqf(sq * (1.0f / 256.0f) + EPS);
      if (q == g) { const float* lg = oin(C.in_)[12] + (size_t)l * 256 + g * 64; const float* lb = oin(C.in_)[13] + (size_t)l * 256 + g * 64; LAS bf16* vt = (LAS bf16*)(lds + SG_V) + row;
#pragma unroll
          for (int i = 0; i < 64; ++i) vt[i * 136] = (bf16)f2bf(v[i] * rstd * lg[i] + lb[i]); } }
    __syncthreads();
    f32x4 a[4];
#pragma unroll
    for (int ct = 0; ct < 4; ++ct) a[ct] = (f32x4){0.f, 0.f, 0.f, 0.f};
#pragma unroll
    for (int ks = 0; ks < 4; ++ks) { const bf16x8 bw = *(const LAS bf16x8*)(lds + SG_W + ((w * 16 + lr) * 136 + ks * 32 + lq * 8) * 2);
#pragma unroll
        for (int ct = 0; ct < 4; ++ct) a[ct] = __builtin_amdgcn_mfma_f32_16x16x32_bf16(*(const LAS bf16x8*)(lds + SG_V + ((ct * 16 + lr) * 136 + ks * 32 + lq * 8) * 2), bw, a[ct], 0, 0, 0); }
#pragma unroll
    for (int ct = 0; ct < 4; ++ct) { const int c = ct * 16 + 4 * lq;
        u32x2 o; o.x = pk2(bflo(uw[ct].x) * (a[ct][0] + bias), bfhi(uw[ct].x) * (a[ct][1] + bias)); o.y = pk2(bflo(uw[ct].y) * (a[ct][2] + bias), bfhi(uw[ct].y) * (a[ct][3] + bias));
        *(u32x2*)(YS + rowo * D + 768 + g * 64 + c) = o; }
    __syncthreads();
}
__device__ __forceinline__ void cdft_tile(const Ctx& C, int c) {
    const bf16* cols = wsb(C, WS_R + R_COLS); const bf16* CS = wsb(C, WS_CS64);
    const int tid = otid(), lane = tid & 63, wave = owave(), wr = wave >> 2, wc = wave & 3, fr = lane & 15, fq = lane >> 4;
    const bf16* pa0 = CS + (size_t)(tid >> 3) * 64 + (tid & 7) * 8; const bf16* pa1 = pa0 + 64 * 64;
    if (c < 1024) {
        const int b = c >> 6, g = (c >> 4) & 3, bq = c & 15; bf16* ZT = wsb(C, WS_R + R_ZT) + (size_t)b * 256 * 4096;
        const int n0 = tid >> 3, n1 = n0 + 64;
        const int t0 = 64 * (n0 & 31) + 4 * bq + (n0 >> 5), t1 = 64 * (n1 & 31) + 4 * bq + (n1 >> 5);
        const bf16* pb0 = cols + (size_t)(b * T + t0) * NINP + C_FFT + g * 64 + (tid & 7) * 8; const bf16* pb1 = cols + (size_t)(b * T + t1) * NINP + C_FFT + g * 64 + (tid & 7) * 8;
        f32x4 acc[4][2]; tg_zero(acc); tg_tile(acc, C.lds, pa0, pa1, pb0, pb1, 1);
#pragma unroll
        for (int m = 0; m < 4; ++m)
#pragma unroll
            for (int n = 0; n < 2; ++n) { const int row = wr * 64 + m * 16 + fr, col = wc * 32 + n * 16 + 4 * fq;
                const int p = row >> 6, mm = row & 63, j = col >> 5, a = col & 31; u32x2 w; w.x = pk2(acc[m][n][0], acc[m][n][1]); w.y = pk2(acc[m][n][2], acc[m][n][3]);
                *(u32x2*)(ZT + ((size_t)((g * 64 + mm) * 2 + p) * 64 + 4 * bq + j) * 32 + a) = w; }
    } else {
        const int c2 = c - 1024, b = c2 >> 3, g = (c2 >> 1) & 3, tt = c2 & 1, m0 = MLAT + b * TC + tt * 128; bf16* ZT = wsb(C, WS_R + R_ZTC) + (size_t)b * 256 * 512;
        const bf16* pb0 = cols + (size_t)(m0 + (tid >> 3)) * NINP + C_FFT + g * 64 + (tid & 7) * 8; const bf16* pb1 = pb0 + (size_t)64 * NINP;
        f32x4 acc[4][2]; tg_zero(acc); tg_tile(acc, C.lds, pa0, pa1, pb0, pb1, 1);
#pragma unroll
        for (int m = 0; m < 4; ++m)
#pragma unroll
            for (int n = 0; n < 2; ++n) { const int row = wr * 64 + m * 16 + fr, col = wc * 32 + n * 16 + 4 * fq;
                const int p = row >> 6, mm = row & 63; u32x2 w; w.x = pk2(acc[m][n][0], acc[m][n][1]); w.y = pk2(acc[m][n][2], acc[m][n][3]);
                *(u32x2*)(ZT + (size_t)(g * 64 + mm) * (2 * TC) + p * TC + tt * 128 + col) = w; }
    }
}
constexpr int FF_X = 0, FF_T1 = 81920, FF_T2 = 90112, FF_TW = 106496, FF_OUT = 0;
__device__ __forceinline__ void fft_load_tables(const Ctx& C) {
    const int tid = otid(); const u32x4* src = (const u32x4*)(ows(C.ws_) + WS_TF1);
#pragma unroll
    for (int q = 0; q < 5; ++q) { const int i = tid + q * NTHR; *(LAS u32x4*)(C.lds + FF_T1 + i * 16) = src[i]; }
    __syncthreads();
}
__device__ __forceinline__ void fft_item(const Ctx& C, int item) {
    const int b = item >> 5, ch0 = (item & 31) * 8; LAS unsigned char* lds = C.lds;
    const int tid = otid(), lane = tid & 63, w = owave(), lr = lane & 15, lq = lane >> 4;
    LAS unsigned char* fx = lds + FF_X + w * 10240;
    { const u32x4* src = (const u32x4*)(wsb(C, WS_R + R_ZT) + ((size_t)(b * 256 + ch0 + w)) * 4096);
#pragma unroll
      for (int i = 0; i < 8; ++i) { const int q = lane + 64 * i; *(LAS u32x4*)(fx + (q >> 2) * 80 + (q & 3) * 16) = src[q]; } }
    f32x4 acc1[4][4];
#pragma unroll
    for (int rt = 0; rt < 4; ++rt)
#pragma unroll
        for (int ct = 0; ct < 4; ++ct) acc1[rt][ct] = (f32x4){0.f, 0.f, 0.f, 0.f};
#pragma unroll
    for (int ks = 0; ks < 2; ++ks) { bf16x8 af[4];
#pragma unroll
        for (int rt = 0; rt < 4; ++rt) af[rt] = *(const LAS bf16x8*)(fx + (ks * 64 + 16 * rt + lr) * 80 + lq * 16);
#pragma unroll
        for (int ct = 0; ct < 4; ++ct) { const bf16x8 bfr = *(const LAS bf16x8*)(lds + FF_T1 + ((ct * 2 + ks) * 64 + lane) * 16);
#pragma unroll
            for (int rt = 0; rt < 4; ++rt) acc1[rt][ct] = __builtin_amdgcn_mfma_f32_16x16x32_bf16(af[rt], bfr, acc1[rt][ct], 0, 0, 0); } }
    bf16x8 VR[2][2], VI[2][2];
#pragma unroll
    for (int ct = 0; ct < 2; ++ct)
#pragma unroll
        for (int ks = 0; ks < 2; ++ks) { float vr[8], vi[8];
#pragma unroll
            for (int hf = 0; hf < 2; ++hf) { const int rt = 2 * ks + hf;
#pragma unroll
                for (int r = 0; r < 4; ++r) { const f32x2 tw = *(const LAS f32x2*)(lds + FF_TW + (((rt * 2 + ct) * 4 + r) * 64 + lane) * 8);
                    const float ur = acc1[rt][ct][r], ui = acc1[rt][ct + 2][r]; vr[hf * 4 + r] = ur * tw.x + ui * tw.y; vi[hf * 4 + r] = ui * tw.x - ur * tw.y; } }
            u32x4 pr, pi; pr.x = pk2(vr[0], vr[1]); pr.y = pk2(vr[2], vr[3]); pr.z = pk2(vr[4], vr[5]); pr.w = pk2(vr[6], vr[7]);
            pi.x = pk2(vi[0], vi[1]); pi.y = pk2(vi[2], vi[3]); pi.z = pk2(vi[4], vi[5]); pi.w = pk2(vi[6], vi[7]);
            VR[ct][ks] = __builtin_bit_cast(bf16x8, pr); VI[ct][ks] = __builtin_bit_cast(bf16x8, pi); }
    __syncthreads();
#pragma unroll
    for (int dt = 0; dt < 4; ++dt) { bf16x8 fc[2], fs[2];
#pragma unroll
        for (int ks = 0; ks < 2; ++ks) { fc[ks] = *(const LAS bf16x8*)(lds + FF_T2 + (((0 * 4 + dt) * 2 + ks) * 64 + lane) * 16); fs[ks] = *(const LAS bf16x8*)(lds + FF_T2 + (((1 * 4 + dt) * 2 + ks) * 64 + lane) * 16); }
#pragma unroll
        for (int ct = 0; ct < 2; ++ct) { f32x4 o = (f32x4){0.f, 0.f, 0.f, 0.f};
#pragma unroll
            for (int ks = 0; ks < 2; ++ks) { o = __builtin_amdgcn_mfma_f32_16x16x32_bf16(fc[ks], VR[ct][ks], o, 0, 0, 0); o = __builtin_amdgcn_mfma_f32_16x16x32_bf16(fs[ks], VI[ct][ks], o, 0, 0, 0); }
#pragma unroll
            for (int r = 0; r < 4; ++r) { const int d = 16 * dt + 4 * lq + r, c = 16 * ct + lr, k = c + 32 * d; *(LAS bf16*)(lds + FF_OUT + (k * 8 + w) * 2) = (bf16)f2bf(o[r]); } } }
    __syncthreads();
    { bf16* YS = wsb(C, WS_R + R_YS);
#pragma unroll
      for (int i = 0; i < 4; ++i) { const int k = tid + NTHR * i; *(u32x4*)(YS + (size_t)(b * T + k) * D + 512 + ch0) = *(const LAS u32x4*)(lds + FF_OUT + k * 16); } }
    __syncthreads();
}

constexpr bool LOCAL_BARS = true;
__global__ void __launch_bounds__(NTHR, 2) fwd_kernel(Params prm) {
    extern __shared__ __attribute__((aligned(16))) unsigned char lds_raw[];
    Ctx C; C.lds = (LAS unsigned char*)lds_raw; C.ws_ = prm.ws; C.in_ = prm.in; C.out_ = prm.out; C.vx = 0; C.vr = 0; C.loc = 0;

    volatile LAS unsigned* MISC = (volatile LAS unsigned*)(C.lds + LDS_MISC);
    if (threadIdx.x < 16) MISC[threadIdx.x] = 0u;
    __syncthreads();
    (void)xcd_barrier_post((unsigned*)(ows(C.ws_) + WS_CTL) + CW_BAR, MISC + 8);
#define BAR_(rel) do { XcdBarrier b_; b_.bar = (unsigned*)(ows(C.ws_) + WS_CTL) + CW_BAR; b_.x = (unsigned)__builtin_amdgcn_readfirstlane((int)xb_xcc_id()); b_.st = MISC + 8; xcd_barrier(b_, rel); } while (0)
#define GRID_BAR() BAR_(true)
#define BAR_X() BAR_(oloc(C) == 0)
#define BAR_L() do { if (LOCAL_BARS && oloc(C)) xcd_local_barrier((unsigned*)(ows(C.ws_) + WS_CTL) + CW_BAR, (unsigned)__builtin_amdgcn_readfirstlane((int)xb_xcc_id())); else BAR_(oloc(C) == 0); } while (0)

    p_prologue(C); GRID_BAR();
    { const int ok = (int)MISC[8 + 2];
      C.loc = __builtin_amdgcn_readfirstlane(ok); C.vx = __builtin_amdgcn_readfirstlane(ok ? (int)MISC[8 + 4] : (oblk() >> 5)); C.vr = __builtin_amdgcn_readfirstlane(ok ? (int)MISC[8 + 3] : (oblk() & 31)); }
    p_lna(C); BAR_L();

#pragma unroll 1
    for (int l = 0; l < DEPTH; ++l) {
        const bool last = (l == DEPTH - 1); const int mrows = last ? MLAT : M;
        const int nMl = last ? 16 : 18;
        const bf16* H = hbuf(C);
        { pg8::Gemm g{H, wW(C, WE_WIN + (size_t)l * 6144 * 1024), D, nullptr, D}; pg8::Sched<0> S; S.go.init_l(18, NINP / 256, ovr(C), ovx(C)); S.bp0 = 0; S.p0 = 0; S.pe = nullptr;
          { const int tid = otid(); if (tid < 64) *(LAS f32x4*)(C.lds + 131072 + tid * 16) = *(const f32x4*)(oin(C.in_)[8] + (size_t)l * 256 + tid * 4); __syncthreads(); }
          pg8::EpiCols E{wsb(C, WS_R + R_COLS)};
          pg8::gemm_phase<pg8::EpiCols, pg8::Sched<0>, false>(C.lds, g, S, E); }
        BAR_L();
        { const int nG = 288, nPL = 32, nPC = last ? 0 : 8, nSl = 128, nSc = last ? 0 : 16, nDl = 128, nDc = last ? 0 : 16;
          const int tot = nG + nPL + nPC + nSl + nSc + nDl + nDc, vx = ovx(C);
          for (int it = ovr(C); it < tot; it += 32) { int i = it;
              if (i < nG) { gla1_item(C, 288 * vx + i); continue; } i -= nG;
              if (i < nPL) { pool_lat_item(C, l, 32 * vx + i); continue; } i -= nPL;
              if (i < nPC) { pool_ctx_item(C, l, 8 * vx + i); continue; } i -= nPC;
              if (i < nSl + nSc) { sgu_item(C, l, i < nSl ? 128 * vx + i : 1024 + 16 * vx + (i - nSl), i < 32); continue; } i -= nSl + nSc;
              cdft_tile(C, i < nDl ? 128 * vx + i : 1024 + 16 * vx + (i - nDl)); } }
        BAR_L();
        gla2_all(C);
        fft_load_tables(C);
        for (int it = ovr(C); it < 64; it += 32) fft_item(C, 64 * ovx(C) + it);
        BAR_L();
        { for (int it = ovr(C); it < 288; it += 32) { const int gi = 288 * ovx(C) + it, rem = gi % 144; if (last && rem < 16) continue; gla3_item(C, l, gi); }
          bf16* YS = wsb(C, WS_R + R_YS);
          const int tid = otid(), lane = tid & 63, wave = owave(), wr = wave >> 2, wc = wave & 3, fr = lane & 15, fq = lane >> 4;
          const int nctx = last ? 0 : 8;
          for (int t2l = ovr(C); t2l < nctx; t2l += 32) { const int t2 = 8 * ovx(C) + t2l;
              const int b = t2 >> 2, tm = (t2 >> 1) & 1, tn = t2 & 1, K = 2 * TC, mrow0 = MLAT + b * TC; const bf16* A = wsb(C, WS_DLC); const bf16* Bt = wsb(C, WS_R + R_ZTC) + (size_t)b * 256 * 512;
              const bf16* pa0 = A + (size_t)(tm * 128 + (tid >> 3)) * K + (tid & 7) * 8; const bf16* pa1 = pa0 + (size_t)64 * K;
              const bf16* pb0 = Bt + (size_t)(tn * 128 + (tid >> 3)) * K + (tid & 7) * 8; const bf16* pb1 = pb0 + (size_t)64 * K;
              f32x4 acc[4][2]; tg_zero(acc); tg_tile(acc, C.lds, pa0, pa1, pb0, pb1, K / 64);
#pragma unroll
              for (int m = 0; m < 4; ++m)
#pragma unroll
                  for (int n = 0; n < 2; ++n) { const int row = mrow0 + tm * 128 + wr * 64 + m * 16 + fr, col = tn * 128 + wc * 32 + n * 16 + 4 * fq;
                      u32x2 w; w.x = pk2(acc[m][n][0], acc[m][n][1]); w.y = pk2(acc[m][n][2], acc[m][n][3]); *(u32x2*)(YS + (size_t)row * D + 512 + col) = w; }
          }
        }
        BAR_X();
        { pg8::Gemm g{wsb(C, WS_R + R_YS), wW(C, WE_WBR + (size_t)l * 4 * 1024 * 256), 256, nullptr, D}; pg8::Sched<4> S; S.go.init_l(nMl, 16, ovr(C), ovx(C), 1); S.bp0 = 0; S.p0 = 0; S.pe = nullptr;
          pg8::EpiP E{wsb(C, WS_R + R_G)};
          pg8::gemm_phase<pg8::EpiP, pg8::Sched<4>, false>(C.lds, g, S, E); }
        BAR_L();
        { pg8::Gemm g{(const bf16*)h8buf(C), (const bf16*)(ows(C.ws_) + WS_G8 + (size_t)l * 4096 * 1024), D / 2, nullptr, D / 2}; pg8::Sched<0> S; S.go.init_l(nMl, 16, ovr(C), ovx(C)); S.bp0 = 0; S.p0 = 0; S.pe = nullptr;
          pg8::EpiGateMix E{wsb(C, WS_R + R_G), wsb(C, WS_R + R_MM), 1.0f / G8_SCALE};
          pg8::gemm_phase<pg8::EpiGateMix, pg8::Sched<0>, false, true>(C.lds, g, S, E); }
        BAR_L();
        { pg8::Gemm g{wsb(C, WS_R + R_MM), wW(C, WE_WO + (size_t)l * D * D), D, nullptr, D}; pg8::Sched<0> S; S.go.init_l(nMl, 4, ovr(C), ovx(C), 1); S.bp0 = 0; S.p0 = 0; S.pe = nullptr;
          pg8::EpiAct E{wsb(C, WS_R + R_YS), D, EM_NONE, nullptr};
          pg8::gemm_phase<pg8::EpiAct, pg8::Sched<0>, false>(C.lds, g, S, E); }
        BAR_L();
        p_lnb(C, l, mrows);
        const bool moe = (l & 1); const int jm = l >> 1;
        if (moe) GRID_BAR(); else BAR_X();
        int npanels = mrows / 256;
        if (moe) { p_route_build(C, l, mrows); GRID_BAR(); RouteInfo R; route_info(C, jm, R); npanels = R.npanels; }
        { const int* rt = (const int*)(ows(C.ws_) + WS_ROUTE); const int* s2t = moe ? rt + RT_S2T : rt + RT_IDT; const int* pe = rt + RT_PE;
          const bf16* WGU = moe ? wW(C, WE_GUE + (size_t)jm * 8 * 5632 * 1024) : wW(C, WE_GUD + (size_t)jm * 5632 * 1024);
          const bf16* WDN = moe ? wW(C, WE_DE + (size_t)jm * 8 * 1024 * 2816) : wW(C, WE_DD + (size_t)jm * 1024 * 2816);
          bf16* ACT = wsb(C, WS_R + R_ACT); bf16* Y2 = wsb(C, WS_R + R_Y2);
          const int pcap = moe ? (DOWN8_MOE ? 296 : 128) : 144;
#pragma unroll 1
          for (int p0 = 0; p0 < npanels; p0 += pcap) { const int np = (npanels - p0) < pcap ? (npanels - p0) : pcap;
              const bool own = moe && oloc(C);
              const int plo = (np * ovx(C)) >> 3, phi = (np * (ovx(C) + 1)) >> 3;
              { pg8::Gemm g{(const bf16*)h8buf(C), WGU, D / 2, s2t, D / 2}; pg8::Sched<2> S; if (own) S.go.init_p(phi - plo, 22, ovr(C), plo); else if (moe) S.go.init(np, 22, ogrid(), oblk()); else S.go.init_l(nMl, 22, ovr(C), ovx(C), 1); S.bp0 = 0; S.p0 = p0; S.pe = moe ? pe : nullptr;
                const bool f8down = moe ? DOWN8_MOE : DOWN8_DENSE;
                pg8::EpiSwiGLU E{ACT, DFF, 1.0f / G8_SCALE, f8down ? ACT8_SCALE : 0.f};
                pg8::gemm_phase<pg8::EpiSwiGLU, pg8::Sched<2>, true, true>(C.lds, g, S, E); }
              if (moe && !own) GRID_BAR(); else BAR_L();
              if (moe ? DOWN8_MOE : DOWN8_DENSE) { pg8::Gemm g{ACT, WDN, DFF / 2, nullptr, DFF / 2}; pg8::Sched<3> S; if (own) S.go.init_p(phi - plo, 4, ovr(C), plo, 1); else if (moe) S.go.init(np, 4, ogrid(), oblk()); else S.go.init_l(nMl, 4, ovr(C), ovx(C)); S.bp0 = 8; S.p0 = p0; S.pe = moe ? pe : nullptr;
                pg8::EpiScale E{Y2, D, 1.0f / (G8_SCALE * ACT8_SCALE)};
                pg8::gemm_phase<pg8::EpiScale, pg8::Sched<3>, false, true>(C.lds, g, S, E); }
              else { pg8::Gemm g{ACT, WDN, DFF, nullptr, DFF}; pg8::Sched<3> S; if (own) S.go.init_p(phi - plo, 4, ovr(C), plo, 1); else if (moe) S.go.init(np, 4, ogrid(), oblk()); else S.go.init_l(nMl, 4, ovr(C), ovx(C)); S.bp0 = 4; S.p0 = p0; S.pe = moe ? pe : nullptr;
                pg8::EpiAct E{Y2, D, EM_NONE, nullptr};
                pg8::gemm_phase<pg8::EpiAct, pg8::Sched<3>, false>(C.lds, g, S, E); }
              if (!moe) BAR_L(); else if (own && p0 + np < npanels) BAR_X(); else GRID_BAR();
          } }
        p_lnc(C, l, mrows);
        if (!last) BAR_X();
    }
}

extern "C" void kernel_launch(void* const* d_in, const int* in_sizes, int n_in, void* d_out, int out_size, void* d_ws, size_t ws_size, hipStream_t stream) {
    static int grid = 0;
    if (grid == 0) {
        if (n_in != 28 || out_size != MLAT * D || ws_size < WS_END) { fprintf(stderr, "kernel_launch: unexpected shapes (n_in %d, out %d, ws %zu < %zu)\n", n_in, out_size, ws_size, (size_t)WS_END); grid = -1; return; }
        int dev = 0, cus = 0, per_cu = 0;
        if (hipGetDevice(&dev) != hipSuccess || hipDeviceGetAttribute(&cus, hipDeviceAttributeMultiprocessorCount, dev) != hipSuccess) { grid = -1; return; }
        if (hipFuncSetAttribute((const void*)fwd_kernel, hipFuncAttributeMaxDynamicSharedMemorySize, LDS_BYTES) != hipSuccess) { fprintf(stderr, "kernel_launch: hipFuncSetAttribute failed\n"); grid = -1; return; }
        if (hipOccupancyMaxActiveBlocksPerMultiprocessor(&per_cu, (const void*)fwd_kernel, NTHR, LDS_BYTES) != hipSuccess || per_cu < 1) fprintf(stderr, "kernel_launch: occupancy query says %d\n", per_cu);
        (void)hipGetLastError();
        grid = cus;
        if (grid != 256) { fprintf(stderr, "kernel_launch: built for 256 CUs, device has %d\n", cus); grid = -1; return; }
    }
    if (grid < 0) return;
    if (hipMemsetAsync((char*)d_ws + WS_CTL, 0, CTL_BYTES, stream) != hipSuccess) return;
    Params p{};
    for (int i = 0; i < 28; ++i) p.in[i] = (const float*)d_in[i];
    p.out = (float*)d_out; p.ws = (unsigned char*)d_ws;
    hipLaunchKernelGGL(fwd_kernel, dim3(grid), dim3(NTHR), LDS_BYTES, stream, p);
}
```

```cpp
#include <hip/hip_runtime.h>
#include <cstdio>
#include <cstdint>

#define GAS __attribute__((address_space(1)))
#define LAS __attribute__((address_space(3)))
typedef unsigned short bf16;
typedef short bf16x8 __attribute__((ext_vector_type(8)));
typedef float f32x4 __attribute__((ext_vector_type(4)));
typedef unsigned u32x4 __attribute__((ext_vector_type(4)));
typedef unsigned u32x2 __attribute__((ext_vector_type(2)));
typedef float f32x2 __attribute__((ext_vector_type(2)));

#ifndef PROBE
#define PROBE 0
#endif
constexpr int NB = 16, T = 2048, TC = 256, D = 1024, DEPTH = 4;
constexpr int MLAT = NB * T, MCTX = NB * TC, M = MLAT + MCTX;
constexpr int NIN = 1824, NINP = 2048, DFF = 2816, NE = 8;
constexpr int NTHR = 512, NWAVE = 8;
constexpr float ALPHA = 1.6817928305074290f;
constexpr float EPS = 1e-6f;
constexpr int C_Q = 0, C_K = 128, C_V = 256, C_R = 512, C_LAF = 768, C_LAB = 896, C_POOL = 1024, C_FFT = 1280, C_SU = 1536, C_SV = 1792;

constexpr size_t MiB = 1u << 20;
constexpr size_t WS_CTL = 0, CTL_BYTES = 1 * MiB;
constexpr size_t WS_MOD = 1 * MiB;
constexpr size_t WS_CS64 = 3 * MiB;
constexpr size_t WS_DLC = 3 * MiB + 65536;
constexpr size_t WS_SGUW = 3 * MiB + 512 * 1024;
constexpr size_t WS_TF1 = 4 * MiB;
constexpr size_t WS_TF2 = 4 * MiB + 8192;
constexpr size_t WS_TW = 4 * MiB + 24576;
constexpr size_t WS_ROUTE = 20 * MiB;
constexpr size_t WS_W = 22 * MiB;
constexpr size_t WS_XC = 384 * MiB;
constexpr size_t WS_G8 = WS_XC;
constexpr size_t OUT_H8 = 72 * MiB;
constexpr bool DOWN8_DENSE = true;
constexpr bool DOWN8_MOE = true;
constexpr float ACT8_SCALE = 2.0f;
constexpr float G8_SCALE = 32.0f;
constexpr size_t WS_H = 400 * MiB;
constexpr bool XBF16 = true;
constexpr size_t WS_R = 472 * MiB;
constexpr size_t WS_END = 904 * MiB;
constexpr size_t R_YS = 0, R_MM = 72 * MiB, R_BIG = 144 * MiB;
constexpr size_t R_COLS = R_BIG, R_SCR = R_BIG + 144 * MiB;
constexpr size_t R_ZT = R_SCR, R_ZTC = R_SCR + 32 * MiB, R_DH = R_SCR + 36 * MiB, R_DEC = R_SCR + 72 * MiB;
constexpr size_t R_G = R_BIG;
constexpr size_t R_ACT = 0, R_Y2 = 204 * MiB;
constexpr size_t WE_WIN = 0;
constexpr size_t WE_WBR = WE_WIN + (size_t)4 * 6144 * 1024;
constexpr size_t WE_WO = WE_WBR + (size_t)4 * 4 * 1024 * 256;
constexpr size_t WE_GUD = WE_WO + (size_t)4 * 1024 * 1024;
constexpr size_t WE_DD = WE_GUD + (size_t)2 * 5632 * 1024;
constexpr size_t WE_GUE = WE_DD + (size_t)2 * 1024 * 2816;
constexpr size_t WE_DE = WE_GUE + (size_t)2 * 8 * 5632 * 1024;
constexpr size_t WE_END = WE_DE + (size_t)2 * 8 * 1024 * 2816;
static_assert(WE_END * 2 <= 362 * MiB, "weights fit");
constexpr int MAXP = 296;
constexpr size_t RT_TOKE = 0, RT_TOKR = (size_t)M * 2, RT_TOKW = (size_t)M * 4, RT_TOKS = (size_t)M * 6, RT_S2T = (size_t)M * 8, RT_PE = RT_S2T + (size_t)MAXP * 256, RT_BLK = RT_PE + 512, RT_IDT = RT_BLK + 2048;
static_assert((RT_IDT + M) * 4 <= 2 * MiB, "route tables fit");
constexpr int CW_BAR = 4096;
constexpr int CW_CNT = 16384;
constexpr int LDS_BYTES = 147456;
constexpr int LDS_MISC = 147456 - 256;

typedef __bf16 hwbf2 __attribute__((ext_vector_type(2)));
__device__ __forceinline__ unsigned pk2(float lo, float hi) { hwbf2 v; v[0] = (__bf16)lo; v[1] = (__bf16)hi; return __builtin_bit_cast(unsigned, v); }
__device__ __forceinline__ unsigned f2bf(float f) { return (unsigned)__builtin_bit_cast(unsigned short, (__bf16)f); }
__device__ __forceinline__ unsigned pk4_fp8(float a, float b, float c, float d) { int w = 0; w = __builtin_amdgcn_cvt_pk_fp8_f32(a, b, w, false); w = __builtin_amdgcn_cvt_pk_fp8_f32(c, d, w, true); return (unsigned)w; }
__device__ __forceinline__ float bf2f(unsigned b) { return __builtin_bit_cast(float, b << 16); }
__device__ __forceinline__ float bflo(unsigned w) { return __builtin_bit_cast(float, w << 16); }
__device__ __forceinline__ float bfhi(unsigned w) { return __builtin_bit_cast(float, w & 0xffff0000u); }
typedef float f32x2 __attribute__((ext_vector_type(2)));
__device__ __forceinline__ float sigmoidf_(float x) { return __builtin_amdgcn_rcpf(1.0f + __expf(-x)); }
__device__ __forceinline__ float siluf_(float x) { return x * __builtin_amdgcn_rcpf(1.0f + __expf(-x)); }
__device__ __forceinline__ float gelu_tanh_(float x) { const float u = 0.7978845608028654f * (x + 0.044715f * x * x * x); return x * __builtin_amdgcn_rcpf(1.0f + __expf(-2.0f * u)); }
__device__ __forceinline__ float logsigmoidf_(float z) { return fminf(z, 0.f) - __logf(1.0f + __expf(-fabsf(z))); }
template <int CTRL, int RMASK> __device__ __forceinline__ float dpp_get(float v) { return __builtin_bit_cast(float, __builtin_amdgcn_update_dpp(0, __builtin_bit_cast(int, v), CTRL, RMASK, 0xF, true)); }
__device__ __forceinline__ float wave_sum(float v) {
    v += dpp_get<0xB1, 0xF>(v); v += dpp_get<0x4E, 0xF>(v); v += dpp_get<0x141, 0xF>(v); v += dpp_get<0x140, 0xF>(v);
    v += dpp_get<0x142, 0xA>(v); v += dpp_get<0x143, 0xC>(v);
    return __builtin_bit_cast(float, __builtin_amdgcn_readlane(__builtin_bit_cast(int, v), 63));
}

__device__ __forceinline__ int otid() { int t = threadIdx.x; asm volatile("" : "+v"(t)); return t; }
__device__ __forceinline__ int oblk() { int b = blockIdx.x; asm volatile("" : "+s"(b)); return b; }
__device__ __forceinline__ int ogrid() { int g = gridDim.x; asm volatile("" : "+s"(g)); return g; }
__device__ __forceinline__ int owave() { return __builtin_amdgcn_readfirstlane(otid() >> 6); }
__device__ __forceinline__ unsigned ozero() { unsigned z; asm volatile("s_mov_b32 %0, 0" : "=s"(z)); return z; }
__device__ __forceinline__ unsigned char* ows(unsigned char* p) { return p + ozero(); }
__device__ __forceinline__ const float* const* oin(const float* const* p) { return p; }
__device__ __forceinline__ float* oout(float* p) { return p + ozero(); }

#define XB_TMO      128
#define XB_XCNT(j)  (256  + 64 * (j))
#define XB_XSUB(j)  (1280 + 64 * (j))
#define XB_XGEN(j)  (2304 + 64 * (j))
#define XB_TOP      3328
#define XB_TOPGEN   3392
#define XB_LSUB(j)  (3456 + 64 * (j))
#define XB_LGEN(j)  (4480 + 64 * (j))
#define XCD_BAR_WORDS 3456
#define XB_SPIN_CAP (1u << 22)
__device__ __forceinline__ unsigned xb_ld(unsigned* p)              { return __hip_atomic_load(p, __ATOMIC_RELAXED, __HIP_MEMORY_SCOPE_AGENT); }
__device__ __forceinline__ unsigned xb_add(unsigned* p, unsigned v) { return __hip_atomic_fetch_add(p, v, __ATOMIC_RELAXED, __HIP_MEMORY_SCOPE_AGENT); }
__device__ __forceinline__ unsigned xb_xcc_id() { return (unsigned)__builtin_amdgcn_s_getreg((3 << 11) | 20) & 0xFu; }
#define XB_SPIN(cond, bar) do { unsigned _sp = 0; while (cond) { __builtin_amdgcn_s_sleep(1); \
    if ((++_sp & 255u) == 0u) { if (xb_ld(&(bar)[XB_TMO])) break; if (_sp > XB_SPIN_CAP) { atomicAdd(&(bar)[XB_TMO], 1u); break; } } } } while (0)
struct XcdBarrier { unsigned* bar; unsigned x; volatile LAS unsigned* st; };
__device__ __forceinline__ XcdBarrier xcd_barrier_post(unsigned* bar, volatile LAS unsigned* st) {
    XcdBarrier b; b.bar = bar; b.x = xb_xcc_id(); b.st = st;
    if (threadIdx.x == 0) { st[3] = xb_add(&bar[XB_XCNT(b.x)], 1u); st[4] = b.x; }
    return b;
}
__device__ __forceinline__ void xcd_barrier_complete(unsigned* bar, unsigned x, unsigned& nloc, unsigned& nx, unsigned& even) {
    const unsigned G = gridDim.x * gridDim.y * gridDim.z;
    unsigned sum, cnt, mine, odd, sp = 0u;
    for (;;) {
        sum = 0u; cnt = 0u; mine = 0u; odd = 0u;
#pragma unroll
        for (unsigned j = 0; j < 16; ++j) { const unsigned c = xb_ld(&bar[XB_XCNT(j)]); sum += c; cnt += (c > 0u) ? 1u : 0u; mine = (j == x) ? c : mine; odd += (j < 8u ? c != 32u : c != 0u) ? 1u : 0u; }
        if (sum == G) break;
        __builtin_amdgcn_s_sleep(1);
        if ((++sp & 255u) == 0u) { if (xb_ld(&bar[XB_TMO])) break; if (sp > XB_SPIN_CAP) { atomicAdd(&bar[XB_TMO], 1u); break; } }
    }
    nloc = mine > 0u ? mine : 1u; nx = cnt > 0u ? cnt : 1u; even = (odd == 0u && sum == 256u) ? 1u : 0u;
}
__device__ __forceinline__ void xcd_barrier(const XcdBarrier& b, bool rel) {
    asm volatile("s_waitcnt vmcnt(0)" ::: "memory");
    __syncthreads();
    if (otid() == 0) {
        unsigned* bar = b.bar;
        __builtin_amdgcn_s_waitcnt(0);
        unsigned nloc = b.st[0], nx = b.st[1];
        if (nloc == 0u) { unsigned even; xcd_barrier_complete(bar, b.x, nloc, nx, even); b.st[0] = nloc; b.st[1] = nx; b.st[2] = even; }
        const unsigned old = xb_add(&bar[XB_XSUB(b.x)], 1u);
        const unsigned gen = old / nloc;
        if (old + 1u == (gen + 1u) * nloc) {
            if (rel) __builtin_amdgcn_fence(__ATOMIC_RELEASE, "agent");
            asm volatile("s_waitcnt vmcnt(0)" ::: "memory");
            const unsigned og = xb_add(&bar[XB_TOP], 1u);
            const unsigned tg = og / nx;
            if (og + 1u == (tg + 1u) * nx) xb_add(&bar[XB_TOPGEN], 1u);
            else XB_SPIN(xb_ld(&bar[XB_TOPGEN]) == tg, bar);
            __builtin_amdgcn_fence(__ATOMIC_ACQUIRE, "agent");
            xb_add(&bar[XB_XGEN(b.x)], 1u);
            asm volatile("s_waitcnt vmcnt(0)" ::: "memory");
        } else {
            XB_SPIN(xb_ld(&bar[XB_XGEN(b.x)]) == gen, bar);
            __builtin_amdgcn_fence(__ATOMIC_ACQUIRE, "agent");
            asm volatile("s_waitcnt vmcnt(0)" ::: "memory");
        }
    }
    __syncthreads();
}

__device__ __forceinline__ void xcd_local_barrier(unsigned* bar, unsigned x) {
    asm volatile("s_waitcnt vmcnt(0)" ::: "memory");
    __syncthreads();
    if (otid() == 0) {
        __builtin_amdgcn_s_waitcnt(0);
        const unsigned old = xb_add(&bar[XB_LSUB(x)], 1u);
        const unsigned gen = old / 32u;
        if (old + 1u == (gen + 1u) * 32u) xb_add(&bar[XB_LGEN(x)], 1u);
        else XB_SPIN(xb_ld(&bar[XB_LGEN(x)]) == gen, bar);
        __builtin_amdgcn_fence(__ATOMIC_ACQUIRE, "agent");
        asm volatile("s_waitcnt vmcnt(0)" ::: "memory");
    }
    __syncthreads();
}

struct Params { const float* in[28]; float* out; unsigned char* ws; };
struct Ctx {
    LAS unsigned char* lds;
    unsigned char* ws_;
    const float* const* in_;
    float* out_;
    int vx, vr, loc;
};
__device__ __forceinline__ int ovx(const Ctx& C) { int v = C.vx; asm volatile("" : "+s"(v)); return v; }
__device__ __forceinline__ int ovr(const Ctx& C) { int v = C.vr; asm volatile("" : "+s"(v)); return v; }
__device__ __forceinline__ int oloc(const Ctx& C) { int v = C.loc; asm volatile("" : "+s"(v)); return v; }
__device__ __forceinline__ int lrow(const Ctx& C, int j) { const int vx = ovx(C); return j < 4096 ? 4096 * vx + j : MLAT + 512 * vx + (j - 4096); }
__device__ __forceinline__ bf16* wsb(const Ctx& C, size_t off) { return (bf16*)(ows(C.ws_) + off); }
__device__ __forceinline__ bf16* wW(const Ctx& C, size_t eoff) { return (bf16*)(ows(C.ws_) + WS_W) + eoff; }
__device__ __forceinline__ const float* modv(const Ctx& C, int l, int r, int part) { return (const float*)(ows(C.ws_) + WS_MOD) + ((size_t)(l * 17 + r) * 6144 + part * 1024); }
__device__ __forceinline__ int row_r(int m) { return m < MLAT ? (m >> 11) : 16; }

constexpr int TG_ROWB = 144;
constexpr int TG_OPB = 128 * TG_ROWB;
__device__ __forceinline__ void tg_tile(f32x4 (&acc)[4][2], LAS unsigned char* lds, const bf16* pa0, const bf16* pa1, const bf16* pb0, const bf16* pb1, int nk) {
    const int tid = otid(), lane = tid & 63, wave = tid >> 6, wr = wave >> 2, wc = wave & 3, fr = lane & 15, fq = lane >> 4;
    const int so0 = (tid >> 3) * TG_ROWB + (tid & 7) * 16, so1 = so0 + 64 * TG_ROWB;
    u32x4 ra0 = *(const u32x4*)pa0, ra1 = *(const u32x4*)pa1, rb0 = *(const u32x4*)pb0, rb1 = *(const u32x4*)pb1;
    *(LAS u32x4*)(lds + so0) = ra0; *(LAS u32x4*)(lds + so1) = ra1; *(LAS u32x4*)(lds + TG_OPB + so0) = rb0; *(LAS u32x4*)(lds + TG_OPB + so1) = rb1;
    __syncthreads();
    for (int kt = 0; kt < nk; ++kt) {
        const bool more = kt + 1 < nk;
        if (more) { const int ko = (kt + 1) * 64; ra0 = *(const u32x4*)(pa0 + ko); ra1 = *(const u32x4*)(pa1 + ko); rb0 = *(const u32x4*)(pb0 + ko); rb1 = *(const u32x4*)(pb1 + ko); }
        LAS unsigned char* cur = lds + (kt & 1) * (2 * TG_OPB);
#pragma unroll
        for (int ks = 0; ks < 2; ++ks) {
            bf16x8 af[4], bfr[2];
#pragma unroll
            for (int m = 0; m < 4; ++m) af[m] = *(const LAS bf16x8*)(cur + (wr * 64 + m * 16 + fr) * TG_ROWB + ks * 64 + fq * 16);
#pragma unroll
            for (int n = 0; n < 2; ++n) bfr[n] = *(const LAS bf16x8*)(cur + TG_OPB + (wc * 32 + n * 16 + fr) * TG_ROWB + ks * 64 + fq * 16);
#pragma unroll
            for (int m = 0; m < 4; ++m)
#pragma unroll
                for (int n = 0; n < 2; ++n) acc[m][n] = __builtin_amdgcn_mfma_f32_16x16x32_bf16(bfr[n], af[m], acc[m][n], 0, 0, 0);
        }
        if (more) { LAS unsigned char* nxt = lds + ((kt + 1) & 1) * (2 * TG_OPB);
            *(LAS u32x4*)(nxt + so0) = ra0; *(LAS u32x4*)(nxt + so1) = ra1; *(LAS u32x4*)(nxt + TG_OPB + so0) = rb0; *(LAS u32x4*)(nxt + TG_OPB + so1) = rb1; }
        __syncthreads();
    }
}
__device__ __forceinline__ void tg_zero(f32x4 (&acc)[4][2]) {
#pragma unroll
    for (int m = 0; m < 4; ++m)
#pragma unroll
        for (int n = 0; n < 2; ++n) acc[m][n] = (f32x4){0.f, 0.f, 0.f, 0.f};
}

enum { EM_NONE = 0, EM_SIGMOID = 1, EM_COLS = 2 };
__device__ __forceinline__ f32x4 epi_apply(f32x4 v, int mode, int col, const float* bgk) {
    if (mode == EM_NONE) return v;
    if (mode == EM_SIGMOID) { for (int j = 0; j < 4; ++j) v[j] = sigmoidf_(v[j]); return v; }
    if (col < C_K) { for (int j = 0; j < 4; ++j) v[j] *= 0.17677669529663689f; }
    else if (col < C_R) {}
    else if (col < C_LAF) { for (int j = 0; j < 4; ++j) v[j] = siluf_(v[j]); }
    else if (col < C_POOL) { for (int j = 0; j < 4; ++j) v[j] = logsigmoidf_(v[j] + bgk[col - C_LAF + j]) * 0.0625f; }
    else if (col < C_SU) {}
    else { for (int j = 0; j < 4; ++j) v[j] = gelu_tanh_(v[j]); }
    return v;
}
__device__ __forceinline__ void tg_gemm_plain(const Ctx& C, const bf16* A, int lda, const int* rowmap, int mrows, const bf16* Bt, int ldb, int ncols, int K,
                                              bf16* O, int ldo, int mode, const float* bgk) {
    const int tid = otid(), lane = tid & 63, wave = owave(), wr = wave >> 2, wc = wave & 3, fr = lane & 15, fq = lane >> 4;
    const int ntn = ncols / 128, ntiles = (mrows / 128) * ntn;
    for (int t = oblk(); t < ntiles; t += ogrid()) {
        const int tm = t / ntn, tn = t % ntn;
        const int r0 = tm * 128 + (tid >> 3), r1 = r0 + 64;
        const size_t ar0 = rowmap ? (size_t)rowmap[r0] : (size_t)r0, ar1 = rowmap ? (size_t)rowmap[r1] : (size_t)r1;
        const bf16* pa0 = A + ar0 * lda + (tid & 7) * 8; const bf16* pa1 = A + ar1 * lda + (tid & 7) * 8;
        const bf16* pb0 = Bt + (size_t)(tn * 128 + (tid >> 3)) * ldb + (tid & 7) * 8; const bf16* pb1 = pb0 + (size_t)64 * ldb;
        f32x4 acc[4][2]; tg_zero(acc);
        tg_tile(acc, C.lds, pa0, pa1, pb0, pb1, K / 64);
#pragma unroll
        for (int m = 0; m < 4; ++m)
#pragma unroll
            for (int n = 0; n < 2; ++n) {
                const int row = tm * 128 + wr * 64 + m * 16 + fr, col = tn * 128 + wc * 32 + n * 16 + 4 * fq;
                const f32x4 v = epi_apply(acc[m][n], mode, col, bgk);
                u32x2 w; w.x = pk2(v[0], v[1]); w.y = pk2(v[2], v[3]);
                *(u32x2*)(O + (size_t)row * ldo + col) = w;
            }
    }
}


namespace pg8 {
constexpr int BM = 256, BK = 64, HALF = 128, HTB = HALF * BK * 2, STAGE_BYTES = 8 * HTB;
__device__ __forceinline__ int lds_byte(int r, int c) { return r * 128 + ((((c >> 3) ^ (r >> 1)) & 7) << 4) + (c & 7) * 2; }
__device__ __forceinline__ void stage_rc(int b, int& R, int& C) { R = b >> 7; C = ((((b >> 4) ^ (R >> 1)) & 7) << 3) + ((b & 15) >> 1); }
__device__ __forceinline__ int perm32(int rho) { const int n = rho >> 4, i = rho & 15; return 8 * (i >> 2) + 4 * n + (i & 3); }
struct Unit { int ap, bp, orow, ocol, akb; };
struct Gemm { const bf16* A; const bf16* Bt; int K; const int* rowmap; int lda; };
struct GridOrder {
    int nM, nN, nwg, G, c, vx, pb, rev;
    __device__ __forceinline__ void init(int nM_, int nN_, int G_, int c_) { nM = nM_; nN = nN_; nwg = nM * nN; G = G_; c = c_; vx = -1; pb = 0; rev = 0; }
    __device__ __forceinline__ void init_l(int nMl, int nN_, int vr_, int vx_, int rev_ = 0) { nM = nMl; nN = nN_; nwg = nM * nN; G = 32; c = vr_; vx = vx_; pb = 0; rev = rev_; }
    __device__ __forceinline__ void init_p(int nMl, int nN_, int vr_, int pb_, int rev_ = 0) { nM = nMl; nN = nN_; nwg = nM * nN; G = 32; c = vr_; vx = -2; pb = pb_; rev = rev_; }
    __device__ __forceinline__ bool mn(int i, int& pm, int& pn) const {
        const long L = (long)i * G + c; if (L >= nwg) return false;
        int wgid = (int)L; if (vx == -1) { const int q = nwg / 8, r = nwg % 8, xcd = wgid % 8, off = wgid / 8; wgid = (xcd < r ? xcd * (q + 1) : r * (q + 1) + (xcd - r) * q) + off; }
        const int nig = 8 * nN, gid = wgid / nig, fm = gid * 8, gsz = (nM - fm) < 8 ? (nM - fm) : 8;
        pm = fm + ((wgid % nig) % gsz); pn = (wgid % nig) / gsz;
        if (rev) pm = nM - 1 - pm;
        if (vx >= 0) pm = pm < 16 ? 16 * vx + pm : 128 + 2 * vx + (pm - 16); else if (vx == -2) pm += pb;
        return true;
    }
};
__device__ __forceinline__ unsigned cvt_pk_bf16(float lo, float hi) { unsigned r; asm volatile("v_cvt_pk_bf16_f32 %0, %1, %2" : "=v"(r) : "v"(lo), "v"(hi)); return r; }

typedef int i32x4 __attribute__((ext_vector_type(4)));
template <class Epi, class Sched, bool GATHER, bool F8 = false>
__device__ __forceinline__ void gemm_phase(LAS unsigned char* lds, const Gemm g, const Sched& S, const Epi& E) {
    const int tid = otid(), wid = __builtin_amdgcn_readfirstlane(tid >> 6), lane = tid & 63, wr = wid >> 2, wc = wid & 3, fr = lane & 15, fq = lane >> 4;
    const int K = g.K, nt = K / BK;
    int Rl[2]; unsigned Cb[2], voffB[2];
#pragma unroll
    for (int i = 0; i < 2; ++i) { int R, Cc; stage_rc(tid * 16 + i * 8192, R, Cc); const int Rb = (R & ~31) + perm32(R & 31); Rl[i] = R; Cb[i] = (unsigned)Cc * 2u; voffB[i] = (unsigned)(Rb * K + Cc) * 2u; }
    const size_t kstep = (size_t)(BK * 2), hstep = (size_t)HALF * K * 2, tstep = 2 * hstep;
    const unsigned ldsw = (unsigned)wid * 1024u;
    const int aoff0 = lds_byte(wr * 64 + fr, fq * 8), aoff1 = lds_byte(wr * 64 + fr, 32 + fq * 8), boff0 = lds_byte(wc * 32 + fr, fq * 8), boff1 = lds_byte(wc * 32 + fr, 32 + fq * 8);
#define PG8_SA(b, h) (((b) * 2 + (h)) * HTB)
#define PG8_SB(b, h) ((4 + (b) * 2 + (h)) * HTB)
#define PG8_STAGE(bufoff, gbase, voff) do { _Pragma("unroll") for (int _i = 0; _i < 2; ++_i) \
        __builtin_amdgcn_global_load_lds((const unsigned*)((const char*)(gbase) + (voff)[_i]), (LAS unsigned*)(lds + (bufoff) + ldsw + _i * 8192), 16, 0, 0); } while (0)
#define PG8_LDA(dst, b, h) do { _Pragma("unroll") for (int m = 0; m < 4; ++m) { dst[m][0] = *(const LAS bf16x8*)(lds + PG8_SA(b, h) + aoff0 + m * 2048); dst[m][1] = *(const LAS bf16x8*)(lds + PG8_SA(b, h) + aoff1 + m * 2048); } } while (0)
#define PG8_LDB(dst, b, h) do { _Pragma("unroll") for (int n = 0; n < 2; ++n) { dst[n][0] = *(const LAS bf16x8*)(lds + PG8_SB(b, h) + boff0 + n * 2048); dst[n][1] = *(const LAS bf16x8*)(lds + PG8_SB(b, h) + boff1 + n * 2048); } } while (0)
#define PG8_MMA(ai, bj, At, Bt) do { __builtin_amdgcn_s_setprio(1); _Pragma("unroll") for (int m = 0; m < 4; ++m) _Pragma("unroll") for (int n = 0; n < 2; ++n) { \
        if (F8) { const i32x4 b0_ = __builtin_bit_cast(i32x4, Bt[n][0]), b1_ = __builtin_bit_cast(i32x4, Bt[n][1]), a0_ = __builtin_bit_cast(i32x4, At[m][0]), a1_ = __builtin_bit_cast(i32x4, At[m][1]); \
            acc[ai][bj][m][n] = __builtin_amdgcn_mfma_scale_f32_16x16x128_f8f6f4(__builtin_shufflevector(b0_, b1_, 0, 1, 2, 3, 4, 5, 6, 7), __builtin_shufflevector(a0_, a1_, 0, 1, 2, 3, 4, 5, 6, 7), acc[ai][bj][m][n], 0, 0, 0, 0x7F7F7F7F, 0, 0x7F7F7F7F); } \
        else { _Pragma("unroll") for (int k = 0; k < 2; ++k) acc[ai][bj][m][n] = __builtin_amdgcn_mfma_f32_16x16x32_bf16(Bt[n][k], At[m][k], acc[ai][bj][m][n], 0, 0, 0); } } __builtin_amdgcn_s_setprio(0); } while (0)
#define PG8_WAIT_V(n) asm volatile("s_waitcnt vmcnt(" #n ")" ::: "memory")
#define PG8_WAIT_L(n) asm volatile("s_waitcnt lgkmcnt(" #n ")" ::: "memory")
#define PG8_WAIT_VF() do { (void)fresh; PG8_WAIT_V(8); } while (0)
#define PG8_BAR __builtin_amdgcn_s_barrier()
#define PG8_SCHED __builtin_amdgcn_sched_barrier(0)
#define PG8_AOFF(dst, u) do { _Pragma("unroll") for (int _h = 0; _h < 2; ++_h) _Pragma("unroll") for (int _i = 0; _i < 2; ++_i) { \
        const int _r = (u).ap * BM + _h * HALF + Rl[_i]; const unsigned _row = GATHER ? (unsigned)g.rowmap[_r] : (unsigned)_r; dst[_h][_i] = _row * (unsigned)(g.lda * 2) + Cb[_i] + (unsigned)(u).akb; } } while (0)
    Unit cur, nxt; int ui = 0;
    if (!S.next(0, cur)) return;
    f32x4 acc[2][2][4][2];
#pragma unroll
    for (int a = 0; a < 2; ++a)
#pragma unroll
        for (int b = 0; b < 2; ++b)
#pragma unroll
            for (int m = 0; m < 4; ++m)
#pragma unroll
                for (int n = 0; n < 2; ++n) acc[a][b][m][n] = (f32x4){0.f, 0.f, 0.f, 0.f};
    bf16x8 At[4][2], B0[2][2], B1[2][2];
    unsigned ao[2][2], nao[2][2]; bool fresh = false;
    PG8_AOFF(ao, cur);
    const char* Ab = (const char*)g.A;
    const char* cB = (const char*)g.Bt + (size_t)cur.bp * tstep;
    PG8_STAGE(PG8_SB(0, 0), cB, voffB); PG8_STAGE(PG8_SB(0, 1), cB + hstep, voffB); PG8_STAGE(PG8_SA(0, 0), Ab, ao[0]); PG8_STAGE(PG8_SA(0, 1), Ab, ao[1]);
    if (wr == 1) PG8_BAR;
    PG8_WAIT_V(2); PG8_BAR;
    PG8_STAGE(PG8_SB(1, 0), cB + kstep, voffB); PG8_STAGE(PG8_SA(1, 0), Ab + kstep, ao[0]); PG8_STAGE(PG8_SB(1, 1), cB + hstep + kstep, voffB);
    PG8_WAIT_V(6); PG8_BAR;
    for (;;) {
        const bool has_next = S.next(ui + 1, nxt);
        if (has_next) { PG8_AOFF(nao, nxt); }
        else {
#pragma unroll
            for (int _h = 0; _h < 2; ++_h)
#pragma unroll
                for (int _i = 0; _i < 2; ++_i) nao[_h][_i] = ao[_h][_i]; }
        const char* nB = has_next ? (const char*)g.Bt + (size_t)nxt.bp * tstep : cB;
#pragma unroll 1
        for (int t = 0; t < nt; t += 2) {
            const bool last = (t == nt - 2);
            const char* a1 = Ab + (size_t)(t + 1) * kstep;
            const char* a2 = last ? Ab : Ab + (size_t)(t + 2) * kstep; const char* b2 = last ? nB : cB + (size_t)(t + 2) * kstep;
            const char* a3 = a2 + kstep; const char* b3 = b2 + kstep;
            PG8_LDB(B0, 0, 0); PG8_LDB(B1, 0, 1); PG8_SCHED; PG8_LDA(At, 0, 0); PG8_STAGE(PG8_SA(1, 1), a1, ao[1]);
            if (last) {
#pragma unroll
                for (int _h = 0; _h < 2; ++_h)
#pragma unroll
                    for (int _i = 0; _i < 2; ++_i) ao[_h][_i] = nao[_h][_i]; }
            PG8_WAIT_VF(); PG8_WAIT_L(0); PG8_BAR; PG8_MMA(0, 0, At, B0); PG8_MMA(0, 1, At, B1); PG8_BAR; PG8_SCHED;
            PG8_LDA(At, 0, 1); PG8_STAGE(PG8_SB(0, 0), b2, voffB); PG8_STAGE(PG8_SB(0, 1), b2 + hstep, voffB); PG8_STAGE(PG8_SA(0, 0), a2, ao[0]);
            PG8_WAIT_VF(); PG8_WAIT_L(0); PG8_BAR; PG8_MMA(1, 0, At, B0); PG8_MMA(1, 1, At, B1); PG8_BAR; PG8_SCHED;
            fresh = false;
            PG8_LDB(B0, 1, 0); PG8_LDB(B1, 1, 1); PG8_SCHED; PG8_LDA(At, 1, 0); PG8_STAGE(PG8_SA(0, 1), a2, ao[1]);
            PG8_WAIT_V(8); PG8_WAIT_L(0); PG8_BAR; PG8_MMA(0, 0, At, B0); PG8_MMA(0, 1, At, B1); PG8_BAR; PG8_SCHED;
            PG8_LDA(At, 1, 1); PG8_STAGE(PG8_SB(1, 0), b3, voffB); PG8_STAGE(PG8_SB(1, 1), b3 + hstep, voffB); PG8_STAGE(PG8_SA(1, 0), a3, ao[0]);
            PG8_WAIT_V(8); PG8_WAIT_L(0); PG8_BAR; PG8_MMA(1, 0, At, B0); PG8_MMA(1, 1, At, B1); PG8_BAR; PG8_SCHED;
        }
        if (wr == 0) PG8_BAR;
        E(acc, cur, wr, wc, fr, fq);
        if (PROBE == 12) { asm volatile("" ::: "memory"); E(acc, cur, wr, wc, fr, fq); }
        if (!has_next) break;
#pragma unroll
        for (int a = 0; a < 2; ++a)
#pragma unroll
            for (int b = 0; b < 2; ++b)
#pragma unroll
                for (int m = 0; m < 4; ++m)
#pragma unroll
                    for (int n = 0; n < 2; ++n) acc[a][b][m][n] = (f32x4){0.f, 0.f, 0.f, 0.f};
        cur = nxt; cB = nB; ++ui; fresh = true;
        if (wr == 1) PG8_BAR;
    }
    PG8_WAIT_V(0);
    PG8_BAR;
#undef PG8_SA
#undef PG8_SB
#undef PG8_STAGE
#undef PG8_LDA
#undef PG8_LDB
#undef PG8_MMA
#undef PG8_WAIT_V
#undef PG8_WAIT_L
#undef PG8_WAIT_VF
#undef PG8_BAR
#undef PG8_SCHED
#undef PG8_AOFF
}
struct EpiAct {
    static constexpr int NVM = 16;
    bf16* O; int ldo; int mode; const float* bgk;
    __device__ __forceinline__ void operator()(const f32x4 (&acc)[2][2][4][2], const Unit& u, int wr, int wc, int fr, int fq) const {
#pragma unroll
        for (int ai = 0; ai < 2; ++ai)
#pragma unroll
            for (int m = 0; m < 4; ++m) { bf16* rowp = O + (size_t)(u.orow + ai * HALF + wr * 64 + m * 16 + fr) * ldo + u.ocol + wc * 32 + 8 * fq;
#pragma unroll
                for (int bj = 0; bj < 2; ++bj) { const int col = u.ocol + bj * HALF + wc * 32 + 8 * fq;
                    const f32x4 v0 = epi_apply(acc[ai][bj][m][0], mode, col, bgk), v1 = epi_apply(acc[ai][bj][m][1], mode, col + 4, bgk);
                    u32x4 w; w.x = cvt_pk_bf16(v0[0], v0[1]); w.y = cvt_pk_bf16(v0[2], v0[3]); w.z = cvt_pk_bf16(v1[0], v1[1]); w.w = cvt_pk_bf16(v1[2], v1[3]);
                    *(u32x4*)(rowp + bj * HALF) = w; } }
    }
};
__device__ __forceinline__ size_t p_index(size_t row, int i, int c) { return row * 4096 + (size_t)((c >> 6) * 256 + ((c >> 5) & 1) * 128 + i * 32 + (c & 31)); }
struct EpiP {
    static constexpr int NVM = 16;
    bf16* O;
    __device__ __forceinline__ void operator()(const f32x4 (&acc)[2][2][4][2], const Unit& u, int wr, int wc, int fr, int fq) const {
        const int i = u.ocol >> 10, c0 = (u.ocol & 1023) + wc * 32 + 8 * fq;
#pragma unroll
        for (int ai = 0; ai < 2; ++ai)
#pragma unroll
            for (int m = 0; m < 4; ++m) { const size_t row = (size_t)(u.orow + ai * HALF + wr * 64 + m * 16 + fr);
#pragma unroll
                for (int bj = 0; bj < 2; ++bj) { const f32x4 v0 = acc[ai][bj][m][0], v1 = acc[ai][bj][m][1];
                    u32x4 w; w.x = cvt_pk_bf16(v0[0], v0[1]); w.y = cvt_pk_bf16(v0[2], v0[3]); w.z = cvt_pk_bf16(v1[0], v1[1]); w.w = cvt_pk_bf16(v1[2], v1[3]);
                    *(u32x4*)(O + p_index(row, i, c0 + bj * HALF)) = w; } }
    }
};
struct EpiCols {
    static constexpr int NVM = 16;
    bf16* O;
    __device__ __forceinline__ void operator()(const f32x4 (&acc)[2][2][4][2], const Unit& u, int wr, int wc, int fr, int fq) const {
        const int tile = __builtin_amdgcn_readfirstlane(u.ocol >> 8);
        f32x4 bv[2][2];
        if (tile == 3) {
#pragma unroll
            for (int bj = 0; bj < 2; ++bj)
#pragma unroll
                for (int n = 0; n < 2; ++n) bv[bj][n] = *(const LAS f32x4*)((LAS unsigned char*)131072 + (bj * HALF + wc * 32 + 8 * fq + 4 * n) * 4);
        }
#pragma unroll
        for (int ai = 0; ai < 2; ++ai)
#pragma unroll
            for (int m = 0; m < 4; ++m) { bf16* rowp = O + (size_t)(u.orow + ai * HALF + wr * 64 + m * 16 + fr) * NINP + u.ocol + wc * 32 + 8 * fq;
#pragma unroll
                for (int bj = 0; bj < 2; ++bj) { f32x4 v0 = acc[ai][bj][m][0], v1 = acc[ai][bj][m][1];
                    if (tile == 0) { if (bj == 0) { v0 = v0 * 0.17677669529663689f; v1 = v1 * 0.17677669529663689f; } }
                    else if (tile == 2) {
#pragma unroll
                        for (int j = 0; j < 4; ++j) { v0[j] = siluf_(v0[j]); v1[j] = siluf_(v1[j]); } }
                    else if (tile == 3) {
#pragma unroll
                        for (int j = 0; j < 4; ++j) { v0[j] = logsigmoidf_(v0[j] + bv[bj][0][j]) * 0.0625f; v1[j] = logsigmoidf_(v1[j] + bv[bj][1][j]) * 0.0625f; } }
                    else if (tile >= 6) {
#pragma unroll
                        for (int j = 0; j < 4; ++j) { v0[j] = gelu_tanh_(v0[j]); v1[j] = gelu_tanh_(v1[j]); } }
                    u32x4 w; w.x = cvt_pk_bf16(v0[0], v0[1]); w.y = cvt_pk_bf16(v0[2], v0[3]); w.z = cvt_pk_bf16(v1[0], v1[1]); w.w = cvt_pk_bf16(v1[2], v1[3]);
                    *(u32x4*)(rowp + bj * HALF) = w; } }
    }
};
struct EpiGateMix {
    static constexpr int NVM = 8;
    const bf16* P; bf16* MMo; float gs;
    __device__ __forceinline__ void operator()(const f32x4 (&acc)[2][2][4][2], const Unit& u, int wr, int wc, int fr, int fq) const {
        const int col = (u.ocol >> 2) + wc * 16 + 4 * fq;
#pragma unroll
        for (int ai = 0; ai < 2; ++ai) {
            u32x2 pw[4][4];
#pragma unroll
            for (int m = 0; m < 4; ++m) { const size_t row = (size_t)(u.orow + ai * HALF + wr * 64 + m * 16 + fr);
#pragma unroll
                for (int i = 0; i < 4; ++i) pw[m][i] = *(const u32x2*)(P + p_index(row, i, col)); }
#pragma unroll
            for (int m = 0; m < 4; ++m) { const size_t row = (size_t)(u.orow + ai * HALF + wr * 64 + m * 16 + fr);
                f32x2 s01 = (f32x2){0.f, 0.f}, s23 = s01; const float kc = -1.4426950408889634f * gs;
#pragma unroll
                for (int i = 0; i < 4; ++i) { const f32x4 g = acc[ai][i >> 1][m][i & 1];
                    f32x2 d01 = (f32x2){__builtin_amdgcn_exp2f(g[0] * kc), __builtin_amdgcn_exp2f(g[1] * kc)}, d23 = (f32x2){__builtin_amdgcn_exp2f(g[2] * kc), __builtin_amdgcn_exp2f(g[3] * kc)};
                    d01 = d01 + 1.0f; d23 = d23 + 1.0f;
                    const f32x2 r01 = (f32x2){__builtin_amdgcn_rcpf(d01[0]), __builtin_amdgcn_rcpf(d01[1])}, r23 = (f32x2){__builtin_amdgcn_rcpf(d23[0]), __builtin_amdgcn_rcpf(d23[1])};
                    const f32x2 p01 = (f32x2){bflo(pw[m][i].x), bfhi(pw[m][i].x)}, p23 = (f32x2){bflo(pw[m][i].y), bfhi(pw[m][i].y)};
                    s01 = r01 * p01 + s01; s23 = r23 * p23 + s23; }
                f32x4 s; s[0] = s01[0]; s[1] = s01[1]; s[2] = s23[0]; s[3] = s23[1];
                u32x2 w; w.x = cvt_pk_bf16(s[0], s[1]); w.y = cvt_pk_bf16(s[2], s[3]);
                *(u32x2*)(MMo + row * D + col) = w; } }
    }
};
struct EpiSwiGLU {
    static constexpr int NVM = 8;
    bf16* O; int ldo; float gs; float o8;
    __device__ __forceinline__ void operator()(const f32x4 (&acc)[2][2][4][2], const Unit& u, int wr, int wc, int fr, int fq) const {
#pragma unroll
        for (int ai = 0; ai < 2; ++ai)
#pragma unroll
            for (int m = 0; m < 4; ++m) { bf16* rowp = O + (size_t)(u.orow + ai * HALF + wr * 64 + m * 16 + fr) * ldo + u.ocol + wc * 32 + 8 * fq;
                f32x4 v0, v1;
                { const float kc = -1.4426950408889634f * gs, g2 = gs * gs * (o8 > 0.f ? o8 : 1.0f);
                  const f32x4 ga = acc[ai][0][m][0], gb = acc[ai][0][m][1], ua = acc[ai][1][m][0], ub = acc[ai][1][m][1];
                  f32x4 da, db;
#pragma unroll
                  for (int j = 0; j < 4; ++j) { da[j] = __builtin_amdgcn_exp2f(ga[j] * kc); db[j] = __builtin_amdgcn_exp2f(gb[j] * kc); }
                  da = da + 1.0f; db = db + 1.0f;
#pragma unroll
                  for (int j = 0; j < 4; ++j) { da[j] = __builtin_amdgcn_rcpf(da[j]); db[j] = __builtin_amdgcn_rcpf(db[j]); }
                  v0 = (ga * ua) * (da * g2); v1 = (gb * ub) * (db * g2); }
                if (o8 > 0.f) { u32x2 w; w.x = pk4_fp8(v0[0], v0[1], v0[2], v0[3]); w.y = pk4_fp8(v1[0], v1[1], v1[2], v1[3]);
                    *(u32x2*)((unsigned char*)O + (size_t)(u.orow + ai * HALF + wr * 64 + m * 16 + fr) * ldo + u.ocol + wc * 32 + 8 * fq) = w; }
                else { u32x4 w; w.x = cvt_pk_bf16(v0[0], v0[1]); w.y = cvt_pk_bf16(v0[2], v0[3]); w.z = cvt_pk_bf16(v1[0], v1[1]); w.w = cvt_pk_bf16(v1[2], v1[3]);
                    *(u32x4*)rowp = w; } }
    }
};
struct EpiScale {
    static constexpr int NVM = 16;
    bf16* O; int ldo; float gs;
    __device__ __forceinline__ void operator()(const f32x4 (&acc)[2][2][4][2], const Unit& u, int wr, int wc, int fr, int fq) const {
#pragma unroll
        for (int ai = 0; ai < 2; ++ai)
#pragma unroll
            for (int m = 0; m < 4; ++m) { bf16* rowp = O + (size_t)(u.orow + ai * HALF + wr * 64 + m * 16 + fr) * ldo + u.ocol + wc * 32 + 8 * fq;
#pragma unroll
                for (int bj = 0; bj < 2; ++bj) { const f32x4 v0 = acc[ai][bj][m][0] * gs, v1 = acc[ai][bj][m][1] * gs;
                    u32x4 w; w.x = cvt_pk_bf16(v0[0], v0[1]); w.y = cvt_pk_bf16(v0[2], v0[3]); w.z = cvt_pk_bf16(v1[0], v1[1]); w.w = cvt_pk_bf16(v1[2], v1[3]);
                    *(u32x4*)(rowp + bj * HALF) = w; } }
    }
};
template <int KIND> struct Sched {
    GridOrder go; int bp0, p0; const int* pe;
    __device__ __forceinline__ bool next(int i, Unit& u) const {
        int pm, pn; if (!go.mn(i, pm, pn)) return false;
        u.akb = 0;
        if (KIND == 0) { u.ap = pm; u.bp = bp0 + pn; u.orow = pm * BM; u.ocol = pn * BM; }
        else if (KIND == 4) { const int i = pn & 3, cp = pn >> 2; u.ap = pm; u.bp = i * 4 + cp; u.orow = pm * BM; u.ocol = i * 1024 + cp * BM; u.akb = i * 512; }
        else if (KIND == 1) { u.ap = pm; u.bp = pn; u.orow = pn * 2048 + pm * BM; u.ocol = 512; }
        else if (KIND == 2) { const int e = pe ? pe[p0 + pm] : 0; u.ap = p0 + pm; u.bp = e * 44 + pn; u.orow = pm * BM; u.ocol = pn * HALF; }
        else { const int e = pe ? pe[p0 + pm] : 0; u.ap = pm; u.bp = e * bp0 + pn; u.orow = (p0 + pm) * BM; u.ocol = pn * BM; }
        return true;
    }
};
}

__device__ __forceinline__ int gate_row(int i, int cc) { return 256 * (cc >> 6) + 128 * (i >> 1) + 32 * ((cc >> 4) & 3) + 8 * ((cc >> 2) & 3) + 4 * (i & 1) + (cc & 3); }
__device__ __forceinline__ void xpose_item(const float* W, int ldw, int k0, int n0, bf16* WT, int ldk, int drow0, LAS float* scr, int lane, int gate_i = -1) {
#pragma unroll 8
    for (int i = 0; i < 32; ++i) { const int kk = 2 * i + (lane >> 5); scr[kk * 33 + (lane & 31)] = W[(size_t)(k0 + kk) * ldw + n0 + (lane & 31)]; }
    asm volatile("s_waitcnt lgkmcnt(0)" ::: "memory");
    const int c = lane & 7;
#pragma unroll
    for (int j = 0; j < 4; ++j) { const int n = (lane >> 3) + 8 * j; const LAS float* s = scr + (8 * c) * 33 + n;
        u32x4 o; o.x = pk2(s[0 * 33], s[1 * 33]); o.y = pk2(s[2 * 33], s[3 * 33]); o.z = pk2(s[4 * 33], s[5 * 33]); o.w = pk2(s[6 * 33], s[7 * 33]);
        const int drow = gate_i < 0 ? drow0 + n : drow0 + gate_row(gate_i, n0 + n);
        *(u32x4*)(WT + (size_t)drow * ldk + k0 + 8 * c) = o; }
    asm volatile("s_waitcnt lgkmcnt(0)" ::: "memory");
}
__device__ __forceinline__ void xpose_item_fp8(const float* W, int ldw, int k0, int n0, unsigned char* WT, int ldk, LAS float* scr, int lane, int gate_i, float scale, int drow0 = 0) {
#pragma unroll 8
    for (int i = 0; i < 32; ++i) { const int kk = 2 * i + (lane >> 5); scr[kk * 33 + (lane & 31)] = W[(size_t)(k0 + kk) * ldw + n0 + (lane & 31)]; }
    asm volatile("s_waitcnt lgkmcnt(0)" ::: "memory");
    const int c = lane & 7;
#pragma unroll
    for (int j = 0; j < 4; ++j) { const int n = (lane >> 3) + 8 * j; const LAS float* s = scr + (8 * c) * 33 + n;
        u32x2 o; o.x = pk4_fp8(s[0 * 33] * scale, s[1 * 33] * scale, s[2 * 33] * scale, s[3 * 33] * scale); o.y = pk4_fp8(s[4 * 33] * scale, s[5 * 33] * scale, s[6 * 33] * scale, s[7 * 33] * scale);
        const int drow = gate_i < 0 ? drow0 + n : gate_row(gate_i, n0 + n);
        *(u32x2*)(WT + (size_t)drow * ldk + k0 + 8 * c) = o; }
    asm volatile("s_waitcnt lgkmcnt(0)" ::: "memory");
}
__device__ __forceinline__ void xpose_dispatch(const Ctx& C, int it, LAS float* scr) {
    const float* const* in = oin(C.in_); const int lane = otid() & 63;
    if (it < 4 * 768) { const int l = it / 768, r = it % 768, part = r / 384, q = r % 384, kb = q / 24, nb = q % 24;
        const int n0 = (part ? 1056 : 0) + nb * 32, drow = (part ? 1280 : 0) + nb * 32;
        xpose_item(in[6] + (size_t)l * D * NIN, NIN, kb * 64, n0, wW(C, WE_WIN + (size_t)l * 6144 * 1024), 1024, drow, scr, lane); return; }
    it -= 4 * 768;
    if (it < 16 * 512) { const int li = it / 512, q = it % 512, kb = q / 32, nb = q % 32, l = li >> 2, i = li & 3;
        xpose_item_fp8(in[16] + (size_t)li * D * D, D, kb * 64, nb * 32, ows(C.ws_) + WS_G8 + (size_t)l * 4096 * 1024, 1024, scr, lane, i, G8_SCALE); return; }
    it -= 16 * 512;
    if (it < 16 * 128) { const int li = it / 128, q = it % 128, kb = q / 32, nb = q % 32;
        xpose_item(in[17] + (size_t)li * 256 * D, D, kb * 64, nb * 32, wW(C, WE_WBR + (size_t)li * 1024 * 256), 256, nb * 32, scr, lane); return; }
    it -= 16 * 128;
    if (it < 4 * 512) { const int l = it / 512, q = it % 512, kb = q / 32, nb = q % 32;
        xpose_item(in[18] + (size_t)l * D * D, D, kb * 64, nb * 32, wW(C, WE_WO + (size_t)l * D * D), 1024, nb * 32, scr, lane); return; }
    it -= 4 * 512;
    if (it < 4 * 1408) { const int jw = it / 1408, q = it % 1408, kb = q / 88, nb = q % 88, j = jw >> 1, which = jw & 1, n0 = nb * 32;
        xpose_item_fp8(in[which ? 22 : 21] + (size_t)j * D * DFF, DFF, kb * 64, n0, (unsigned char*)wW(C, WE_GUD + (size_t)j * 5632 * 1024), 1024, scr, lane, -1, G8_SCALE, (n0 >> 7) * 256 + which * 128 + (n0 & 127)); return; }
    it -= 4 * 1408;
    if (it < 2 * 1408) { const int j = it / 1408, q = it % 1408, kb = q / 32, nb = q % 32;
        if (DOWN8_DENSE) xpose_item_fp8(in[23] + (size_t)j * DFF * D, D, kb * 64, nb * 32, (unsigned char*)wW(C, WE_DD + (size_t)j * 1024 * 2816), 2816, scr, lane, -1, G8_SCALE, nb * 32);
        else xpose_item(in[23] + (size_t)j * DFF * D, D, kb * 64, nb * 32, wW(C, WE_DD + (size_t)j * 1024 * 2816), 2816, nb * 32, scr, lane); return; }
    it -= 2 * 1408;
    (void)it;
}
constexpr int XPE_GU = 16 * 1408, XPE_ALL = 24 * 1408;
constexpr bool DEFER_EXPERT_CONV = false;
__device__ __forceinline__ void xpose_expert(const Ctx& C, int jm, int idx, LAS float* scr, int lane) {
    const float* const* in = oin(C.in_);
    if (idx < XPE_GU) { const int ew = idx / 1408, q = idx % 1408, kb = q / 88, nb = q % 88, e = ew >> 1, which = ew & 1, n0 = nb * 32, je = jm * 8 + e;
        xpose_item_fp8(in[which ? 26 : 25] + (size_t)je * D * DFF, DFF, kb * 64, n0, (unsigned char*)wW(C, WE_GUE + (size_t)je * 5632 * 1024), 1024, scr, lane, -1, G8_SCALE, (n0 >> 7) * 256 + which * 128 + (n0 & 127)); }
    else { const int i2 = idx - XPE_GU, e = i2 / 1408, q = i2 % 1408, kb = q / 32, nb = q % 32, je = jm * 8 + e;
        if (DOWN8_MOE) xpose_item_fp8(in[27] + (size_t)je * DFF * D, D, kb * 64, nb * 32, (unsigned char*)wW(C, WE_DE + (size_t)je * 1024 * 2816), 2816, scr, lane, -1, G8_SCALE, nb * 32);
        else xpose_item(in[27] + (size_t)je * DFF * D, D, kb * 64, nb * 32, wW(C, WE_DE + (size_t)je * 1024 * 2816), 2816, nb * 32, scr, lane); }
}
__device__ __forceinline__ void expert_convert_share(const Ctx& C, int jm, int i0, int i1, int first_blk) {
    const int blk = oblk(); if (blk < first_blk) return;
    const int wave = owave(), lane = otid() & 63; LAS float* scr = (LAS float*)(C.lds + wave * 16384);
    const int nw = (ogrid() - first_blk) * NWAVE;
    for (int idx = i0 + (blk - first_blk) * NWAVE + wave; idx < i1; idx += nw) xpose_expert(C, jm, idx, scr, lane);
}
constexpr int XPOSE_ITEMS = 4 * 768 + 16 * 512 + 16 * 128 + 4 * 512 + 4 * 1408 + 2 * 1408;

__device__ __forceinline__ void p_prologue(const Ctx& C) {
    const float* const* in = oin(C.in_); const int tid = otid();
    { LAS float* scr = (LAS float*)(C.lds + owave() * 16384);
      const int gw = oblk() * NWAVE + owave(), NGW = ogrid() * NWAVE;
      for (int it = gw; it < XPOSE_ITEMS; it += NGW) xpose_dispatch(C, it, scr);
      if (!DEFER_EXPERT_CONV) for (int it = gw; it < 2 * XPE_ALL; it += NGW) xpose_expert(C, it / XPE_ALL, it % XPE_ALL, scr, otid() & 63); }
    { const size_t gt = (size_t)oblk() * NTHR + tid, NT = (size_t)ogrid() * NTHR;
      for (size_t o = gt; o < (size_t)4 * 512 * 1024; o += NT) {
          const int l = (int)(o >> 19), n = (int)((o >> 10) & 511), k = (int)(o & 1023);
          const float* wi = in[6] + ((size_t)l * D + k) * NIN; float s = 0.f;
          if (n < 256) { const int dir = n >> 7, nn = n & 127; const float* w2 = in[7] + ((size_t)(l * 2 + dir) * 16) * 128 + nn;
              for (int c = 0; c < 16; ++c) s += wi[768 + 16 * dir + c] * w2[c * 128]; }
          else { const int nn = n - 256, gi = nn >> 6, d = nn & 63; const float* pw = in[10] + ((size_t)(l * 4 + gi) * 64) * 64 + d;
              for (int c = 0; c < 64; ++c) s += wi[800 + 64 * gi + c] * pw[c * 64]; }
          wW(C, WE_WIN + (size_t)l * 6144 * 1024)[(size_t)(768 + n) * 1024 + k] = (bf16)f2bf(s);
      } }
    { const size_t gt = (size_t)oblk() * NTHR + tid, NT = (size_t)ogrid() * NTHR;
      { int* idt = (int*)(ows(C.ws_) + WS_ROUTE) + RT_IDT; for (size_t o = gt; o < (size_t)M; o += NT) idt[o] = (int)o; }
      { bf16* sw = wsb(C, WS_SGUW); const float* src = in[14]; for (size_t o = gt; o < (size_t)4 * 4 * 128 * 128; o += NT) sw[o] = (bf16)f2bf(src[o]); }
      { bf16* TF1 = wsb(C, WS_TF1); bf16* TF2 = wsb(C, WS_TF2); float* TW = (float*)(ows(C.ws_) + WS_TW); const float sc = 0.0027621358640099515f;
        for (size_t o = gt; o < (size_t)4 * 2 * 64 * 8; o += NT) { const int x = (int)(o & 7), lane = (int)((o >> 3) & 63), ks = (int)((o >> 9) & 1), ct = (int)(o >> 10), lr = lane & 15, lq = lane >> 4;
            const int po = ct >> 1, c = 16 * (ct & 1) + lr, a = 8 * lq + x; float sn, cs; sincospif((float)((c * a) & 31) * (1.0f / 16.0f), &sn, &cs);
            const float v = po == 0 ? (ks == 0 ? cs : sn) : (ks == 0 ? -sn : cs); TF1[o] = (bf16)f2bf(v); }
        for (size_t o = gt; o < (size_t)2 * 4 * 2 * 64 * 8; o += NT) { const int x = (int)(o & 7), lane = (int)((o >> 3) & 63), ks = (int)((o >> 9) & 1), dt = (int)((o >> 10) & 3), part = (int)(o >> 12), lr = lane & 15, lq = lane >> 4;
            const int d = 16 * dt + lr, bb = 32 * ks + (x < 4 ? 4 * lq + x : 16 + 4 * lq + (x - 4)); float sn, cs; sincospif((float)((d * bb) & 63) * (1.0f / 32.0f), &sn, &cs);
            TF2[o] = (bf16)f2bf((part == 0 ? cs : sn) * sc); }
        for (size_t o = gt; o < (size_t)4 * 2 * 4 * 64; o += NT) { const int lane = (int)(o & 63), r = (int)((o >> 6) & 3), ct = (int)((o >> 8) & 1), rt = (int)(o >> 9), lr = lane & 15, lq = lane >> 4;
            const int bb = 16 * rt + 4 * lq + r, c = 16 * ct + lr; float sn, cs; sincospif((float)(c * bb) * (1.0f / 1024.0f), &sn, &cs); TW[2 * o] = cs; TW[2 * o + 1] = sn; } }
      bf16* DLC = wsb(C, WS_DLC);
      for (size_t o = gt; o < (size_t)256 * 512; o += NT) { const int k = (int)(o >> 9), kk = (int)(o & 511), t = kk & 255; const int idx = (k * t) & 255; float sn, cs; sincospif((float)idx * (1.0f / 128.0f), &sn, &cs);
          DLC[o] = (bf16)f2bf((kk < 256 ? cs : sn) * 0.0078125f); }
      bf16* CS = wsb(C, WS_CS64);
      for (size_t o = gt; o < (size_t)128 * 64; o += NT) { const int pm = (int)(o >> 6), c = (int)(o & 63), m = pm & 63; const int idx = (m * c) & 63; float sn, cs; sincospif((float)idx * (1.0f / 32.0f), &sn, &cs);
          CS[o] = (bf16)f2bf(pm < 64 ? cs : -sn); } }
    __syncthreads();
    { LAS float* S = (LAS float*)C.lds;
      LAS float* RED = (LAS float*)(C.lds + 17 * 1024 * 4);
      for (int i = tid; i < 17 * 1024; i += NTHR) { const int r = i >> 10, k = i & 1023; const float v = r < 16 ? in[1][r * 1024 + k] : in[3][k]; S[i] = siluf_(v); }
      __syncthreads();
      for (int it = oblk(); it < 4 * 96; it += ogrid()) {
          const int l = it / 96, jb = it % 96, j = tid & 63, kg = tid >> 6;
          float acc[17];
#pragma unroll
          for (int r = 0; r < 17; ++r) acc[r] = 0.f;
          const float* wp = in[4] + ((size_t)l * D + kg * 128) * 6144 + jb * 64 + j;
          for (int kk = 0; kk < 128; ++kk) { const float w = wp[(size_t)kk * 6144];
#pragma unroll
              for (int r = 0; r < 17; ++r) acc[r] += S[r * 1024 + kg * 128 + kk] * w; }
#pragma unroll
          for (int r = 0; r < 17; ++r) RED[(kg * 17 + r) * 64 + j] = acc[r];
          __syncthreads();
          for (int o = tid; o < 17 * 64; o += NTHR) { const int r = o >> 6, jj = o & 63; float s = 0.f;
              for (int g = 0; g < 8; ++g) s += RED[(g * 17 + r) * 64 + jj];
              ((float*)(ows(C.ws_) + WS_MOD))[(size_t)(l * 17 + r) * 6144 + jb * 64 + jj] = s + in[5][(size_t)l * 6144 + jb * 64 + jj]; }
          __syncthreads();
      } }
}

struct RowV { f32x4 v[4]; };
__device__ __forceinline__ void row_ln(RowV& x, int  ) {
    float s = 0.f;
#pragma unroll
    for (int j = 0; j < 4; ++j) s += (x.v[j][0] + x.v[j][1]) + (x.v[j][2] + x.v[j][3]);
    const float mean = wave_sum(s) * (1.f / D); float q = 0.f;
#pragma unroll
    for (int j = 0; j < 4; ++j) { x.v[j] = x.v[j] - mean; q += (x.v[j][0] * x.v[j][0] + x.v[j][1] * x.v[j][1]) + (x.v[j][2] * x.v[j][2] + x.v[j][3] * x.v[j][3]); }
    const float rstd = __builtin_amdgcn_rsqf(wave_sum(q) * (1.f / D) + EPS);
#pragma unroll
    for (int j = 0; j < 4; ++j) x.v[j] = x.v[j] * rstd;
}
__device__ __forceinline__ void row_load_f32(RowV& x, const float* p, int lane) {
#pragma unroll
    for (int j = 0; j < 4; ++j) x.v[j] = *(const f32x4*)(p + 4 * lane + 256 * j);
}
__device__ __forceinline__ void row_load_bf16(RowV& x, const bf16* p, int lane) {
#pragma unroll
    for (int j = 0; j < 4; ++j) { const u32x2 w = *(const u32x2*)(p + 4 * lane + 256 * j); x.v[j] = (f32x4){bflo(w.x), bfhi(w.x), bflo(w.y), bfhi(w.y)}; }
}
__device__ __forceinline__ void row_store_f32(const RowV& x, float* p, int lane) {
#pragma unroll
    for (int j = 0; j < 4; ++j) *(f32x4*)(p + 4 * lane + 256 * j) = x.v[j];
}
__device__ __forceinline__ void row_store_fp8(const RowV& x, unsigned char* p, int lane) {
#pragma unroll
    for (int j = 0; j < 4; ++j) { int w = 0; w = __builtin_amdgcn_cvt_pk_fp8_f32(x.v[j][0], x.v[j][1], w, false); w = __builtin_amdgcn_cvt_pk_fp8_f32(x.v[j][2], x.v[j][3], w, true); *(int*)(p + 4 * lane + 256 * j) = w; }
}
__device__ __forceinline__ void row_store_bf16(const RowV& x, bf16* p, int lane) {
#pragma unroll
    for (int j = 0; j < 4; ++j) { u32x2 w; w.x = pk2(x.v[j][0], x.v[j][1]); w.y = pk2(x.v[j][2], x.v[j][3]); *(u32x2*)(p + 4 * lane + 256 * j) = w; }
}
__device__ __forceinline__ void row_mod(RowV& x, const float* shift, const float* scale, int lane) {
#pragma unroll
    for (int j = 0; j < 4; ++j) { const f32x4 sh = *(const f32x4*)(shift + 4 * lane + 256 * j), sc = *(const f32x4*)(scale + 4 * lane + 256 * j); x.v[j] = x.v[j] * (sc + 1.0f) + sh; }
}
__device__ __forceinline__ void row_affine(RowV& x, const float* g, const float* b, int lane) {
#pragma unroll
    for (int j = 0; j < 4; ++j) { const f32x4 gg = *(const f32x4*)(g + 4 * lane + 256 * j), bb = *(const f32x4*)(b + 4 * lane + 256 * j); x.v[j] = x.v[j] * gg + bb; }
}
__device__ __forceinline__ void row_mod_v(RowV& x, const RowV& shift, const RowV& scale) {
#pragma unroll
    for (int j = 0; j < 4; ++j) x.v[j] = x.v[j] * (scale.v[j] + 1.0f) + shift.v[j];
}
__device__ __forceinline__ void row_affine_v(RowV& x, const RowV& g, const RowV& b) {
#pragma unroll
    for (int j = 0; j < 4; ++j) x.v[j] = x.v[j] * g.v[j] + b.v[j];
}
__device__ __forceinline__ float* xrow(const Ctx& C, int m) { return m < MLAT ? oout(C.out_) + (size_t)m * D : (float*)(ows(C.ws_) + WS_XC) + (size_t)(m - MLAT) * D; }
__device__ __forceinline__ bf16* hbuf(const Ctx& C) { return XBF16 ? (bf16*)oout(C.out_) : wsb(C, WS_H); }
__device__ __forceinline__ unsigned char* h8buf(const Ctx& C) { return (unsigned char*)oout(C.out_) + OUT_H8; }
__device__ __forceinline__ const float* x0row(const Ctx& C, int m) { return m < MLAT ? oin(C.in_)[0] + (size_t)m * D : oin(C.in_)[2] + (size_t)(m - MLAT) * D; }

typedef _Float16 h16x2 __attribute__((ext_vector_type(2)));
struct XRaw { f32x4 f[4]; u32x2 h[4]; };
__device__ __forceinline__ void xraw_load(XRaw& R, const Ctx& C, int m, int lane, bool from_input) {
    if (from_input || !XBF16) { const float* p = from_input ? x0row(C, m) : xrow(C, m);
#pragma unroll
        for (int j = 0; j < 4; ++j) R.f[j] = *(const f32x4*)(p + 4 * lane + 256 * j); }
    else { const bf16* p = wsb(C, WS_H) + (size_t)m * D;
#pragma unroll
        for (int j = 0; j < 4; ++j) R.h[j] = *(const u32x2*)(p + 4 * lane + 256 * j); }
}
__device__ __forceinline__ void xraw_get(RowV& x, const XRaw& R, bool from_input) {
    if (from_input || !XBF16) {
#pragma unroll
        for (int j = 0; j < 4; ++j) x.v[j] = R.f[j]; }
    else {
#pragma unroll
        for (int j = 0; j < 4; ++j) { const unsigned wx = R.h[j].x, wy = R.h[j].y;
            const h16x2 a = __builtin_bit_cast(h16x2, wx), b = __builtin_bit_cast(h16x2, wy); x.v[j] = (f32x4){(float)a[0], (float)a[1], (float)b[0], (float)b[1]}; } }
}
__device__ __forceinline__ void yraw_load(u32x2 (&y)[4], const bf16* p, int lane) {
#pragma unroll
    for (int j = 0; j < 4; ++j) y[j] = *(const u32x2*)(p + 4 * lane + 256 * j);
}
__device__ __forceinline__ void yraw_get(RowV& y, const u32x2 (&w)[4]) {
#pragma unroll
    for (int j = 0; j < 4; ++j) y.v[j] = (f32x4){bflo(w[j].x), bfhi(w[j].x), bflo(w[j].y), bfhi(w[j].y)};
}
__device__ __forceinline__ void x_store(const RowV& x, const Ctx& C, int m, int lane) {
    if (XBF16) { bf16* p = wsb(C, WS_H) + (size_t)m * D;
#pragma unroll
        for (int j = 0; j < 4; ++j) { h16x2 a, b; a[0] = (_Float16)x.v[j][0]; a[1] = (_Float16)x.v[j][1]; b[0] = (_Float16)x.v[j][2]; b[1] = (_Float16)x.v[j][3];
            u32x2 w; w.x = __builtin_bit_cast(unsigned, a); w.y = __builtin_bit_cast(unsigned, b); *(u32x2*)(p + 4 * lane + 256 * j) = w; } }
    else row_store_f32(x, xrow(C, m), lane);
}
__device__ __forceinline__ void p_lna(const Ctx& C) {
    const int tid = otid(), lane = tid & 63, wave = owave();
    bf16* H = hbuf(C); const int rpb = M / 256; RowV shv, scv; int rcur = -1;
    const int nrow = rpb / NWAVE, jb = (nrow - 1) * 256 + ovr(C) * NWAVE + wave;
    RowV xn; row_load_f32(xn, x0row(C, lrow(C, jb)), lane);
    for (int k = 0; k < nrow; ++k) { const int m = lrow(C, jb - k * 256), r = row_r(m);
        if (r != rcur) { row_load_f32(shv, modv(C, 0, r, 0), lane); row_load_f32(scv, modv(C, 0, r, 1), lane); rcur = r; }
        RowV x = xn; if (k + 1 < nrow) row_load_f32(xn, x0row(C, lrow(C, jb - (k + 1) * 256)), lane);
        row_ln(x, lane); row_mod_v(x, shv, scv);
        row_store_bf16(x, H + (size_t)m * D, lane); row_store_fp8(x, h8buf(C) + (size_t)m * D, lane);
    }
}
__device__ __forceinline__ void p_lnb(const Ctx& C, int l, int mrows, bool dry = false) {
    const int tid = otid(), lane = tid & 63;
    bf16* H = dry ? wsb(C, WS_R + R_BIG + 152 * MiB) : hbuf(C); const bf16* Y = wsb(C, WS_R + R_YS);
    const bool moe = (l & 1); const int jm = l >> 1;
    const int rpb = mrows / 256;
    LAS float* WR = (LAS float*)C.lds;
    LAS int* LC = (LAS int*)(C.lds + 32768);
    int* rt = (int*)(ows(C.ws_) + WS_ROUTE);
    if (moe) {
        for (int i = tid; i < 8 * 1024; i += NTHR) { const int e = i >> 10, k = i & 1023; WR[i] = oin(C.in_)[24][((size_t)jm * D + k) * NE + e]; }
        if (tid < 8) LC[tid] = 0;
        __syncthreads();
    }
    RowV g2v, shv, scv, lgv, lbv; int rcur = -1;
    row_load_f32(lgv, oin(C.in_)[19] + (size_t)(l * 2 + 0) * D, lane); row_load_f32(lbv, oin(C.in_)[20] + (size_t)(l * 2 + 0) * D, lane);
    const int w0 = owave(), nrow = rpb / NWAVE, jb = ovr(C) * NWAVE + w0, mb = lrow(C, jb); const bool fin = (l == 0);
    XRaw xa; u32x2 ya[4];
    xraw_load(xa, C, mb, lane, fin); yraw_load(ya, Y + (size_t)mb * D, lane);
    XRaw xb = xa; u32x2 yb[4] = {ya[0], ya[1], ya[2], ya[3]};
    for (int k = 0; k < nrow; ++k) {
        const int m = lrow(C, jb + k * 256), mn = lrow(C, k + 1 < nrow ? jb + (k + 1) * 256 : jb), r = row_r(m);
        if (k + 1 < nrow) { xraw_load(xb, C, mn, lane, fin); yraw_load(yb, Y + (size_t)mn * D, lane); }
        if (r != rcur) { row_load_f32(g2v, modv(C, l, r, 2), lane); row_load_f32(shv, modv(C, l, r, 3), lane); row_load_f32(scv, modv(C, l, r, 4), lane); rcur = r; }
        RowV x, y; xraw_get(x, xa, fin); yraw_get(y, ya);
#pragma unroll
        for (int j = 0; j < 4; ++j) x.v[j] = x.v[j] * ALPHA + g2v.v[j] * y.v[j];
        row_ln(x, lane); row_affine_v(x, lgv, lbv);
        if (dry) row_store_f32(x, (float*)(ows(C.ws_) + WS_R + R_BIG) + (size_t)m * D, lane); else x_store(x, C, m, lane);
        row_ln(x, lane); row_mod_v(x, shv, scv);
        row_store_fp8(x, (dry ? (unsigned char*)H : h8buf(C)) + (size_t)m * D, lane);
        if (moe) {
            float lg[8];
#pragma unroll
            for (int e = 0; e < 8; ++e) { float s = 0.f;
#pragma unroll
                for (int j = 0; j < 4; ++j) { const f32x4 w = *(const LAS f32x4*)(WR + e * 1024 + 4 * lane + 256 * j); s += (x.v[j][0] * w[0] + x.v[j][1] * w[1]) + (x.v[j][2] * w[2] + x.v[j][3] * w[3]); }
                lg[e] = wave_sum(s); }
            if (lane == 0 && !dry) {
                int e1 = 0; float v1 = lg[0];
#pragma unroll
                for (int e = 1; e < 8; ++e) if (lg[e] > v1) { v1 = lg[e]; e1 = e; }
                int e2 = -1; float v2 = -3.0e38f;
#pragma unroll
                for (int e = 0; e < 8; ++e) if (e != e1 && lg[e] > v2) { v2 = lg[e]; e2 = e; }
                const float w1 = 1.0f / (1.0f + __expf(v2 - v1)), w2 = 1.0f - w1;
                const int r1 = __hip_atomic_fetch_add(&LC[e1], 1, __ATOMIC_RELAXED, __HIP_MEMORY_SCOPE_WORKGROUP), r2 = __hip_atomic_fetch_add(&LC[e2], 1, __ATOMIC_RELAXED, __HIP_MEMORY_SCOPE_WORKGROUP);
                rt[RT_TOKE + (size_t)m * 2] = e1; rt[RT_TOKE + (size_t)m * 2 + 1] = e2;
                rt[RT_TOKR + (size_t)m * 2] = r1; rt[RT_TOKR + (size_t)m * 2 + 1] = r2;
                ((float*)rt)[RT_TOKW + (size_t)m * 2] = w1; ((float*)rt)[RT_TOKW + (size_t)m * 2 + 1] = w2;
            }
        }
        asm volatile("" ::: "memory");
        xa = xb;
#pragma unroll
        for (int j = 0; j < 4; ++j) ya[j] = yb[j];
    }
    if (moe && !dry) {
        __syncthreads();
        if (tid < 8) { unsigned* cnt = (unsigned*)(ows(C.ws_) + WS_CTL) + CW_CNT + (jm * 8 + tid) * 64;
            const unsigned base = __hip_atomic_fetch_add(cnt, (unsigned)LC[tid], __ATOMIC_RELAXED, __HIP_MEMORY_SCOPE_AGENT);
            rt[RT_BLK + (ovx(C) * 32 + ovr(C)) * 8 + tid] = (int)base; }
    }
}
struct RouteInfo { int base[9]; int cnt[8]; int npanels; };
__device__ __forceinline__ void route_info(const Ctx& C, int jm, RouteInfo& R) {
    unsigned* cnt = (unsigned*)(ows(C.ws_) + WS_CTL) + CW_CNT; int b = 0;
#pragma unroll
    for (int e = 0; e < 8; ++e) { const int c = (int)__hip_atomic_load(cnt + (jm * 8 + e) * 64, __ATOMIC_RELAXED, __HIP_MEMORY_SCOPE_AGENT); R.cnt[e] = c; R.base[e] = b; b += ((c + 255) >> 8) << 8; }
    R.base[8] = b; R.npanels = b >> 8;
}
__device__ __forceinline__ void p_route_build(const Ctx& C, int l, int mrows) {
    const int tid = otid();
    const int jm = l >> 1; RouteInfo R; route_info(C, jm, R);
    int* rt = (int*)(ows(C.ws_) + WS_ROUTE); const int rpb = mrows / 256;
    const int gt = oblk() * NTHR + tid, NT = ogrid() * NTHR;
    for (int i = gt; i < mrows * 2; i += NT) { const int m = i >> 1, e = rt[RT_TOKE + i], blk = (m < MLAT ? (m >> 12) : ((m - MLAT) >> 9)) * 32 + ((m & 255) >> 3);
        int be = 0;
#pragma unroll
        for (int q = 0; q < 8; ++q) be = (q == e) ? R.base[q] : be;
        const int slot = be + rt[RT_BLK + blk * 8 + e] + rt[RT_TOKR + i];
        rt[RT_TOKS + i] = slot; rt[RT_S2T + slot] = m; }
    for (int s = gt; s < R.base[8]; s += NT) { int e = 0;
#pragma unroll
        for (int q = 1; q < 8; ++q) e = (s >= R.base[q]) ? q : e;
        int be = 0, ce = 0;
#pragma unroll
        for (int q = 0; q < 8; ++q) { be = (q == e) ? R.base[q] : be; ce = (q == e) ? R.cnt[q] : ce; }
        if (s >= be + ce) rt[RT_S2T + s] = 0;
        if ((s & 255) == 0) rt[RT_PE + (s >> 8)] = e; }
}
__device__ __forceinline__ void p_lnc(const Ctx& C, int l, int mrows, bool dry = false) {
    const int tid = otid(), lane = tid & 63, wave = owave();
    bf16* H = dry ? wsb(C, WS_R + 350 * MiB) : hbuf(C); const bf16* Y2 = wsb(C, WS_R + R_Y2);
    const bool moe = (l & 1); const int* rt = (const int*)(ows(C.ws_) + WS_ROUTE); const int rpb = mrows / 256;
    RowV g5v, shv, scv, lgv, lbv; int rcur = -1;
    row_load_f32(lgv, oin(C.in_)[19] + (size_t)(l * 2 + 1) * D, lane); row_load_f32(lbv, oin(C.in_)[20] + (size_t)(l * 2 + 1) * D, lane);
    const int nrow = rpb / NWAVE, jb = (nrow - 1) * 256 + ovr(C) * NWAVE + wave, mb = lrow(C, jb);
    int sa1 = 0, sa2 = 0, sb1 = 0, sb2 = 0, sc1 = 0, sc2 = 0; float wa1 = 0.f, wa2 = 0.f, wb1 = 0.f, wb2 = 0.f, wc1 = 0.f, wc2 = 0.f;
    if (moe) { sa1 = rt[RT_TOKS + (size_t)mb * 2]; sa2 = rt[RT_TOKS + (size_t)mb * 2 + 1]; wa1 = ((const float*)rt)[RT_TOKW + (size_t)mb * 2]; wa2 = ((const float*)rt)[RT_TOKW + (size_t)mb * 2 + 1];
        if (nrow > 1) { const size_t q = (size_t)lrow(C, jb - 256) * 2; sb1 = rt[RT_TOKS + q]; sb2 = rt[RT_TOKS + q + 1]; wb1 = ((const float*)rt)[RT_TOKW + q]; wb2 = ((const float*)rt)[RT_TOKW + q + 1]; } }
    XRaw xa; u32x2 ya[4], za[4];
    xraw_load(xa, C, mb, lane, false); yraw_load(ya, Y2 + (size_t)(moe ? sa1 : mb) * D, lane); if (moe) yraw_load(za, Y2 + (size_t)sa2 * D, lane); else { za[0] = ya[0]; za[1] = ya[1]; za[2] = ya[2]; za[3] = ya[3]; }
    XRaw xb = xa; u32x2 yb[4] = {ya[0], ya[1], ya[2], ya[3]}, zb[4] = {za[0], za[1], za[2], za[3]};
    for (int k = 0; k < nrow; ++k) {
        const int m = lrow(C, jb - k * 256), mn = lrow(C, k + 1 < nrow ? jb - (k + 1) * 256 : jb), r = row_r(m);
        if (moe && k + 2 < nrow) { const size_t q = (size_t)lrow(C, jb - (k + 2) * 256) * 2; sc1 = rt[RT_TOKS + q]; sc2 = rt[RT_TOKS + q + 1]; wc1 = ((const float*)rt)[RT_TOKW + q]; wc2 = ((const float*)rt)[RT_TOKW + q + 1]; }
        if (k + 1 < nrow) { xraw_load(xb, C, mn, lane, false); yraw_load(yb, Y2 + (size_t)(moe ? sb1 : mn) * D, lane); if (moe) yraw_load(zb, Y2 + (size_t)sb2 * D, lane); }
        if (r != rcur) { row_load_f32(g5v, modv(C, l, r, 5), lane); if (l < DEPTH - 1) { row_load_f32(shv, modv(C, l + 1, r, 0), lane); row_load_f32(scv, modv(C, l + 1, r, 1), lane); } rcur = r; }
        RowV x, y; xraw_get(x, xa, false); yraw_get(y, ya);
        if (moe) { RowV y2; yraw_get(y2, za);
#pragma unroll
            for (int j = 0; j < 4; ++j) y.v[j] = y.v[j] * wa1 + y2.v[j] * wa2; }
#pragma unroll
        for (int j = 0; j < 4; ++j) x.v[j] = x.v[j] * ALPHA + g5v.v[j] * y.v[j];
        row_ln(x, lane); row_affine_v(x, lgv, lbv);
        if (dry) row_store_f32(x, (float*)(ows(C.ws_) + WS_R) + (size_t)m * D, lane); else if (l == DEPTH - 1) row_store_f32(x, oout(C.out_) + (size_t)m * D, lane); else x_store(x, C, m, lane);
        if (l < DEPTH - 1) { row_ln(x, lane); row_mod_v(x, shv, scv); row_store_bf16(x, H + (size_t)m * D, lane); row_store_fp8(x, h8buf(C) + (size_t)m * D, lane); }
        asm volatile("" ::: "memory");
        xa = xb; sa1 = sb1; sa2 = sb2; wa1 = wb1; wa2 = wb2; sb1 = sc1; sb2 = sc2; wb1 = wc1; wb2 = wc2;
#pragma unroll
        for (int j = 0; j < 4; ++j) { ya[j] = yb[j]; za[j] = zb[j]; }
    }
}

__device__ __forceinline__ f32x4 mm4(float a, float b, f32x4 c) { return __builtin_amdgcn_mfma_f32_16x16x4f32(a, b, c, 0, 0, 0); }
__device__ __forceinline__ int gla_row0(int b, int sc) { return sc < 4 ? MLAT + b * TC + sc * 64 : b * T + (sc - 4) * 64; }
constexpr int GL_VT = 0, GL_LA = 9216, GL_SEG = 26112, GL_QT = 28160, GL_KT = 36608, GL_KWT = 45056, GL_DC = 54272, GL_QE = 54528, GL_KE = 64768, GL_SPT = 75008, GL_AT = 85248, GL_RS = 103680;
__device__ __forceinline__ void gla_load_common(const bf16* cols, int m0, int h, LAS unsigned char* lds, int tid, bool with_q) {
    const int row = tid >> 3, seg = tid & 7; const bf16* rp = cols + (size_t)(m0 + row) * NINP;
    { const u32x4 w = *(const u32x4*)(rp + C_V + h * 64 + seg * 8); LAS bf16* vt = (LAS bf16*)(lds + GL_VT) + (seg * 8) * 72 + row;
      vt[0 * 72] = (bf16)(w.x & 0xffff); vt[1 * 72] = (bf16)(w.x >> 16); vt[2 * 72] = (bf16)(w.y & 0xffff); vt[3 * 72] = (bf16)(w.y >> 16);
      vt[4 * 72] = (bf16)(w.z & 0xffff); vt[5 * 72] = (bf16)(w.z >> 16); vt[6 * 72] = (bf16)(w.w & 0xffff); vt[7 * 72] = (bf16)(w.w >> 16); }
    const int s4 = seg & 3, dir = seg >> 2;
    { const u32x4 a = *(const u32x4*)(rp + (dir ? C_LAB : C_LAF) + h * 32 + s4 * 8); LAS float* d = (LAS float*)(lds + GL_LA) + (dir * 64 + row) * 33 + s4 * 8;
      d[0] = bflo(a.x); d[1] = bfhi(a.x); d[2] = bflo(a.y); d[3] = bfhi(a.y); d[4] = bflo(a.z); d[5] = bfhi(a.z); d[6] = bflo(a.w); d[7] = bfhi(a.w); }
    if (dir == 0 || with_q) { const u32x4 a = *(const u32x4*)(rp + (dir ? C_Q : C_K) + h * 32 + s4 * 8); LAS float* d = (LAS float*)(lds + (dir ? GL_QT : GL_KT)) + row * 33 + s4 * 8;
      d[0] = bflo(a.x); d[1] = bfhi(a.x); d[2] = bflo(a.y); d[3] = bfhi(a.y); d[4] = bflo(a.z); d[5] = bfhi(a.z); d[6] = bflo(a.w); d[7] = bfhi(a.w); }
}
__device__ __forceinline__ void gla1_item(const Ctx& C, int g) {
    const int b = g / 144, rem = g % 144, sc = rem >> 2, h = rem & 3, m0 = gla_row0(b, sc);
    const bf16* cols = wsb(C, WS_R + R_COLS); LAS unsigned char* lds = C.lds;
    const int tid = otid(), lane = tid & 63, w = owave(), lr = lane & 15, lq = lane >> 4;
    gla_load_common(cols, m0, h, lds, tid, false);
    __syncthreads();
    const int dir = tid >> 8, d = (tid >> 3) & 31, sg = tid & 7;
    LAS float* LA = (LAS float*)(lds + GL_LA) + dir * 64 * 33; LAS float* SEG = (LAS float*)(lds + GL_SEG) + (dir * 32 + d) * 8;
    float v[8], pre[8]; float run = 0.f;
#pragma unroll
    for (int x = 0; x < 8; ++x) { v[x] = LA[(sg * 8 + x) * 33 + d]; run += v[x]; pre[x] = run; }
    SEG[sg] = run;
    __syncthreads();
    { float off = 0.f, tot = 0.f;
#pragma unroll
      for (int s2 = 0; s2 < 8; ++s2) { const float t2 = SEG[s2]; tot += t2; off += (s2 < sg) ? t2 : 0.f; }
      const LAS float* KT = (const LAS float*)(lds + GL_KT);
      float kw[8];
#pragma unroll
      for (int x = 0; x < 8; ++x) { const float wt = dir == 0 ? __expf(tot - (off + pre[x])) : __expf(off + pre[x] - v[x]); kw[x] = KT[(sg * 8 + x) * 33 + d] * wt; }
      u32x4 o; o.x = pk2(kw[0], kw[1]); o.y = pk2(kw[2], kw[3]); o.z = pk2(kw[4], kw[5]); o.w = pk2(kw[6], kw[7]);
      *(LAS u32x4*)(lds + GL_KWT + ((dir * 32 + d) * 72 + sg * 8) * 2) = o;
      if (sg == 0) ((LAS float*)(lds + GL_DC))[dir * 32 + d] = __expf(tot); }
    __syncthreads();
    { const int wd = w >> 2, et = w & 3;
      f32x4 a0 = (f32x4){0.f, 0.f, 0.f, 0.f}, a1 = a0;
#pragma unroll
      for (int ks = 0; ks < 2; ++ks) { const bf16x8 av = *(const LAS bf16x8*)(lds + GL_VT + ((et * 16 + lr) * 72 + ks * 32 + lq * 8) * 2);
          const bf16x8 b0 = *(const LAS bf16x8*)(lds + GL_KWT + ((wd * 32 + lr) * 72 + ks * 32 + lq * 8) * 2), b1 = *(const LAS bf16x8*)(lds + GL_KWT + ((wd * 32 + 16 + lr) * 72 + ks * 32 + lq * 8) * 2);
          a0 = __builtin_amdgcn_mfma_f32_16x16x32_bf16(av, b0, a0, 0, 0, 0); a1 = __builtin_amdgcn_mfma_f32_16x16x32_bf16(av, b1, a1, 0, 0, 0); }
      const int cp = wd ? (sc < 4 ? 3 - sc : 39 - sc) : sc, ch = (b * 4 + h) * 2 + wd;
      float* DH = (float*)(ows(C.ws_) + WS_R + R_DH) + ((size_t)ch * 36 + cp) * 2048;
#pragma unroll
      for (int r = 0; r < 4; ++r) { const int e = et * 16 + 4 * lq + r; DH[e * 32 + lr] = a0[r]; DH[e * 32 + 16 + lr] = a1[r]; }
      if (tid < 64) { const int dd = tid >> 5, d2 = tid & 31; const int cp2 = dd ? (sc < 4 ? 3 - sc : 39 - sc) : sc;
          ((float*)(ows(C.ws_) + WS_R + R_DEC))[((size_t)((b * 4 + h) * 2 + dd) * 36 + cp2) * 32 + d2] = ((const LAS float*)(lds + GL_DC))[dd * 32 + d2]; } }
    __syncthreads();
}
__device__ __forceinline__ void gla2_all(const Ctx& C) {
    const int tid = otid();
    float* DH = (float*)(ows(C.ws_) + WS_R + R_DH); const float* DEC = (const float*)(ows(C.ws_) + WS_R + R_DEC);
    for (int il = ovr(C) * NTHR + tid; il < 16 * 2048; il += 32 * NTHR) { const int i = ovx(C) * 16 * 2048 + il, ch = i >> 11, el = i & 2047, d = el & 31;
        float* p = DH + (size_t)ch * 36 * 2048 + el; const float* dc = DEC + (size_t)ch * 36 * 32 + d;
        float dh[36], de[36];
#pragma unroll
        for (int cp = 0; cp < 36; ++cp) { dh[cp] = p[(size_t)cp * 2048]; de[cp] = dc[cp * 32]; }
        float S = 0.f;
#pragma unroll
        for (int cp = 0; cp < 36; ++cp) { p[(size_t)cp * 2048] = S; S = de[cp] * S + dh[cp]; } }
}
__device__ __forceinline__ void gla3_item(const Ctx& C, int l, int g) {
    const int b = g / 144, rem = g % 144, sc = rem >> 2, h = rem & 3, m0 = gla_row0(b, sc);
    const bf16* cols = wsb(C, WS_R + R_COLS); bf16* YS = wsb(C, WS_R + R_YS); LAS unsigned char* lds = C.lds;
    const int tid = otid(), lane = tid & 63, w = owave(), lr = lane & 15, lq = lane >> 4;
    gla_load_common(cols, m0, h, lds, tid, true);
    { const int dir = tid >> 8, e = (tid >> 2) & 63, dq = tid & 3; const int cp = dir ? (sc < 4 ? 3 - sc : 39 - sc) : sc, ch = (b * 4 + h) * 2 + dir;
      const float* sp = (const float*)(ows(C.ws_) + WS_R + R_DH) + ((size_t)ch * 36 + cp) * 2048 + e * 32 + dq * 8;
      const f32x4 s0 = *(const f32x4*)sp, s1 = *(const f32x4*)(sp + 4);
      u32x4 o; o.x = pk2(s0[0], s0[1]); o.y = pk2(s0[2], s0[3]); o.z = pk2(s1[0], s1[1]); o.w = pk2(s1[2], s1[3]);
      *(LAS u32x4*)(lds + GL_SPT + ((dir * 64 + e) * 40 + dq * 8) * 2) = o; }
    __syncthreads();
    { const int dir = tid >> 8, d = (tid >> 3) & 31, sg = tid & 7;
      LAS float* LA = (LAS float*)(lds + GL_LA) + dir * 64 * 33; LAS float* SEG = (LAS float*)(lds + GL_SEG) + (dir * 32 + d) * 8;
      float v[8], pre[8]; float run = 0.f;
#pragma unroll
      for (int x = 0; x < 8; ++x) { v[x] = LA[(sg * 8 + x) * 33 + d]; run += v[x]; pre[x] = run; }
      SEG[sg] = run;
      __syncthreads();
      float off = 0.f, tot = 0.f;
#pragma unroll
      for (int s2 = 0; s2 < 8; ++s2) { const float t2 = SEG[s2]; tot += t2; off += (s2 < sg) ? t2 : 0.f; }
      const LAS float* QT = (const LAS float*)(lds + GL_QT); const LAS float* KT = (const LAS float*)(lds + GL_KT);
      LAS bf16* QE = (LAS bf16*)(lds + GL_QE) + dir * 64 * 40 + d; LAS bf16* KE = (LAS bf16*)(lds + GL_KE) + dir * 64 * 40 + d;
#pragma unroll
      for (int x = 0; x < 8; ++x) { const int i = sg * 8 + x;
          const float bb = dir == 0 ? (off + pre[x]) : (tot - (off + pre[x] - v[x]));
          QE[i * 40] = (bf16)f2bf(QT[i * 33 + d] * __expf(bb)); KE[i * 40] = (bf16)f2bf(KT[i * 33 + d] * __expf(-bb)); } }
    __syncthreads();
    { const int dir = w >> 2, jt = w & 3;
      const bf16x8 bq = *(const LAS bf16x8*)(lds + GL_QE + ((dir * 64 + jt * 16 + lr) * 40 + lq * 8) * 2);
#pragma unroll
      for (int it = 0; it < 4; ++it) { const bf16x8 ak = *(const LAS bf16x8*)(lds + GL_KE + ((dir * 64 + it * 16 + lr) * 40 + lq * 8) * 2);
          const f32x4 a = __builtin_amdgcn_mfma_f32_16x16x32_bf16(ak, bq, (f32x4){0.f, 0.f, 0.f, 0.f}, 0, 0, 0);
          const int j = jt * 16 + lr, i0 = it * 16 + 4 * lq; float m4[4];
#pragma unroll
          for (int r = 0; r < 4; ++r) { const int i = i0 + r; const bool keep = dir ? (i > j) : (i <= j); m4[r] = keep ? a[r] : 0.f; }
          u32x2 o; o.x = pk2(m4[0], m4[1]); o.y = pk2(m4[2], m4[3]);
          *(LAS u32x2*)(lds + GL_AT + ((dir * 64 + j) * 72 + i0) * 2) = o; } }
    __syncthreads();
    const int jt = w >> 1, et0 = 2 * (w & 1);
    f32x4 o0 = (f32x4){0.f, 0.f, 0.f, 0.f}, o1 = o0;
#pragma unroll
    for (int dir = 0; dir < 2; ++dir) {
#pragma unroll
        for (int ks = 0; ks < 2; ++ks) { const bf16x8 ba = *(const LAS bf16x8*)(lds + GL_AT + ((dir * 64 + jt * 16 + lr) * 72 + ks * 32 + lq * 8) * 2);
            o0 = __builtin_amdgcn_mfma_f32_16x16x32_bf16(*(const LAS bf16x8*)(lds + GL_VT + ((et0 * 16 + lr) * 72 + ks * 32 + lq * 8) * 2), ba, o0, 0, 0, 0);
            o1 = __builtin_amdgcn_mfma_f32_16x16x32_bf16(*(const LAS bf16x8*)(lds + GL_VT + (((et0 + 1) * 16 + lr) * 72 + ks * 32 + lq * 8) * 2), ba, o1, 0, 0, 0); }
        const bf16x8 bq = *(const LAS bf16x8*)(lds + GL_QE + ((dir * 64 + jt * 16 + lr) * 40 + lq * 8) * 2);
        o0 = __builtin_amdgcn_mfma_f32_16x16x32_bf16(*(const LAS bf16x8*)(lds + GL_SPT + ((dir * 64 + et0 * 16 + lr) * 40 + lq * 8) * 2), bq, o0, 0, 0, 0);
        o1 = __builtin_amdgcn_mfma_f32_16x16x32_bf16(*(const LAS bf16x8*)(lds + GL_SPT + ((dir * 64 + (et0 + 1) * 16 + lr) * 40 + lq * 8) * 2), bq, o1, 0, 0, 0);
    }
    { float ss = (o0[0] * o0[0] + o0[1] * o0[1]) + (o0[2] * o0[2] + o0[3] * o0[3]) + (o1[0] * o1[0] + o1[1] * o1[1]) + (o1[2] * o1[2] + o1[3] * o1[3]);
      ss += __shfl_xor(ss, 16); ss += __shfl_xor(ss, 32);
      if (lq == 0) ((LAS float*)(lds + GL_RS))[(jt * 16 + lr) * 2 + (w & 1)] = ss; }
    __syncthreads();
    { const int j = jt * 16 + lr; const LAS float* RS = (const LAS float*)(lds + GL_RS);
      const float rs = 1.0f / sqrtf((RS[j * 2] + RS[j * 2 + 1]) * (1.0f / 64.0f) + EPS);
      const size_t rowo = (size_t)(m0 + j);
#pragma unroll
      for (int q = 0; q < 2; ++q) { const int e = (et0 + q) * 16 + 4 * lq; const f32x4 o = q ? o1 : o0;
          const u32x2 rw = *(const u32x2*)(cols + rowo * NINP + C_R + h * 64 + e); const f32x4 gg = *(const f32x4*)(oin(C.in_)[9] + (size_t)l * 256 + h * 64 + e);
          u32x2 ow; ow.x = pk2(o[0] * rs * gg[0] * bflo(rw.x), o[1] * rs * gg[1] * bfhi(rw.x)); ow.y = pk2(o[2] * rs * gg[2] * bflo(rw.y), o[3] * rs * gg[3] * bfhi(rw.y));
          *(u32x2*)(YS + rowo * D + h * 64 + e) = ow; } }
    __syncthreads();
}

template <int GI> __device__ __forceinline__ void pool_lat_item_t(const Ctx& C, int l, int b, int slab) {
    constexpr int HW = 1 << GI; constexpr int RS = 64 * 16 + 16;
    const int ch0 = slab * 16;
    const bf16* cols = wsb(C, WS_R + R_COLS); bf16* YS = wsb(C, WS_R + R_YS);
    LAS float* G = (LAS float*)C.lds;
    const int tid = otid(), hf = tid & 1;
    u32x4 xin[8];
#pragma unroll
    for (int k = 0; k < 8; ++k) { const int t = (tid + k * NTHR) >> 1; xin[k] = *(const u32x4*)(cols + (size_t)(b * T + t) * NINP + C_POOL + ch0 + hf * 8); }
#pragma unroll
    for (int k = 0; k < 8; ++k) { const int t = (tid + k * NTHR) >> 1; LAS float* d = G + (t >> 6) * RS + (t & 63) * 16 + hf * 8; const u32x4 w = xin[k];
        *(LAS f32x4*)d = (f32x4){bflo(w.x), bfhi(w.x), bflo(w.y), bfhi(w.y)}; *(LAS f32x4*)(d + 4) = (f32x4){bflo(w.z), bfhi(w.z), bflo(w.w), bfhi(w.w)}; }
    __syncthreads();
#pragma unroll 1
    for (int q = 0; q < 2; ++q) { const int cix = tid + q * NTHR; float p[33]; p[0] = 0.f;
#pragma unroll
        for (int gr = 0; gr < 32; ++gr) p[gr + 1] = p[gr] + G[gr * RS + cix];
#pragma unroll
        for (int gr = 0; gr < 32; ++gr) { const int lo = gr - HW < 0 ? 0 : gr - HW, hi = gr + HW > 32 ? 32 : gr + HW;
            G[gr * RS + cix] = (p[hi] - p[lo]) * (1.0f / (float)(hi - lo)); } }
    __syncthreads();
    { const int gr = tid >> 4, ch = tid & 15; LAS float* Gr = G + gr * RS + ch; float p[65]; p[0] = 0.f;
#pragma unroll
      for (int gc = 0; gc < 64; ++gc) p[gc + 1] = p[gc] + Gr[gc * 16];
#pragma unroll
      for (int gc = 0; gc < 64; ++gc) { const int lo = gc - HW < 0 ? 0 : gc - HW, hi = gc + HW > 64 ? 64 : gc + HW;
          Gr[gc * 16] = (p[hi] - p[lo]) * (1.0f / (float)(hi - lo)); } }
    __syncthreads();
    { const float* ps = oin(C.in_)[11] + (size_t)l * 256 + ch0 + hf * 8; const f32x4 s0 = *(const f32x4*)ps, s1 = *(const f32x4*)(ps + 4);
#pragma unroll
      for (int k = 0; k < 8; ++k) { const int t = (tid + k * NTHR) >> 1; const LAS float* d = G + (t >> 6) * RS + (t & 63) * 16 + hf * 8; const f32x4 m0 = *(const LAS f32x4*)d, m1 = *(const LAS f32x4*)(d + 4); const u32x4 w = xin[k];
          u32x4 o; o.x = pk2((m0[0] - bflo(w.x)) * s0[0], (m0[1] - bfhi(w.x)) * s0[1]); o.y = pk2((m0[2] - bflo(w.y)) * s0[2], (m0[3] - bfhi(w.y)) * s0[3]);
          o.z = pk2((m1[0] - bflo(w.z)) * s1[0], (m1[1] - bfhi(w.z)) * s1[1]); o.w = pk2((m1[2] - bflo(w.w)) * s1[2], (m1[3] - bfhi(w.w)) * s1[3]);
          *(u32x4*)(YS + (size_t)(b * T + t) * D + 256 + ch0 + hf * 8) = o; } }
    __syncthreads();
}
__device__ __forceinline__ void pool_lat_item(const Ctx& C, int l, int p) {
    const int b = p >> 4, slab = p & 15, gi = slab >> 2;
    if (gi == 0) pool_lat_item_t<0>(C, l, b, slab); else if (gi == 1) pool_lat_item_t<1>(C, l, b, slab); else if (gi == 2) pool_lat_item_t<2>(C, l, b, slab); else pool_lat_item_t<3>(C, l, b, slab);
}
__device__ __forceinline__ void pool_ctx_item(const Ctx& C, int l, int p) {
    const int b = p >> 2, gi = p & 3, hw = 1 << gi;
    const bf16* cols = wsb(C, WS_R + R_COLS); bf16* YS = wsb(C, WS_R + R_YS);
    LAS float* G = (LAS float*)C.lds;
    const int tid = otid(), sg = tid & 7;
    u32x4 xin[4];
#pragma unroll
    for (int k = 0; k < 4; ++k) { const int t = (tid + k * NTHR) >> 3; xin[k] = *(const u32x4*)(cols + (size_t)(MLAT + b * TC + t) * NINP + C_POOL + gi * 64 + sg * 8); }
#pragma unroll
    for (int k = 0; k < 4; ++k) { const int t = (tid + k * NTHR) >> 3; LAS float* d = G + t * 64 + sg * 8; const u32x4 w = xin[k];
        *(LAS f32x4*)d = (f32x4){bflo(w.x), bfhi(w.x), bflo(w.y), bfhi(w.y)}; *(LAS f32x4*)(d + 4) = (f32x4){bflo(w.z), bfhi(w.z), bflo(w.w), bfhi(w.w)}; }
    __syncthreads();
    { const float* ps = oin(C.in_)[11] + (size_t)l * 256 + gi * 64 + sg * 8; const f32x4 s0 = *(const f32x4*)ps, s1 = *(const f32x4*)(ps + 4);
#pragma unroll
      for (int k = 0; k < 4; ++k) { const int t = (tid + k * NTHR) >> 3, lo = t - hw < 0 ? 0 : t - hw, hi = t + hw > 256 ? 256 : t + hw;
          f32x4 a0 = (f32x4){0.f, 0.f, 0.f, 0.f}, a1 = a0;
          for (int t2 = lo; t2 < hi; ++t2) { const LAS float* d = G + t2 * 64 + sg * 8; a0 += *(const LAS f32x4*)d; a1 += *(const LAS f32x4*)(d + 4); }
          const float inv = 1.0f / (float)(hi - lo); const u32x4 w = xin[k];
          u32x4 o; o.x = pk2((a0[0] * inv - bflo(w.x)) * s0[0], (a0[1] * inv - bfhi(w.x)) * s0[1]); o.y = pk2((a0[2] * inv - bflo(w.y)) * s0[2], (a0[3] * inv - bfhi(w.y)) * s0[3]);
          o.z = pk2((a1[0] * inv - bflo(w.z)) * s1[0], (a1[1] * inv - bfhi(w.z)) * s1[1]); o.w = pk2((a1[2] * inv - bflo(w.w)) * s1[2], (a1[3] * inv - bfhi(w.w)) * s1[3]);
          *(u32x4*)(YS + (size_t)(MLAT + b * TC + t) * D + 256 + gi * 64 + sg * 8) = o; } }
    __syncthreads();
}
__device__ __forceinline__ void sgu_item(const Ctx& C, int l, int s, bool loadw) {
    int m0, g;
    if (s < 1024) { const int b = s >> 6, n = (s >> 2) & 15; g = s & 3; m0 = b * T + n * 128; }
    else { const int s2 = s - 1024, b = s2 >> 3, n = (s2 >> 2) & 1; g = s2 & 3; m0 = MLAT + b * TC + n * 128; }
    const bf16* cols = wsb(C, WS_R + R_COLS); bf16* YS = wsb(C, WS_R + R_YS); LAS unsigned char* lds = C.lds;
    constexpr int SG_W = 0, SG_V = 34816;
    const int tid = otid(), lane = tid & 63, w = owave(), lr = lane & 15, lq = lane >> 4;
    if (loadw) { const bf16* wg = wsb(C, WS_SGUW) + (size_t)(l * 4 + g) * 128 * 128;
#pragma unroll
      for (int q = 0; q < 4; ++q) { const int i = tid + q * NTHR, r = i >> 4, c16 = i & 15; *(LAS u32x4*)(lds + SG_W + (r * 136 + c16 * 8) * 2) = *(const u32x4*)(wg + r * 128 + c16 * 8); } }
    const int srow = w * 16 + lr; const size_t rowo = (size_t)(m0 + srow); u32x2 uw[4];
#pragma unroll
    for (int ct = 0; ct < 4; ++ct) uw[ct] = *(const u32x2*)(cols + rowo * NINP + C_SU + g * 64 + ct * 16 + 4 * lq);
    const float bias = oin(C.in_)[15][(size_t)(l * 4 + g) * 128 + srow];
    { const int row = tid >> 2, q = tid & 3; const bf16* rp = cols + (size_t)(m0 + row) * NINP + C_SV + q * 64; float v[64]; float sm4[4] = {0.f, 0.f, 0.f, 0.f};
      const u32x4 own0 = *(const u32x4*)(cols + (size_t)(m0 + row) * NINP + C_SV + g * 64 + q * 16), own1 = *(const u32x4*)(cols + (size_t)(m0 + row) * NINP + C_SV + g * 64 + q * 16 + 8);
#pragma unroll
      for (int i = 0; i < 8; ++i) { const u32x4 x = *(const u32x4*)(rp + i * 8); v[8 * i] = bflo(x.x); v[8 * i + 1] = bfhi(x.x); v[8 * i + 2] = bflo(x.y); v[8 * i + 3] = bfhi(x.y); v[8 * i + 4] = bflo(x.z); v[8 * i + 5] = bfhi(x.z); v[8 * i + 6] = bflo(x.w); v[8 * i + 7] = bfhi(x.w); }
#pragma unroll
      for (int i = 0; i < 64; ++i) sm4[i & 3] += v[i];
      float sm = (sm4[0] + sm4[1]) + (sm4[2] + sm4[3]);
      sm += __shfl_xor(sm, 1); sm += __shfl_xor(sm, 2); const float mean = sm * (1.0f / 256.0f); float sq4[4] = {0.f, 0.f, 0.f, 0.f};
#pragma unroll
      for (int i = 0; i < 64; ++i) { v[i] -= mean; sq4[i & 3] += v[i] * v[i]; }
      float sq = (sq4[0] + sq4[1]) + (sq4[2] + sq4[3]);
      sq += __shfl_xor(sq, 1); sq += __shfl_xor(sq, 2); const float rstd = __builtin_amdgcn_rsqf(sq * (1.0f / 256.0f) + EPS);
      { const float* lg = oin(C.in_)[12] + (size_t)l * 256 + g * 64 + q * 16; const float* lb = oin(C.in_)[13] + (size_t)l * 256 + g * 64 + q * 16; LAS bf16* vt = (LAS bf16*)(lds + SG_V) + (q * 16) * 136 + row;
        const unsigned ow[8] = {own0.x, own0.y, own0.z, own0.w, own1.x, own1.y, own1.z, own1.w};
#pragma unroll
        for (int i = 0; i < 8; ++i) { vt[(2 * i) * 136] = (bf16)f2bf((bflo(ow[i]) - mean) * rstd * lg[2 * i] + lb[2 * i]); vt[(2 * i + 1) * 136] = (bf16)f2bf((bfhi(ow[i]) - mean) * rstd * lg[2 * i + 1] + lb[2 * i + 1]); } } }
    __syncthreads();
    f32x4 a[4];
#pragma unroll
    for (int ct = 0; ct < 4; ++ct) a[ct] = (f32x4){0.f, 0.f, 0.f, 0.f};
#pragma unroll
    for (int ks = 0; ks < 4; ++ks) { const bf16x8 bw = *(const LAS bf16x8*)(lds + SG_W + ((w * 16 + lr) * 136 + ks * 32 + lq * 8) * 2);
#pragma unroll
        for (int ct = 0; ct < 4; ++ct) a[ct] = __builtin_amdgcn_mfma_f32_16x16x32_bf16(*(const LAS bf16x8*)(lds + SG_V + ((ct * 16 + lr) * 136 + ks * 32 + lq * 8) * 2), bw, a[ct], 0, 0, 0); }
#pragma unroll
    for (int ct = 0; ct < 4; ++ct) { const int c = ct * 16 + 4 * lq;
        u32x2 o; o.x = pk2(bflo(uw[ct].x) * (a[ct][0] + bias), bfhi(uw[ct].x) * (a[ct][1] + bias)); o.y = pk2(bflo(uw[ct].y) * (a[ct][2] + bias), bfhi(uw[ct].y) * (a[ct][3] + bias));
        *(u32x2*)(YS + rowo * D + 768 + g * 64 + c) = o; }
    __syncthreads();
}
__device__ __forceinline__ void cdft_tile(const Ctx& C, int c) {
    const bf16* cols = wsb(C, WS_R + R_COLS); const bf16* CS = wsb(C, WS_CS64);
    const int tid = otid(), lane = tid & 63, wave = owave(), wr = wave >> 2, wc = wave & 3, fr = lane & 15, fq = lane >> 4;
    const bf16* pa0 = CS + (size_t)(tid >> 3) * 64 + (tid & 7) * 8; const bf16* pa1 = pa0 + 64 * 64;
    if (c < 1024) {
        const int b = c >> 6, g = (c >> 4) & 3, bq = c & 15; bf16* ZT = wsb(C, WS_R + R_ZT) + (size_t)b * 256 * 4096;
        const int n0 = tid >> 3, n1 = n0 + 64;
        const int t0 = 64 * (n0 & 31) + 4 * bq + (n0 >> 5), t1 = 64 * (n1 & 31) + 4 * bq + (n1 >> 5);
        const bf16* pb0 = cols + (size_t)(b * T + t0) * NINP + C_FFT + g * 64 + (tid & 7) * 8; const bf16* pb1 = cols + (size_t)(b * T + t1) * NINP + C_FFT + g * 64 + (tid & 7) * 8;
        f32x4 acc[4][2]; tg_zero(acc); tg_tile(acc, C.lds, pa0, pa1, pb0, pb1, 1);
#pragma unroll
        for (int m = 0; m < 4; ++m)
#pragma unroll
            for (int n = 0; n < 2; ++n) { const int row = wr * 64 + m * 16 + fr, col = wc * 32 + n * 16 + 4 * fq;
                const int p = row >> 6, mm = row & 63, j = col >> 5, a = col & 31; u32x2 w; w.x = pk2(acc[m][n][0], acc[m][n][1]); w.y = pk2(acc[m][n][2], acc[m][n][3]);
                *(u32x2*)(ZT + ((size_t)((g * 64 + mm) * 2 + p) * 64 + 4 * bq + j) * 32 + a) = w; }
    } else {
        const int c2 = c - 1024, b = c2 >> 3, g = (c2 >> 1) & 3, tt = c2 & 1, m0 = MLAT + b * TC + tt * 128; bf16* ZT = wsb(C, WS_R + R_ZTC) + (size_t)b * 256 * 512;
        const bf16* pb0 = cols + (size_t)(m0 + (tid >> 3)) * NINP + C_FFT + g * 64 + (tid & 7) * 8; const bf16* pb1 = pb0 + (size_t)64 * NINP;
        f32x4 acc[4][2]; tg_zero(acc); tg_tile(acc, C.lds, pa0, pa1, pb0, pb1, 1);
#pragma unroll
        for (int m = 0; m < 4; ++m)
#pragma unroll
            for (int n = 0; n < 2; ++n) { const int row = wr * 64 + m * 16 + fr, col = wc * 32 + n * 16 + 4 * fq;
                const int p = row >> 6, mm = row & 63; u32x2 w; w.x = pk2(acc[m][n][0], acc[m][n][1]); w.y = pk2(acc[m][n][2], acc[m][n][3]);
                *(u32x2*)(ZT + (size_t)(g * 64 + mm) * (2 * TC) + p * TC + tt * 128 + col) = w; }
    }
}
constexpr int FF_X = 0, FF_T1 = 81920, FF_T2 = 90112, FF_TW = 106496, FF_OUT = 0;
__device__ __forceinline__ void fft_load_tables(const Ctx& C) {
    const int tid = otid(); const u32x4* src = (const u32x4*)(ows(C.ws_) + WS_TF1);
#pragma unroll
    for (int q = 0; q < 5; ++q) { const int i = tid + q * NTHR; *(LAS u32x4*)(C.lds + FF_T1 + i * 16) = src[i]; }
    __syncthreads();
}
__device__ __forceinline__ void fft_item(const Ctx& C, int item) {
    const int b = item >> 5, ch0 = (item & 31) * 8; LAS unsigned char* lds = C.lds;
    const int tid = otid(), lane = tid & 63, w = owave(), lr = lane & 15, lq = lane >> 4;
    LAS unsigned char* fx = lds + FF_X + w * 10240;
    { const u32x4* src = (const u32x4*)(wsb(C, WS_R + R_ZT) + ((size_t)(b * 256 + ch0 + w)) * 4096);
#pragma unroll
      for (int i = 0; i < 8; ++i) { const int q = lane + 64 * i; *(LAS u32x4*)(fx + (q >> 2) * 80 + (q & 3) * 16) = src[q]; } }
    f32x4 acc1[4][4];
#pragma unroll
    for (int rt = 0; rt < 4; ++rt)
#pragma unroll
        for (int ct = 0; ct < 4; ++ct) acc1[rt][ct] = (f32x4){0.f, 0.f, 0.f, 0.f};
#pragma unroll
    for (int ks = 0; ks < 2; ++ks) { bf16x8 af[4];
#pragma unroll
        for (int rt = 0; rt < 4; ++rt) af[rt] = *(const LAS bf16x8*)(fx + (ks * 64 + 16 * rt + lr) * 80 + lq * 16);
#pragma unroll
        for (int ct = 0; ct < 4; ++ct) { const bf16x8 bfr = *(const LAS bf16x8*)(lds + FF_T1 + ((ct * 2 + ks) * 64 + lane) * 16);
#pragma unroll
            for (int rt = 0; rt < 4; ++rt) acc1[rt][ct] = __builtin_amdgcn_mfma_f32_16x16x32_bf16(af[rt], bfr, acc1[rt][ct], 0, 0, 0); } }
    bf16x8 VR[2][2], VI[2][2];
#pragma unroll
    for (int ct = 0; ct < 2; ++ct)
#pragma unroll
        for (int ks = 0; ks < 2; ++ks) { float vr[8], vi[8];
#pragma unroll
            for (int hf = 0; hf < 2; ++hf) { const int rt = 2 * ks + hf;
#pragma unroll
                for (int r = 0; r < 4; ++r) { const f32x2 tw = *(const LAS f32x2*)(lds + FF_TW + (((rt * 2 + ct) * 4 + r) * 64 + lane) * 8);
                    const float ur = acc1[rt][ct][r], ui = acc1[rt][ct + 2][r]; vr[hf * 4 + r] = ur * tw.x + ui * tw.y; vi[hf * 4 + r] = ui * tw.x - ur * tw.y; } }
            u32x4 pr, pi; pr.x = pk2(vr[0], vr[1]); pr.y = pk2(vr[2], vr[3]); pr.z = pk2(vr[4], vr[5]); pr.w = pk2(vr[6], vr[7]);
            pi.x = pk2(vi[0], vi[1]); pi.y = pk2(vi[2], vi[3]); pi.z = pk2(vi[4], vi[5]); pi.w = pk2(vi[6], vi[7]);
            VR[ct][ks] = __builtin_bit_cast(bf16x8, pr); VI[ct][ks] = __builtin_bit_cast(bf16x8, pi); }
    __syncthreads();
#pragma unroll
    for (int dt = 0; dt < 4; ++dt) { bf16x8 fc[2], fs[2];
#pragma unroll
        for (int ks = 0; ks < 2; ++ks) { fc[ks] = *(const LAS bf16x8*)(lds + FF_T2 + (((0 * 4 + dt) * 2 + ks) * 64 + lane) * 16); fs[ks] = *(const LAS bf16x8*)(lds + FF_T2 + (((1 * 4 + dt) * 2 + ks) * 64 + lane) * 16); }
#pragma unroll
        for (int ct = 0; ct < 2; ++ct) { f32x4 o = (f32x4){0.f, 0.f, 0.f, 0.f};
#pragma unroll
            for (int ks = 0; ks < 2; ++ks) { o = __builtin_amdgcn_mfma_f32_16x16x32_bf16(fc[ks], VR[ct][ks], o, 0, 0, 0); o = __builtin_amdgcn_mfma_f32_16x16x32_bf16(fs[ks], VI[ct][ks], o, 0, 0, 0); }
#pragma unroll
            for (int r = 0; r < 4; ++r) { const int d = 16 * dt + 4 * lq + r, c = 16 * ct + lr, k = c + 32 * d; *(LAS bf16*)(lds + FF_OUT + (k * 8 + w) * 2) = (bf16)f2bf(o[r]); } } }
    __syncthreads();
    { bf16* YS = wsb(C, WS_R + R_YS);
#pragma unroll
      for (int i = 0; i < 4; ++i) { const int k = tid + NTHR * i; *(u32x4*)(YS + (size_t)(b * T + k) * D + 512 + ch0) = *(const LAS u32x4*)(lds + FF_OUT + k * 16); } }
    __syncthreads();
}

constexpr bool LOCAL_BARS = true;
__global__ void __launch_bounds__(NTHR, 2) fwd_kernel(Params prm) {
    extern __shared__ __attribute__((aligned(16))) unsigned char lds_raw[];
    Ctx C; C.lds = (LAS unsigned char*)lds_raw; C.ws_ = prm.ws; C.in_ = prm.in; C.out_ = prm.out; C.vx = 0; C.vr = 0; C.loc = 0;

    volatile LAS unsigned* MISC = (volatile LAS unsigned*)(C.lds + LDS_MISC);
    if (threadIdx.x < 16) MISC[threadIdx.x] = 0u;
    __syncthreads();
    (void)xcd_barrier_post((unsigned*)(ows(C.ws_) + WS_CTL) + CW_BAR, MISC + 8);
#define BAR_(rel) do { XcdBarrier b_; b_.bar = (unsigned*)(ows(C.ws_) + WS_CTL) + CW_BAR; b_.x = (unsigned)__builtin_amdgcn_readfirstlane((int)xb_xcc_id()); b_.st = MISC + 8; xcd_barrier(b_, rel); } while (0)
#define GRID_BAR() BAR_(true)
#define BAR_X() BAR_(oloc(C) == 0)
#define BAR_L() do { if (LOCAL_BARS && oloc(C)) xcd_local_barrier((unsigned*)(ows(C.ws_) + WS_CTL) + CW_BAR, (unsigned)__builtin_amdgcn_readfirstlane((int)xb_xcc_id())); else BAR_(oloc(C) == 0); } while (0)

    p_prologue(C); GRID_BAR();
    { const int ok = (int)MISC[8 + 2];
      C.loc = __builtin_amdgcn_readfirstlane(ok); C.vx = __builtin_amdgcn_readfirstlane(ok ? (int)MISC[8 + 4] : (oblk() >> 5)); C.vr = __builtin_amdgcn_readfirstlane(ok ? (int)MISC[8 + 3] : (oblk() & 31)); }
    p_lna(C); BAR_L();

#pragma unroll 1
    for (int l = 0; l < DEPTH; ++l) {
        const bool last = (l == DEPTH - 1); const int mrows = last ? MLAT : M;
        const int nMl = last ? 16 : 18;
        const bf16* H = hbuf(C);
        { pg8::Gemm g{H, wW(C, WE_WIN + (size_t)l * 6144 * 1024), D, nullptr, D}; pg8::Sched<0> S; S.go.init_l(18, NINP / 256, ovr(C), ovx(C)); S.bp0 = 0; S.p0 = 0; S.pe = nullptr;
          { const int tid = otid(); if (tid < 64) *(LAS f32x4*)(C.lds + 131072 + tid * 16) = *(const f32x4*)(oin(C.in_)[8] + (size_t)l * 256 + tid * 4); __syncthreads(); }
          pg8::EpiCols E{wsb(C, WS_R + R_COLS)};
          pg8::gemm_phase<pg8::EpiCols, pg8::Sched<0>, false>(C.lds, g, S, E); }
        BAR_L();
        { const int nG = 288, nPL = 32, nPC = last ? 0 : 8, nSl = 128, nSc = last ? 0 : 16, nDl = 128, nDc = last ? 0 : 16;
          const int tot = nG + nPL + nPC + nSl + nSc + nDl + nDc, vx = ovx(C);
          for (int it = ovr(C); it < tot; it += 32) { int i = it;
              if (i < nG) { gla1_item(C, 288 * vx + i); continue; } i -= nG;
              if (i < nPL) { pool_lat_item(C, l, 32 * vx + i); continue; } i -= nPL;
              if (i < nPC) { pool_ctx_item(C, l, 8 * vx + i); continue; } i -= nPC;
              if (i < nSl + nSc) { sgu_item(C, l, i < nSl ? 128 * vx + i : 1024 + 16 * vx + (i - nSl), i < 32); continue; } i -= nSl + nSc;
              cdft_tile(C, i < nDl ? 128 * vx + i : 1024 + 16 * vx + (i - nDl)); } }
        BAR_L();
        gla2_all(C);
        fft_load_tables(C);
        for (int it = ovr(C); it < 64; it += 32) fft_item(C, 64 * ovx(C) + it);
        BAR_L();
        { for (int it = ovr(C); it < 288; it += 32) { const int gi = 288 * ovx(C) + it, rem = gi % 144; if (last && rem < 16) continue; gla3_item(C, l, gi); }
          bf16* YS = wsb(C, WS_R + R_YS);
          const int tid = otid(), lane = tid & 63, wave = owave(), wr = wave >> 2, wc = wave & 3, fr = lane & 15, fq = lane >> 4;
          const int nctx = last ? 0 : 8;
          for (int t2l = ovr(C); t2l < nctx; t2l += 32) { const int t2 = 8 * ovx(C) + t2l;
              const int b = t2 >> 2, tm = (t2 >> 1) & 1, tn = t2 & 1, K = 2 * TC, mrow0 = MLAT + b * TC; const bf16* A = wsb(C, WS_DLC); const bf16* Bt = wsb(C, WS_R + R_ZTC) + (size_t)b * 256 * 512;
              const bf16* pa0 = A + (size_t)(tm * 128 + (tid >> 3)) * K + (tid & 7) * 8; const bf16* pa1 = pa0 + (size_t)64 * K;
              const bf16* pb0 = Bt + (size_t)(tn * 128 + (tid >> 3)) * K + (tid & 7) * 8; const bf16* pb1 = pb0 + (size_t)64 * K;
              f32x4 acc[4][2]; tg_zero(acc); tg_tile(acc, C.lds, pa0, pa1, pb0, pb1, K / 64);
#pragma unroll
              for (int m = 0; m < 4; ++m)
#pragma unroll
                  for (int n = 0; n < 2; ++n) { const int row = mrow0 + tm * 128 + wr * 64 + m * 16 + fr, col = tn * 128 + wc * 32 + n * 16 + 4 * fq;
                      u32x2 w; w.x = pk2(acc[m][n][0], acc[m][n][1]); w.y = pk2(acc[m][n][2], acc[m][n][3]); *(u32x2*)(YS + (size_t)row * D + 512 + col) = w; }
          }
        }
        BAR_X();
        { pg8::Gemm g{wsb(C, WS_R + R_YS), wW(C, WE_WBR + (size_t)l * 4 * 1024 * 256), 256, nullptr, D}; pg8::Sched<4> S; S.go.init_l(nMl, 16, ovr(C), ovx(C), 1); S.bp0 = 0; S.p0 = 0; S.pe = nullptr;
          pg8::EpiP E{wsb(C, WS_R + R_G)};
          pg8::gemm_phase<pg8::EpiP, pg8::Sched<4>, false>(C.lds, g, S, E); }
        BAR_L();
        { pg8::Gemm g{(const bf16*)h8buf(C), (const bf16*)(ows(C.ws_) + WS_G8 + (size_t)l * 4096 * 1024), D / 2, nullptr, D / 2}; pg8::Sched<0> S; S.go.init_l(nMl, 16, ovr(C), ovx(C)); S.bp0 = 0; S.p0 = 0; S.pe = nullptr;
          pg8::EpiGateMix E{wsb(C, WS_R + R_G), wsb(C, WS_R + R_MM), 1.0f / G8_SCALE};
          pg8::gemm_phase<pg8::EpiGateMix, pg8::Sched<0>, false, true>(C.lds, g, S, E); }
        BAR_L();
        { pg8::Gemm g{wsb(C, WS_R + R_MM), wW(C, WE_WO + (size_t)l * D * D), D, nullptr, D}; pg8::Sched<0> S; S.go.init_l(nMl, 4, ovr(C), ovx(C), 1); S.bp0 = 0; S.p0 = 0; S.pe = nullptr;
          pg8::EpiAct E{wsb(C, WS_R + R_YS), D, EM_NONE, nullptr};
          pg8::gemm_phase<pg8::EpiAct, pg8::Sched<0>, false>(C.lds, g, S, E); }
        BAR_L();
        p_lnb(C, l, mrows);
        const bool moe = (l & 1); const int jm = l >> 1;
        if (moe) GRID_BAR(); else BAR_X();
        int npanels = mrows / 256;
        if (moe) { p_route_build(C, l, mrows); GRID_BAR(); RouteInfo R; route_info(C, jm, R); npanels = R.npanels; }
        { const int* rt = (const int*)(ows(C.ws_) + WS_ROUTE); const int* s2t = moe ? rt + RT_S2T : rt + RT_IDT; const int* pe = rt + RT_PE;
          const bf16* WGU = moe ? wW(C, WE_GUE + (size_t)jm * 8 * 5632 * 1024) : wW(C, WE_GUD + (size_t)jm * 5632 * 1024);
          const bf16* WDN = moe ? wW(C, WE_DE + (size_t)jm * 8 * 1024 * 2816) : wW(C, WE_DD + (size_t)jm * 1024 * 2816);
          bf16* ACT = wsb(C, WS_R + R_ACT); bf16* Y2 = wsb(C, WS_R + R_Y2);
          const int pcap = moe ? (DOWN8_MOE ? 296 : 128) : 144;
#pragma unroll 1
          for (int p0 = 0; p0 < npanels; p0 += pcap) { const int np = (npanels - p0) < pcap ? (npanels - p0) : pcap;
              const bool own = moe && oloc(C);
              const int plo = (np * ovx(C)) >> 3, phi = (np * (ovx(C) + 1)) >> 3;
              { pg8::Gemm g{(const bf16*)h8buf(C), WGU, D / 2, s2t, D / 2}; pg8::Sched<2> S; if (own) S.go.init_p(phi - plo, 22, ovr(C), plo); else if (moe) S.go.init(np, 22, ogrid(), oblk()); else S.go.init_l(nMl, 22, ovr(C), ovx(C), 1); S.bp0 = 0; S.p0 = p0; S.pe = moe ? pe : nullptr;
                const bool f8down = moe ? DOWN8_MOE : DOWN8_DENSE;
                pg8::EpiSwiGLU E{ACT, DFF, 1.0f / G8_SCALE, f8down ? ACT8_SCALE : 0.f};
                pg8::gemm_phase<pg8::EpiSwiGLU, pg8::Sched<2>, true, true>(C.lds, g, S, E); }
              if (moe && !own) GRID_BAR(); else BAR_L();
              if (moe ? DOWN8_MOE : DOWN8_DENSE) { pg8::Gemm g{ACT, WDN, DFF / 2, nullptr, DFF / 2}; pg8::Sched<3> S; if (own) S.go.init_p(phi - plo, 4, ovr(C), plo, 1); else if (moe) S.go.init(np, 4, ogrid(), oblk()); else S.go.init_l(nMl, 4, ovr(C), ovx(C)); S.bp0 = 8; S.p0 = p0; S.pe = moe ? pe : nullptr;
                pg8::EpiScale E{Y2, D, 1.0f / (G8_SCALE * ACT8_SCALE)};
                pg8::gemm_phase<pg8::EpiScale, pg8::Sched<3>, false, true>(C.lds, g, S, E); }
              else { pg8::Gemm g{ACT, WDN, DFF, nullptr, DFF}; pg8::Sched<3> S; if (own) S.go.init_p(phi - plo, 4, ovr(C), plo, 1); else if (moe) S.go.init(np, 4, ogrid(), oblk()); else S.go.init_l(nMl, 4, ovr(C), ovx(C)); S.bp0 = 4; S.p0 = p0; S.pe = moe ? pe : nullptr;
                pg8::EpiAct E{Y2, D, EM_NONE, nullptr};
                pg8::gemm_phase<pg8::EpiAct, pg8::Sched<3>, false>(C.lds, g, S, E); }
              if (!moe) BAR_L(); else if (own && p0 + np < npanels) BAR_X(); else GRID_BAR();
          } }
        p_lnc(C, l, mrows);
        if (!last) BAR_X();
    }
}

extern "C" void kernel_launch(void* const* d_in, const int* in_sizes, int n_in, void* d_out, int out_size, void* d_ws, size_t ws_size, hipStream_t stream) {
    static int grid = 0;
    if (grid == 0) {
        if (n_in != 28 || out_size != MLAT * D || ws_size < WS_END) { fprintf(stderr, "kernel_launch: unexpected shapes (n_in %d, out %d, ws %zu < %zu)\n", n_in, out_size, ws_size, (size_t)WS_END); grid = -1; return; }
        int dev = 0, cus = 0, per_cu = 0;
        if (hipGetDevice(&dev) != hipSuccess || hipDeviceGetAttribute(&cus, hipDeviceAttributeMultiprocessorCount, dev) != hipSuccess) { grid = -1; return; }
        if (hipFuncSetAttribute((const void*)fwd_kernel, hipFuncAttributeMaxDynamicSharedMemorySize, LDS_BYTES) != hipSuccess) { fprintf(stderr, "kernel_launch: hipFuncSetAttribute failed\n"); grid = -1; return; }
        if (hipOccupancyMaxActiveBlocksPerMultiprocessor(&per_cu, (const void*)fwd_kernel, NTHR, LDS_BYTES) != hipSuccess || per_cu < 1) fprintf(stderr, "kernel_launch: occupancy query says %d\n", per_cu);
        (void)hipGetLastError();
        grid = cus;
        if (grid != 256) { fprintf(stderr, "kernel_launch: built for 256 CUs, device has %d\n", cus); grid = -1; return; }
    }
    if (grid < 0) return;
    if (hipMemsetAsync((char*)d_ws + WS_CTL, 0, CTL_BYTES, stream) != hipSuccess) return;
    Params p{};
    for (int i = 0; i < 28; ++i) p.in[i] = (const float*)d_in[i];
    p.out = (float*)d_out; p.ws = (unsigned char*)d_ws;
    hipLaunchKernelGGL(fwd_kernel, dim3(grid), dim3(NTHR), LDS_BYTES, stream, p);
}
```

```cpp
#include <hip/hip_runtime.h>
#include <cstdio>
#include <cstdint>

#define GAS __attribute__((address_space(1)))
#define LAS __attribute__((address_space(3)))
typedef unsigned short bf16;
typedef short bf16x8 __attribute__((ext_vector_type(8)));
typedef float f32x4 __attribute__((ext_vector_type(4)));
typedef unsigned u32x4 __attribute__((ext_vector_type(4)));
typedef unsigned u32x2 __attribute__((ext_vector_type(2)));
typedef float f32x2 __attribute__((ext_vector_type(2)));

#ifndef PROBE
#define PROBE 0
#endif
constexpr int NB = 16, T = 2048, TC = 256, D = 1024, DEPTH = 4;
constexpr int MLAT = NB * T, MCTX = NB * TC, M = MLAT + MCTX;
constexpr int NIN = 1824, NINP = 2048, DFF = 2816, NE = 8;
constexpr int NTHR = 512, NWAVE = 8;
constexpr float ALPHA = 1.6817928305074290f;
constexpr float EPS = 1e-6f;
constexpr int C_Q = 0, C_K = 128, C_V = 256, C_R = 512, C_LAF = 768, C_LAB = 896, C_POOL = 1024, C_FFT = 1280, C_SU = 1536, C_SV = 1792;

constexpr size_t MiB = 1u << 20;
constexpr size_t WS_CTL = 0, CTL_BYTES = 1 * MiB;
constexpr size_t WS_MOD = 1 * MiB;
constexpr size_t WS_CS64 = 3 * MiB;
constexpr size_t WS_DLC = 3 * MiB + 65536;
constexpr size_t WS_SGUW = 3 * MiB + 512 * 1024;
constexpr size_t WS_TF1 = 4 * MiB;
constexpr size_t WS_TF2 = 4 * MiB + 8192;
constexpr size_t WS_TW = 4 * MiB + 24576;
constexpr size_t WS_ROUTE = 20 * MiB;
constexpr size_t WS_W = 22 * MiB;
constexpr size_t WS_XC = 384 * MiB;
constexpr size_t WS_G8 = WS_XC;
constexpr size_t OUT_H8 = 72 * MiB;
constexpr bool DOWN8_DENSE = true;
constexpr bool DOWN8_MOE = true;
constexpr float ACT8_SCALE = 2.0f;
constexpr float G8_SCALE = 32.0f;
constexpr size_t WS_H = 400 * MiB;
constexpr bool XBF16 = true;
constexpr size_t WS_R = 472 * MiB;
constexpr size_t WS_END = 904 * MiB;
constexpr size_t R_YS = 0, R_MM = 72 * MiB, R_BIG = 144 * MiB;
constexpr size_t R_COLS = R_BIG, R_SCR = R_BIG + 144 * MiB;
constexpr size_t R_ZT = R_SCR, R_ZTC = R_SCR + 32 * MiB, R_DH = R_SCR + 36 * MiB, R_DEC = R_SCR + 72 * MiB;
constexpr size_t R_G = R_BIG;
constexpr size_t R_ACT = 0, R_Y2 = 204 * MiB;
constexpr size_t WE_WIN = 0;
constexpr size_t WE_WBR = WE_WIN + (size_t)4 * 6144 * 1024;
constexpr size_t WE_WO = WE_WBR + (size_t)4 * 4 * 1024 * 256;
constexpr size_t WE_GUD = WE_WO + (size_t)4 * 1024 * 1024;
constexpr size_t WE_DD = WE_GUD + (size_t)2 * 5632 * 1024;
constexpr size_t WE_GUE = WE_DD + (size_t)2 * 1024 * 2816;
constexpr size_t WE_DE = WE_GUE + (size_t)2 * 8 * 5632 * 1024;
constexpr size_t WE_END = WE_DE + (size_t)2 * 8 * 1024 * 2816;
static_assert(WE_END * 2 <= 362 * MiB, "weights fit");
constexpr int MAXP = 296;
constexpr size_t RT_TOKE = 0, RT_TOKR = (size_t)M * 2, RT_TOKW = (size_t)M * 4, RT_TOKS = (size_t)M * 6, RT_S2T = (size_t)M * 8, RT_PE = RT_S2T + (size_t)MAXP * 256, RT_BLK = RT_PE + 512, RT_IDT = RT_BLK + 2048;
static_assert((RT_IDT + M) * 4 <= 2 * MiB, "route tables fit");
constexpr int CW_BAR = 4096;
constexpr int CW_CNT = 16384;
constexpr int LDS_BYTES = 147456;
constexpr int LDS_MISC = 147456 - 256;

typedef __bf16 hwbf2 __attribute__((ext_vector_type(2)));
__device__ __forceinline__ unsigned pk2(float lo, float hi) { hwbf2 v; v[0] = (__bf16)lo; v[1] = (__bf16)hi; return __builtin_bit_cast(unsigned, v); }
__device__ __forceinline__ unsigned f2bf(float f) { return (unsigned)__builtin_bit_cast(unsigned short, (__bf16)f); }
__device__ __forceinline__ unsigned pk4_fp8(float a, float b, float c, float d) { int w = 0; w = __builtin_amdgcn_cvt_pk_fp8_f32(a, b, w, false); w = __builtin_amdgcn_cvt_pk_fp8_f32(c, d, w, true); return (unsigned)w; }
__device__ __forceinline__ float bf2f(unsigned b) { return __builtin_bit_cast(float, b << 16); }
__device__ __forceinline__ float bflo(unsigned w) { return __builtin_bit_cast(float, w << 16); }
__device__ __forceinline__ float bfhi(unsigned w) { return __builtin_bit_cast(float, w & 0xffff0000u); }
typedef float f32x2 __attribute__((ext_vector_type(2)));
__device__ __forceinline__ float sigmoidf_(float x) { return __builtin_amdgcn_rcpf(1.0f + __expf(-x)); }
__device__ __forceinline__ float siluf_(float x) { return x * __builtin_amdgcn_rcpf(1.0f + __expf(-x)); }
__device__ __forceinline__ float gelu_tanh_(float x) { const float u = 0.7978845608028654f * (x + 0.044715f * x * x * x); return x * __builtin_amdgcn_rcpf(1.0f + __expf(-2.0f * u)); }
__device__ __forceinline__ float logsigmoidf_(float z) { return fminf(z, 0.f) - __logf(1.0f + __expf(-fabsf(z))); }
template <int CTRL, int RMASK> __device__ __forceinline__ float dpp_get(float v) { return __builtin_bit_cast(float, __builtin_amdgcn_update_dpp(0, __builtin_bit_cast(int, v), CTRL, RMASK, 0xF, true)); }
__device__ __forceinline__ float wave_sum(float v) {
    v += dpp_get<0xB1, 0xF>(v); v += dpp_get<0x4E, 0xF>(v); v += dpp_get<0x141, 0xF>(v); v += dpp_get<0x140, 0xF>(v);
    v += dpp_get<0x142, 0xA>(v); v += dpp_get<0x143, 0xC>(v);
    return __builtin_bit_cast(float, __builtin_amdgcn_readlane(__builtin_bit_cast(int, v), 63));
}

__device__ __forceinline__ int otid() { int t = threadIdx.x; asm volatile("" : "+v"(t)); return t; }
__device__ __forceinline__ int oblk() { int b = blockIdx.x; asm volatile("" : "+s"(b)); return b; }
__device__ __forceinline__ int ogrid() { int g = gridDim.x; asm volatile("" : "+s"(g)); return g; }
__device__ __forceinline__ int owave() { return __builtin_amdgcn_readfirstlane(otid() >> 6); }
__device__ __forceinline__ unsigned ozero() { unsigned z; asm volatile("s_mov_b32 %0, 0" : "=s"(z)); return z; }
__device__ __forceinline__ unsigned char* ows(unsigned char* p) { return p + ozero(); }
__device__ __forceinline__ const float* const* oin(const float* const* p) { return p; }
__device__ __forceinline__ float* oout(float* p) { return p + ozero(); }

#define XB_TMO      128
#define XB_XCNT(j)  (256  + 64 * (j))
#define XB_XSUB(j)  (1280 + 64 * (j))
#define XB_XGEN(j)  (2304 + 64 * (j))
#define XB_TOP      3328
#define XB_TOPGEN   3392
#define XB_LSUB(j)  (3456 + 64 * (j))
#define XB_LGEN(j)  (4480 + 64 * (j))
#define XCD_BAR_WORDS 3456
#define XB_SPIN_CAP (1u << 22)
__device__ __forceinline__ unsigned xb_ld(unsigned* p)              { return __hip_atomic_load(p, __ATOMIC_RELAXED, __HIP_MEMORY_SCOPE_AGENT); }
__device__ __forceinline__ unsigned xb_add(unsigned* p, unsigned v) { return __hip_atomic_fetch_add(p, v, __ATOMIC_RELAXED, __HIP_MEMORY_SCOPE_AGENT); }
__device__ __forceinline__ unsigned xb_xcc_id() { return (unsigned)__builtin_amdgcn_s_getreg((3 << 11) | 20) & 0xFu; }
#define XB_SPIN(cond, bar) do { unsigned _sp = 0; while (cond) { __builtin_amdgcn_s_sleep(1); \
    if ((++_sp & 255u) == 0u) { if (xb_ld(&(bar)[XB_TMO])) break; if (_sp > XB_SPIN_CAP) { atomicAdd(&(bar)[XB_TMO], 1u); break; } } } } while (0)
struct XcdBarrier { unsigned* bar; unsigned x; volatile LAS unsigned* st; };
__device__ __forceinline__ XcdBarrier xcd_barrier_post(unsigned* bar, volatile LAS unsigned* st) {
    XcdBarrier b; b.bar = bar; b.x = xb_xcc_id(); b.st = st;
    if (threadIdx.x == 0) { st[3] = xb_add(&bar[XB_XCNT(b.x)], 1u); st[4] = b.x; }
    return b;
}
__device__ __forceinline__ void xcd_barrier_complete(unsigned* bar, unsigned x, unsigned& nloc, unsigned& nx, unsigned& even) {
    const unsigned G = gridDim.x * gridDim.y * gridDim.z;
    unsigned sum, cnt, mine, odd, sp = 0u;
    for (;;) {
        sum = 0u; cnt = 0u; mine = 0u; odd = 0u;
#pragma unroll
        for (unsigned j = 0; j < 16; ++j) { const unsigned c = xb_ld(&bar[XB_XCNT(j)]); sum += c; cnt += (c > 0u) ? 1u : 0u; mine = (j == x) ? c : mine; odd += (j < 8u ? c != 32u : c != 0u) ? 1u : 0u; }
        if (sum == G) break;
        __builtin_amdgcn_s_sleep(1);
        if ((++sp & 255u) == 0u) { if (xb_ld(&bar[XB_TMO])) break; if (sp > XB_SPIN_CAP) { atomicAdd(&bar[XB_TMO], 1u); break; } }
    }
    nloc = mine > 0u ? mine : 1u; nx = cnt > 0u ? cnt : 1u; even = (odd == 0u && sum == 256u) ? 1u : 0u;
}
__device__ __forceinline__ void xcd_barrier(const XcdBarrier& b, bool rel) {
    asm volatile("s_waitcnt vmcnt(0)" ::: "memory");
    __syncthreads();
    if (otid() == 0) {
        unsigned* bar = b.bar;
        __builtin_amdgcn_s_waitcnt(0);
        unsigned nloc = b.st[0], nx = b.st[1];
        if (nloc == 0u) { unsigned even; xcd_barrier_complete(bar, b.x, nloc, nx, even); b.st[0] = nloc; b.st[1] = nx; b.st[2] = even; }
        const unsigned old = xb_add(&bar[XB_XSUB(b.x)], 1u);
        const unsigned gen = old / nloc;
        if (old + 1u == (gen + 1u) * nloc) {
            if (rel) __builtin_amdgcn_fence(__ATOMIC_RELEASE, "agent");
            asm volatile("s_waitcnt vmcnt(0)" ::: "memory");
            const unsigned og = xb_add(&bar[XB_TOP], 1u);
            const unsigned tg = og / nx;
            if (og + 1u == (tg + 1u) * nx) xb_add(&bar[XB_TOPGEN], 1u);
            else XB_SPIN(xb_ld(&bar[XB_TOPGEN]) == tg, bar);
            __builtin_amdgcn_fence(__ATOMIC_ACQUIRE, "agent");
            xb_add(&bar[XB_XGEN(b.x)], 1u);
            asm volatile("s_waitcnt vmcnt(0)" ::: "memory");
        } else {
            XB_SPIN(xb_ld(&bar[XB_XGEN(b.x)]) == gen, bar);
            __builtin_amdgcn_fence(__ATOMIC_ACQUIRE, "agent");
            asm volatile("s_waitcnt vmcnt(0)" ::: "memory");
        }
    }
    __syncthreads();
}

__device__ __forceinline__ void xcd_local_barrier(unsigned* bar, unsigned x) {
    asm volatile("s_waitcnt vmcnt(0)" ::: "memory");
    __syncthreads();
    if (otid() == 0) {
        __builtin_amdgcn_s_waitcnt(0);
        const unsigned old = xb_add(&bar[XB_LSUB(x)], 1u);
        const unsigned gen = old / 32u;
        if (old + 1u == (gen + 1u) * 32u) xb_add(&bar[XB_LGEN(x)], 1u);
        else XB_SPIN(xb_ld(&bar[XB_LGEN(x)]) == gen, bar);
        __builtin_amdgcn_fence(__ATOMIC_ACQUIRE, "agent");
        asm volatile("s_waitcnt vmcnt(0)" ::: "memory");
    }
    __syncthreads();
}

struct Params { const float* in[28]; float* out; unsigned char* ws; };
struct Ctx {
    LAS unsigned char* lds;
    unsigned char* ws_;
    const float* const* in_;
    float* out_;
    int vx, vr, loc;
};
__device__ __forceinline__ int ovx(const Ctx& C) { int v = C.vx; asm volatile("" : "+s"(v)); return v; }
__device__ __forceinline__ int ovr(const Ctx& C) { int v = C.vr; asm volatile("" : "+s"(v)); return v; }
__device__ __forceinline__ int oloc(const Ctx& C) { int v = C.loc; asm volatile("" : "+s"(v)); return v; }
__device__ __forceinline__ int lrow(const Ctx& C, int j) { const int vx = ovx(C); return j < 4096 ? 4096 * vx + j : MLAT + 512 * vx + (j - 4096); }
__device__ __forceinline__ bf16* wsb(const Ctx& C, size_t off) { return (bf16*)(ows(C.ws_) + off); }
__device__ __forceinline__ bf16* wW(const Ctx& C, size_t eoff) { return (bf16*)(ows(C.ws_) + WS_W) + eoff; }
__device__ __forceinline__ const float* modv(const Ctx& C, int l, int r, int part) { return (const float*)(ows(C.ws_) + WS_MOD) + ((size_t)(l * 17 + r) * 6144 + part * 1024); }
__device__ __forceinline__ int row_r(int m) { return m < MLAT ? (m >> 11) : 16; }

constexpr int TG_ROWB = 144;
constexpr int TG_OPB = 128 * TG_ROWB;
__device__ __forceinline__ void tg_tile(f32x4 (&acc)[4][2], LAS unsigned char* lds, const bf16* pa0, const bf16* pa1, const bf16* pb0, const bf16* pb1, int nk) {
    const int tid = otid(), lane = tid & 63, wave = tid >> 6, wr = wave >> 2, wc = wave & 3, fr = lane & 15, fq = lane >> 4;
    const int so0 = (tid >> 3) * TG_ROWB + (tid & 7) * 16, so1 = so0 + 64 * TG_ROWB;
    u32x4 ra0 = *(const u32x4*)pa0, ra1 = *(const u32x4*)pa1, rb0 = *(const u32x4*)pb0, rb1 = *(const u32x4*)pb1;
    *(LAS u32x4*)(lds + so0) = ra0; *(LAS u32x4*)(lds + so1) = ra1; *(LAS u32x4*)(lds + TG_OPB + so0) = rb0; *(LAS u32x4*)(lds + TG_OPB + so1) = rb1;
    __syncthreads();
    for (int kt = 0; kt < nk; ++kt) {
        const bool more = kt + 1 < nk;
        if (more) { const int ko = (kt + 1) * 64; ra0 = *(const u32x4*)(pa0 + ko); ra1 = *(const u32x4*)(pa1 + ko); rb0 = *(const u32x4*)(pb0 + ko); rb1 = *(const u32x4*)(pb1 + ko); }
        LAS unsigned char* cur = lds + (kt & 1) * (2 * TG_OPB);
#pragma unroll
        for (int ks = 0; ks < 2; ++ks) {
            bf16x8 af[4], bfr[2];
#pragma unroll
            for (int m = 0; m < 4; ++m) af[m] = *(const LAS bf16x8*)(cur + (wr * 64 + m * 16 + fr) * TG_ROWB + ks * 64 + fq * 16);
#pragma unroll
            for (int n = 0; n < 2; ++n) bfr[n] = *(const LAS bf16x8*)(cur + TG_OPB + (wc * 32 + n * 16 + fr) * TG_ROWB + ks * 64 + fq * 16);
#pragma unroll
            for (int m = 0; m < 4; ++m)
#pragma unroll
                for (int n = 0; n < 2; ++n) acc[m][n] = __builtin_amdgcn_mfma_f32_16x16x32_bf16(bfr[n], af[m], acc[m][n], 0, 0, 0);
        }
        if (more) { LAS unsigned char* nxt = lds + ((kt + 1) & 1) * (2 * TG_OPB);
            *(LAS u32x4*)(nxt + so0) = ra0; *(LAS u32x4*)(nxt + so1) = ra1; *(LAS u32x4*)(nxt + TG_OPB + so0) = rb0; *(LAS u32x4*)(nxt + TG_OPB + so1) = rb1; }
        __syncthreads();
    }
}
__device__ __forceinline__ void tg_zero(f32x4 (&acc)[4][2]) {
#pragma unroll
    for (int m = 0; m < 4; ++m)
#pragma unroll
        for (int n = 0; n < 2; ++n) acc[m][n] = (f32x4){0.f, 0.f, 0.f, 0.f};
}

enum { EM_NONE = 0, EM_SIGMOID = 1, EM_COLS = 2 };
__device__ __forceinline__ f32x4 epi_apply(f32x4 v, int mode, int col, const float* bgk) {
    if (mode == EM_NONE) return v;
    if (mode == EM_SIGMOID) { for (int j = 0; j < 4; ++j) v[j] = sigmoidf_(v[j]); return v; }
    if (col < C_K) { for (int j = 0; j < 4; ++j) v[j] *= 0.17677669529663689f; }
    else if (col < C_R) {}
    else if (col < C_LAF) { for (int j = 0; j < 4; ++j) v[j] = siluf_(v[j]); }
    else if (col < C_POOL) { for (int j = 0; j < 4; ++j) v[j] = logsigmoidf_(v[j] + bgk[col - C_LAF + j]) * 0.0625f; }
    else if (col < C_SU) {}
    else { for (int j = 0; j < 4; ++j) v[j] = gelu_tanh_(v[j]); }
    return v;
}
__device__ __forceinline__ void tg_gemm_plain(const Ctx& C, const bf16* A, int lda, const int* rowmap, int mrows, const bf16* Bt, int ldb, int ncols, int K,
                                              bf16* O, int ldo, int mode, const float* bgk) {
    const int tid = otid(), lane = tid & 63, wave = owave(), wr = wave >> 2, wc = wave & 3, fr = lane & 15, fq = lane >> 4;
    const int ntn = ncols / 128, ntiles = (mrows / 128) * ntn;
    for (int t = oblk(); t < ntiles; t += ogrid()) {
        const int tm = t / ntn, tn = t % ntn;
        const int r0 = tm * 128 + (tid >> 3), r1 = r0 + 64;
        const size_t ar0 = rowmap ? (size_t)rowmap[r0] : (size_t)r0, ar1 = rowmap ? (size_t)rowmap[r1] : (size_t)r1;
        const bf16* pa0 = A + ar0 * lda + (tid & 7) * 8; const bf16* pa1 = A + ar1 * lda + (tid & 7) * 8;
        const bf16* pb0 = Bt + (size_t)(tn * 128 + (tid >> 3)) * ldb + (tid & 7) * 8; const bf16* pb1 = pb0 + (size_t)64 * ldb;
        f32x4 acc[4][2]; tg_zero(acc);
        tg_tile(acc, C.lds, pa0, pa1, pb0, pb1, K / 64);
#pragma unroll
        for (int m = 0; m < 4; ++m)
#pragma unroll
            for (int n = 0; n < 2; ++n) {
                const int row = tm * 128 + wr * 64 + m * 16 + fr, col = tn * 128 + wc * 32 + n * 16 + 4 * fq;
                const f32x4 v = epi_apply(acc[m][n], mode, col, bgk);
                u32x2 w; w.x = pk2(v[0], v[1]); w.y = pk2(v[2], v[3]);
                *(u32x2*)(O + (size_t)row * ldo + col) = w;
            }
    }
}


namespace pg8 {
constexpr int BM = 256, BK = 64, HALF = 128, HTB = HALF * BK * 2, STAGE_BYTES = 8 * HTB;
__device__ __forceinline__ int lds_byte(int r, int c) { return r * 128 + ((((c >> 3) ^ (r >> 1)) & 7) << 4) + (c & 7) * 2; }
__device__ __forceinline__ void stage_rc(int b, int& R, int& C) { R = b >> 7; C = ((((b >> 4) ^ (R >> 1)) & 7) << 3) + ((b & 15) >> 1); }
__device__ __forceinline__ int perm32(int rho) { const int n = rho >> 4, i = rho & 15; return 8 * (i >> 2) + 4 * n + (i & 3); }
struct Unit { int ap, bp, orow, ocol, akb; };
struct Gemm { const bf16* A; const bf16* Bt; int K; const int* rowmap; int lda; };
struct GridOrder {
    int nM, nN, nwg, G, c, vx, pb, rev;
    __device__ __forceinline__ void init(int nM_, int nN_, int G_, int c_) { nM = nM_; nN = nN_; nwg = nM * nN; G = G_; c = c_; vx = -1; pb = 0; rev = 0; }
    __device__ __forceinline__ void init_l(int nMl, int nN_, int vr_, int vx_, int rev_ = 0) { nM = nMl; nN = nN_; nwg = nM * nN; G = 32; c = vr_; vx = vx_; pb = 0; rev = rev_; }
    __device__ __forceinline__ void init_p(int nMl, int nN_, int vr_, int pb_, int rev_ = 0) { nM = nMl; nN = nN_; nwg = nM * nN; G = 32; c = vr_; vx = -2; pb = pb_; rev = rev_; }
    __device__ __forceinline__ bool mn(int i, int& pm, int& pn) const {
        const long L = (long)i * G + c; if (L >= nwg) return false;
        int wgid = (int)L; if (vx == -1) { const int q = nwg / 8, r = nwg % 8, xcd = wgid % 8, off = wgid / 8; wgid = (xcd < r ? xcd * (q + 1) : r * (q + 1) + (xcd - r) * q) + off; }
        const int nig = 8 * nN, gid = wgid / nig, fm = gid * 8, gsz = (nM - fm) < 8 ? (nM - fm) : 8;
        pm = fm + ((wgid % nig) % gsz); pn = (wgid % nig) / gsz;
        if (rev) pm = nM - 1 - pm;
        if (vx >= 0) pm = pm < 16 ? 16 * vx + pm : 128 + 2 * vx + (pm - 16); else if (vx == -2) pm += pb;
        return true;
    }
};
__device__ __forceinline__ unsigned cvt_pk_bf16(float lo, float hi) { unsigned r; asm volatile("v_cvt_pk_bf16_f32 %0, %1, %2" : "=v"(r) : "v"(lo), "v"(hi)); return r; }

typedef int i32x4 __attribute__((ext_vector_type(4)));
template <class Epi, class Sched, bool GATHER, bool F8 = false>
__device__ __forceinline__ void gemm_phase(LAS unsigned char* lds, const Gemm g, const Sched& S, const Epi& E) {
    const int tid = otid(), wid = __builtin_amdgcn_readfirstlane(tid >> 6), lane = tid & 63, wr = wid >> 2, wc = wid & 3, fr = lane & 15, fq = lane >> 4;
    const int K = g.K, nt = K / BK;
    int Rl[2]; unsigned Cb[2], voffB[2];
#pragma unroll
    for (int i = 0; i < 2; ++i) { int R, Cc; stage_rc(tid * 16 + i * 8192, R, Cc); const int Rb = (R & ~31) + perm32(R & 31); Rl[i] = R; Cb[i] = (unsigned)Cc * 2u; voffB[i] = (unsigned)(Rb * K + Cc) * 2u; }
    const size_t kstep = (size_t)(BK * 2), hstep = (size_t)HALF * K * 2, tstep = 2 * hstep;
    const unsigned ldsw = (unsigned)wid * 1024u;
    const int aoff0 = lds_byte(wr * 64 + fr, fq * 8), aoff1 = lds_byte(wr * 64 + fr, 32 + fq * 8), boff0 = lds_byte(wc * 32 + fr, fq * 8), boff1 = lds_byte(wc * 32 + fr, 32 + fq * 8);
#define PG8_SA(b, h) (((b) * 2 + (h)) * HTB)
#define PG8_SB(b, h) ((4 + (b) * 2 + (h)) * HTB)
#define PG8_STAGE(bufoff, gbase, voff) do { _Pragma("unroll") for (int _i = 0; _i < 2; ++_i) \
        __builtin_amdgcn_global_load_lds((const unsigned*)((const char*)(gbase) + (voff)[_i]), (LAS unsigned*)(lds + (bufoff) + ldsw + _i * 8192), 16, 0, 0); } while (0)
#define PG8_LDA(dst, b, h) do { _Pragma("unroll") for (int m = 0; m < 4; ++m) { dst[m][0] = *(const LAS bf16x8*)(lds + PG8_SA(b, h) + aoff0 + m * 2048); dst[m][1] = *(const LAS bf16x8*)(lds + PG8_SA(b, h) + aoff1 + m * 2048); } } while (0)
#define PG8_LDB(dst, b, h) do { _Pragma("unroll") for (int n = 0; n < 2; ++n) { dst[n][0] = *(const LAS bf16x8*)(lds + PG8_SB(b, h) + boff0 + n * 2048); dst[n][1] = *(const LAS bf16x8*)(lds + PG8_SB(b, h) + boff1 + n * 2048); } } while (0)
#define PG8_MMA(ai, bj, At, Bt) do { __builtin_amdgcn_s_setprio(1); _Pragma("unroll") for (int m = 0; m < 4; ++m) _Pragma("unroll") for (int n = 0; n < 2; ++n) { \
        if (F8) { const i32x4 b0_ = __builtin_bit_cast(i32x4, Bt[n][0]), b1_ = __builtin_bit_cast(i32x4, Bt[n][1]), a0_ = __builtin_bit_cast(i32x4, At[m][0]), a1_ = __builtin_bit_cast(i32x4, At[m][1]); \
            acc[ai][bj][m][n] = __builtin_amdgcn_mfma_scale_f32_16x16x128_f8f6f4(__builtin_shufflevector(b0_, b1_, 0, 1, 2, 3, 4, 5, 6, 7), __builtin_shufflevector(a0_, a1_, 0, 1, 2, 3, 4, 5, 6, 7), acc[ai][bj][m][n], 0, 0, 0, 0x7F7F7F7F, 0, 0x7F7F7F7F); } \
        else { _Pragma("unroll") for (int k = 0; k < 2; ++k) acc[ai][bj][m][n] = __builtin_amdgcn_mfma_f32_16x16x32_bf16(Bt[n][k], At[m][k], acc[ai][bj][m][n], 0, 0, 0); } } __builtin_amdgcn_s_setprio(0); } while (0)
#define PG8_WAIT_V(n) asm volatile("s_waitcnt vmcnt(" #n ")" ::: "memory")
#define PG8_WAIT_L(n) asm volatile("s_waitcnt lgkmcnt(" #n ")" ::: "memory")
#define PG8_WAIT_VF() do { (void)fresh; PG8_WAIT_V(8); } while (0)
#define PG8_BAR __builtin_amdgcn_s_barrier()
#define PG8_SCHED __builtin_amdgcn_sched_barrier(0)
#define PG8_AOFF(dst, u) do { _Pragma("unroll") for (int _h = 0; _h < 2; ++_h) _Pragma("unroll") for (int _i = 0; _i < 2; ++_i) { \
        const int _r = (u).ap * BM + _h * HALF + Rl[_i]; const unsigned _row = GATHER ? (unsigned)g.rowmap[_r] : (unsigned)_r; dst[_h][_i] = _row * (unsigned)(g.lda * 2) + Cb[_i] + (unsigned)(u).akb; } } while (0)
    Unit cur, nxt; int ui = 0;
    if (!S.next(0, cur)) return;
    f32x4 acc[2][2][4][2];
#pragma unroll
    for (int a = 0; a < 2; ++a)
#pragma unroll
        for (int b = 0; b < 2; ++b)
#pragma unroll
            for (int m = 0; m < 4; ++m)
#pragma unroll
                for (int n = 0; n < 2; ++n) acc[a][b][m][n] = (f32x4){0.f, 0.f, 0.f, 0.f};
    bf16x8 At[4][2], B0[2][2], B1[2][2];
    unsigned ao[2][2], nao[2][2]; bool fresh = false;
    PG8_AOFF(ao, cur);
    const char* Ab = (const char*)g.A;
    const char* cB = (const char*)g.Bt + (size_t)cur.bp * tstep;
    PG8_STAGE(PG8_SB(0, 0), cB, voffB); PG8_STAGE(PG8_SB(0, 1), cB + hstep, voffB); PG8_STAGE(PG8_SA(0, 0), Ab, ao[0]); PG8_STAGE(PG8_SA(0, 1), Ab, ao[1]);
    if (wr == 1) PG8_BAR;
    PG8_WAIT_V(2); PG8_BAR;
    PG8_STAGE(PG8_SB(1, 0), cB + kstep, voffB); PG8_STAGE(PG8_SA(1, 0), Ab + kstep, ao[0]); PG8_STAGE(PG8_SB(1, 1), cB + hstep + kstep, voffB);
    PG8_WAIT_V(6); PG8_BAR;
    for (;;) {
        const bool has_next = S.next(ui + 1, nxt);
        if (has_next) { PG8_AOFF(nao, nxt); }
        else {
#pragma unroll
            for (int _h = 0; _h < 2; ++_h)
#pragma unroll
                for (int _i = 0; _i < 2; ++_i) nao[_h][_i] = ao[_h][_i]; }
        const char* nB = has_next ? (const char*)g.Bt + (size_t)nxt.bp * tstep : cB;
#pragma unroll 1
        for (int t = 0; t < nt; t += 2) {
            const bool last = (t == nt - 2);
            const char* a1 = Ab + (size_t)(t + 1) * kstep;
            const char* a2 = last ? Ab : Ab + (size_t)(t + 2) * kstep; const char* b2 = last ? nB : cB + (size_t)(t + 2) * kstep;
            const char* a3 = a2 + kstep; const char* b3 = b2 + kstep;
            PG8_LDB(B0, 0, 0); PG8_LDB(B1, 0, 1); PG8_SCHED; PG8_LDA(At, 0, 0); PG8_STAGE(PG8_SA(1, 1), a1, ao[1]);
            if (last) {
#pragma unroll
                for (int _h = 0; _h < 2; ++_h)
#pragma unroll
                    for (int _i = 0; _i < 2; ++_i) ao[_h][_i] = nao[_h][_i]; }
            PG8_WAIT_VF(); PG8_WAIT_L(0); PG8_BAR; PG8_MMA(0, 0, At, B0); PG8_MMA(0, 1, At, B1); PG8_BAR; PG8_SCHED;
            PG8_LDA(At, 0, 1); PG8_STAGE(PG8_SB(0, 0), b2, voffB); PG8_STAGE(PG8_SB(0, 1), b2 + hstep, voffB); PG8_STAGE(PG8_SA(0, 0), a2, ao[0]);
            PG8_WAIT_VF(); PG8_WAIT_L(0); PG8_BAR; PG8_MMA(1, 0, At, B0); PG8_MMA(1, 1, At, B1); PG8_BAR; PG8_SCHED;
            fresh = false;
            PG8_LDB(B0, 1, 0); PG8_LDB(B1, 1, 1); PG8_SCHED; PG8_LDA(At, 1, 0); PG8_STAGE(PG8_SA(0, 1), a2, ao[1]);
            PG8_WAIT_V(8); PG8_WAIT_L(0); PG8_BAR; PG8_MMA(0, 0, At, B0); PG8_MMA(0, 1, At, B1); PG8_BAR; PG8_SCHED;
            PG8_LDA(At, 1, 1); PG8_STAGE(PG8_SB(1, 0), b3, voffB); PG8_STAGE(PG8_SB(1, 1), b3 + hstep, voffB); PG8_STAGE(PG8_SA(1, 0), a3, ao[0]);
            PG8_WAIT_V(8); PG8_WAIT_L(0); PG8_BAR; PG8_MMA(1, 0, At, B0); PG8_MMA(1, 1, At, B1); PG8_BAR; PG8_SCHED;
        }
        if (wr == 0) PG8_BAR;
        E(acc, cur, wr, wc, fr, fq);
        if (PROBE == 12) { asm volatile("" ::: "memory"); E(acc, cur, wr, wc, fr, fq); }
        if (!has_next) break;
#pragma unroll
        for (int a = 0; a < 2; ++a)
#pragma unroll
            for (int b = 0; b < 2; ++b)
#pragma unroll
                for (int m = 0; m < 4; ++m)
#pragma unroll
                    for (int n = 0; n < 2; ++n) acc[a][b][m][n] = (f32x4){0.f, 0.f, 0.f, 0.f};
        cur = nxt; cB = nB; ++ui; fresh = true;
        if (wr == 1) PG8_BAR;
    }
    PG8_WAIT_V(0);
    PG8_BAR;
#undef PG8_SA
#undef PG8_SB
#undef PG8_STAGE
#undef PG8_LDA
#undef PG8_LDB
#undef PG8_MMA
#undef PG8_WAIT_V
#undef PG8_WAIT_L
#undef PG8_WAIT_VF
#undef PG8_BAR
#undef PG8_SCHED
#undef PG8_AOFF
}
struct EpiAct {
    static constexpr int NVM = 16;
    bf16* O; int ldo; int mode; const float* bgk;
    __device__ __forceinline__ void operator()(const f32x4 (&acc)[2][2][4][2], const Unit& u, int wr, int wc, int fr, int fq) const {
#pragma unroll
        for (int ai = 0; ai < 2; ++ai)
#pragma unroll
            for (int m = 0; m < 4; ++m) { bf16* rowp = O + (size_t)(u.orow + ai * HALF + wr * 64 + m * 16 + fr) * ldo + u.ocol + wc * 32 + 8 * fq;
#pragma unroll
                for (int bj = 0; bj < 2; ++bj) { const int col = u.ocol + bj * HALF + wc * 32 + 8 * fq;
                    const f32x4 v0 = epi_apply(acc[ai][bj][m][0], mode, col, bgk), v1 = epi_apply(acc[ai][bj][m][1], mode, col + 4, bgk);
                    u32x4 w; w.x = cvt_pk_bf16(v0[0], v0[1]); w.y = cvt_pk_bf16(v0[2], v0[3]); w.z = cvt_pk_bf16(v1[0], v1[1]); w.w = cvt_pk_bf16(v1[2], v1[3]);
                    *(u32x4*)(rowp + bj * HALF) = w; } }
    }
};
__device__ __forceinline__ size_t p_index(size_t row, int i, int c) { return row * 4096 + (size_t)((c >> 6) * 256 + ((c >> 5) & 1) * 128 + i * 32 + (c & 31)); }
struct EpiP {
    static constexpr int NVM = 16;
    bf16* O;
    __device__ __forceinline__ void operator()(const f32x4 (&acc)[2][2][4][2], const Unit& u, int wr, int wc, int fr, int fq) const {
        const int i = u.ocol >> 10, c0 = (u.ocol & 1023) + wc * 32 + 8 * fq;
#pragma unroll
        for (int ai = 0; ai < 2; ++ai)
#pragma unroll
            for (int m = 0; m < 4; ++m) { const size_t row = (size_t)(u.orow + ai * HALF + wr * 64 + m * 16 + fr);
#pragma unroll
                for (int bj = 0; bj < 2; ++bj) { const f32x4 v0 = acc[ai][bj][m][0], v1 = acc[ai][bj][m][1];
                    u32x4 w; w.x = cvt_pk_bf16(v0[0], v0[1]); w.y = cvt_pk_bf16(v0[2], v0[3]); w.z = cvt_pk_bf16(v1[0], v1[1]); w.w = cvt_pk_bf16(v1[2], v1[3]);
                    *(u32x4*)(O + p_index(row, i, c0 + bj * HALF)) = w; } }
    }
};
struct EpiCols {
    static constexpr int NVM = 16;
    bf16* O;
    __device__ __forceinline__ void operator()(const f32x4 (&acc)[2][2][4][2], const Unit& u, int wr, int wc, int fr, int fq) const {
        const int tile = __builtin_amdgcn_readfirstlane(u.ocol >> 8);
        f32x4 bv[2][2];
        if (tile == 3) {
#pragma unroll
            for (int bj = 0; bj < 2; ++bj)
#pragma unroll
                for (int n = 0; n < 2; ++n) bv[bj][n] = *(const LAS f32x4*)((LAS unsigned char*)131072 + (bj * HALF + wc * 32 + 8 * fq + 4 * n) * 4);
        }
#pragma unroll
        for (int ai = 0; ai < 2; ++ai)
#pragma unroll
            for (int m = 0; m < 4; ++m) { bf16* rowp = O + (size_t)(u.orow + ai * HALF + wr * 64 + m * 16 + fr) * NINP + u.ocol + wc * 32 + 8 * fq;
#pragma unroll
                for (int bj = 0; bj < 2; ++bj) { f32x4 v0 = acc[ai][bj][m][0], v1 = acc[ai][bj][m][1];
                    if (tile == 0) { if (bj == 0) { v0 = v0 * 0.17677669529663689f; v1 = v1 * 0.17677669529663689f; } }
                    else if (tile == 2) {
#pragma unroll
                        for (int j = 0; j < 4; ++j) { v0[j] = siluf_(v0[j]); v1[j] = siluf_(v1[j]); } }
                    else if (tile == 3) {
#pragma unroll
                        for (int j = 0; j < 4; ++j) { v0[j] = logsigmoidf_(v0[j] + bv[bj][0][j]) * 0.0625f; v1[j] = logsigmoidf_(v1[j] + bv[bj][1][j]) * 0.0625f; } }
                    else if (tile >= 6) {
#pragma unroll
                        for (int j = 0; j < 4; ++j) { v0[j] = gelu_tanh_(v0[j]); v1[j] = gelu_tanh_(v1[j]); } }
                    u32x4 w; w.x = cvt_pk_bf16(v0[0], v0[1]); w.y = cvt_pk_bf16(v0[2], v0[3]); w.z = cvt_pk_bf16(v1[0], v1[1]); w.w = cvt_pk_bf16(v1[2], v1[3]);
                    *(u32x4*)(rowp + bj * HALF) = w; } }
    }
};
struct EpiGateMix {
    static constexpr int NVM = 8;
    const bf16* P; bf16* MMo; float gs;
    __device__ __forceinline__ void operator()(const f32x4 (&acc)[2][2][4][2], const Unit& u, int wr, int wc, int fr, int fq) const {
        const int col = (u.ocol >> 2) + wc * 16 + 4 * fq;
#pragma unroll
        for (int ai = 0; ai < 2; ++ai) {
            u32x2 pw[4][4];
#pragma unroll
            for (int m = 0; m < 4; ++m) { const size_t row = (size_t)(u.orow + ai * HALF + wr * 64 + m * 16 + fr);
#pragma unroll
                for (int i = 0; i < 4; ++i) pw[m][i] = *(const u32x2*)(P + p_index(row, i, col)); }
#pragma unroll
            for (int m = 0; m < 4; ++m) { const size_t row = (size_t)(u.orow + ai * HALF + wr * 64 + m * 16 + fr);
                f32x2 s01 = (f32x2){0.f, 0.f}, s23 = s01; const float kc = -1.4426950408889634f * gs;
#pragma unroll
                for (int i = 0; i < 4; ++i) { const f32x4 g = acc[ai][i >> 1][m][i & 1];
                    f32x2 d01 = (f32x2){__builtin_amdgcn_exp2f(g[0] * kc), __builtin_amdgcn_exp2f(g[1] * kc)}, d23 = (f32x2){__builtin_amdgcn_exp2f(g[2] * kc), __builtin_amdgcn_exp2f(g[3] * kc)};
                    d01 = d01 + 1.0f; d23 = d23 + 1.0f;
                    const f32x2 r01 = (f32x2){__builtin_amdgcn_rcpf(d01[0]), __builtin_amdgcn_rcpf(d01[1])}, r23 = (f32x2){__builtin_amdgcn_rcpf(d23[0]), __builtin_amdgcn_rcpf(d23[1])};
                    const f32x2 p01 = (f32x2){bflo(pw[m][i].x), bfhi(pw[m][i].x)}, p23 = (f32x2){bflo(pw[m][i].y), bfhi(pw[m][i].y)};
                    s01 = r01 * p01 + s01; s23 = r23 * p23 + s23; }
                f32x4 s; s[0] = s01[0]; s[1] = s01[1]; s[2] = s23[0]; s[3] = s23[1];
                u32x2 w; w.x = cvt_pk_bf16(s[0], s[1]); w.y = cvt_pk_bf16(s[2], s[3]);
                *(u32x2*)(MMo + row * D + col) = w; } }
    }
};
struct EpiSwiGLU {
    static constexpr int NVM = 8;
    bf16* O; int ldo; float gs; float o8;
    __device__ __forceinline__ void operator()(const f32x4 (&acc)[2][2][4][2], const Unit& u, int wr, int wc, int fr, int fq) const {
#pragma unroll
        for (int ai = 0; ai < 2; ++ai)
#pragma unroll
            for (int m = 0; m < 4; ++m) { bf16* rowp = O + (size_t)(u.orow + ai * HALF + wr * 64 + m * 16 + fr) * ldo + u.ocol + wc * 32 + 8 * fq;
                f32x4 v0, v1;
                { const float kc = -1.4426950408889634f * gs, g2 = gs * gs * (o8 > 0.f ? o8 : 1.0f);
                  const f32x4 ga = acc[ai][0][m][0], gb = acc[ai][0][m][1], ua = acc[ai][1][m][0], ub = acc[ai][1][m][1];
                  f32x4 da, db;
#pragma unroll
                  for (int j = 0; j < 4; ++j) { da[j] = __builtin_amdgcn_exp2f(ga[j] * kc); db[j] = __builtin_amdgcn_exp2f(gb[j] * kc); }
                  da = da + 1.0f; db = db + 1.0f;
#pragma unroll
                  for (int j = 0; j < 4; ++j) { da[j] = __builtin_amdgcn_rcpf(da[j]); db[j] = __builtin_amdgcn_rcpf(db[j]); }
                  v0 = (ga * ua) * (da * g2); v1 = (gb * ub) * (db * g2); }
                if (o8 > 0.f) { u32x2 w; w.x = pk4_fp8(v0[0], v0[1], v0[2], v0[3]); w.y = pk4_fp8(v1[0], v1[1], v1[2], v1[3]);
                    *(u32x2*)((unsigned char*)O + (size_t)(u.orow + ai * HALF + wr * 64 + m * 16 + fr) * ldo + u.ocol + wc * 32 + 8 * fq) = w; }
                else { u32x4 w; w.x = cvt_pk_bf16(v0[0], v0[1]); w.y = cvt_pk_bf16(v0[2], v0[3]); w.z = cvt_pk_bf16(v1[0], v1[1]); w.w = cvt_pk_bf16(v1[2], v1[3]);
                    *(u32x4*)rowp = w; } }
    }
};
struct EpiScale {
    static constexpr int NVM = 16;
    bf16* O; int ldo; float gs;
    __device__ __forceinline__ void operator()(const f32x4 (&acc)[2][2][4][2], const Unit& u, int wr, int wc, int fr, int fq) const {
#pragma unroll
        for (int ai = 0; ai < 2; ++ai)
#pragma unroll
            for (int m = 0; m < 4; ++m) { bf16* rowp = O + (size_t)(u.orow + ai * HALF + wr * 64 + m * 16 + fr) * ldo + u.ocol + wc * 32 + 8 * fq;
#pragma unroll
                for (int bj = 0; bj < 2; ++bj) { const f32x4 v0 = acc[ai][bj][m][0] * gs, v1 = acc[ai][bj][m][1] * gs;
                    u32x4 w; w.x = cvt_pk_bf16(v0[0], v0[1]); w.y = cvt_pk_bf16(v0[2], v0[3]); w.z = cvt_pk_bf16(v1[0], v1[1]); w.w = cvt_pk_bf16(v1[2], v1[3]);
                    *(u32x4*)(rowp + bj * HALF) = w; } }
    }
};
template <int KIND> struct Sched {
    GridOrder go; int bp0, p0; const int* pe;
    __device__ __forceinline__ bool next(int i, Unit& u) const {
        int pm, pn; if (!go.mn(i, pm, pn)) return false;
        u.akb = 0;
        if (KIND == 0) { u.ap = pm; u.bp = bp0 + pn; u.orow = pm * BM; u.ocol = pn * BM; }
        else if (KIND == 4) { const int i = pn & 3, cp = pn >> 2; u.ap = pm; u.bp = i * 4 + cp; u.orow = pm * BM; u.ocol = i * 1024 + cp * BM; u.akb = i * 512; }
        else if (KIND == 1) { u.ap = pm; u.bp = pn; u.orow = pn * 2048 + pm * BM; u.ocol = 512; }
        else if (KIND == 2) { const int e = pe ? pe[p0 + pm] : 0; u.ap = p0 + pm; u.bp = e * 44 + pn; u.orow = pm * BM; u.ocol = pn * HALF; }
        else { const int e = pe ? pe[p0 + pm] : 0; u.ap = pm; u.bp = e * bp0 + pn; u.orow = (p0 + pm) * BM; u.ocol = pn * BM; }
        return true;
    }
};
}

__device__ __forceinline__ int gate_row(int i, int cc) { return 256 * (cc >> 6) + 128 * (i >> 1) + 32 * ((cc >> 4) & 3) + 8 * ((cc >> 2) & 3) + 4 * (i & 1) + (cc & 3); }
__device__ __forceinline__ void xpose_item(const float* W, int ldw, int k0, int n0, bf16* WT, int ldk, int drow0, LAS float* scr, int lane, int gate_i = -1) {
#pragma unroll 8
    for (int i = 0; i < 32; ++i) { const int kk = 2 * i + (lane >> 5); scr[kk * 33 + (lane & 31)] = W[(size_t)(k0 + kk) * ldw + n0 + (lane & 31)]; }
    asm volatile("s_waitcnt lgkmcnt(0)" ::: "memory");
    const int c = lane & 7;
#pragma unroll
    for (int j = 0; j < 4; ++j) { const int n = (lane >> 3) + 8 * j; const LAS float* s = scr + (8 * c) * 33 + n;
        u32x4 o; o.x = pk2(s[0 * 33], s[1 * 33]); o.y = pk2(s[2 * 33], s[3 * 33]); o.z = pk2(s[4 * 33], s[5 * 33]); o.w = pk2(s[6 * 33], s[7 * 33]);
        const int drow = gate_i < 0 ? drow0 + n : drow0 + gate_row(gate_i, n0 + n);
        *(u32x4*)(WT + (size_t)drow * ldk + k0 + 8 * c) = o; }
    asm volatile("s_waitcnt lgkmcnt(0)" ::: "memory");
}
__device__ __forceinline__ void xpose_item_fp8(const float* W, int ldw, int k0, int n0, unsigned char* WT, int ldk, LAS float* scr, int lane, int gate_i, float scale, int drow0 = 0) {
#pragma unroll 8
    for (int i = 0; i < 32; ++i) { const int kk = 2 * i + (lane >> 5); scr[kk * 33 + (lane & 31)] = W[(size_t)(k0 + kk) * ldw + n0 + (lane & 31)]; }
    asm volatile("s_waitcnt lgkmcnt(0)" ::: "memory");
    const int c = lane & 7;
#pragma unroll
    for (int j = 0; j < 4; ++j) { const int n = (lane >> 3) + 8 * j; const LAS float* s = scr + (8 * c) * 33 + n;
        u32x2 o; o.x = pk4_fp8(s[0 * 33] * scale, s[1 * 33] * scale, s[2 * 33] * scale, s[3 * 33] * scale); o.y = pk4_fp8(s[4 * 33] * scale, s[5 * 33] * scale, s[6 * 33] * scale, s[7 * 33] * scale);
        const int drow = gate_i < 0 ? drow0 + n : gate_row(gate_i, n0 + n);
        *(u32x2*)(WT + (size_t)drow * ldk + k0 + 8 * c) = o; }
    asm volatile("s_waitcnt lgkmcnt(0)" ::: "memory");
}
__device__ __forceinline__ void xpose_dispatch(const Ctx& C, int it, LAS float* scr) {
    const float* const* in = oin(C.in_); const int lane = otid() & 63;
    if (it < 4 * 768) { const int l = it / 768, r = it % 768, part = r / 384, q = r % 384, kb = q / 24, nb = q % 24;
        const int n0 = (part ? 1056 : 0) + nb * 32, drow = (part ? 1280 : 0) + nb * 32;
        xpose_item(in[6] + (size_t)l * D * NIN, NIN, kb * 64, n0, wW(C, WE_WIN + (size_t)l * 6144 * 1024), 1024, drow, scr, lane); return; }
    it -= 4 * 768;
    if (it < 16 * 512) { const int li = it / 512, q = it % 512, kb = q / 32, nb = q % 32, l = li >> 2, i = li & 3;
        xpose_item_fp8(in[16] + (size_t)li * D * D, D, kb * 64, nb * 32, ows(C.ws_) + WS_G8 + (size_t)l * 4096 * 1024, 1024, scr, lane, i, G8_SCALE); return; }
    it -= 16 * 512;
    if (it < 16 * 128) { const int li = it / 128, q = it % 128, kb = q / 32, nb = q % 32;
        xpose_item(in[17] + (size_t)li * 256 * D, D, kb * 64, nb * 32, wW(C, WE_WBR + (size_t)li * 1024 * 256), 256, nb * 32, scr, lane); return; }
    it -= 16 * 128;
    if (it < 4 * 512) { const int l = it / 512, q = it % 512, kb = q / 32, nb = q % 32;
        xpose_item(in[18] + (size_t)l * D * D, D, kb * 64, nb * 32, wW(C, WE_WO + (size_t)l * D * D), 1024, nb * 32, scr, lane); return; }
    it -= 4 * 512;
    if (it < 4 * 1408) { const int jw = it / 1408, q = it % 1408, kb = q / 88, nb = q % 88, j = jw >> 1, which = jw & 1, n0 = nb * 32;
        xpose_item_fp8(in[which ? 22 : 21] + (size_t)j * D * DFF, DFF, kb * 64, n0, (unsigned char*)wW(C, WE_GUD + (size_t)j * 5632 * 1024), 1024, scr, lane, -1, G8_SCALE, (n0 >> 7) * 256 + which * 128 + (n0 & 127)); return; }
    it -= 4 * 1408;
    if (it < 2 * 1408) { const int j = it / 1408, q = it % 1408, kb = q / 32, nb = q % 32;
        if (DOWN8_DENSE) xpose_item_fp8(in[23] + (size_t)j * DFF * D, D, kb * 64, nb * 32, (unsigned char*)wW(C, WE_DD + (size_t)j * 1024 * 2816), 2816, scr, lane, -1, G8_SCALE, nb * 32);
        else xpose_item(in[23] + (size_t)j * DFF * D, D, kb * 64, nb * 32, wW(C, WE_DD + (size_t)j * 1024 * 2816), 2816, nb * 32, scr, lane); return; }
    it -= 2 * 1408;
    (void)it;
}
constexpr int XPE_GU = 16 * 1408, XPE_ALL = 24 * 1408;
constexpr bool DEFER_EXPERT_CONV = false;
__device__ __forceinline__ void xpose_expert(const Ctx& C, int jm, int idx, LAS float* scr, int lane) {
    const float* const* in = oin(C.in_);
    if (idx < XPE_GU) { const int ew = idx / 1408, q = idx % 1408, kb = q / 88, nb = q % 88, e = ew >> 1, which = ew & 1, n0 = nb * 32, je = jm * 8 + e;
        xpose_item_fp8(in[which ? 26 : 25] + (size_t)je * D * DFF, DFF, kb * 64, n0, (unsigned char*)wW(C, WE_GUE + (size_t)je * 5632 * 1024), 1024, scr, lane, -1, G8_SCALE, (n0 >> 7) * 256 + which * 128 + (n0 & 127)); }
    else { const int i2 = idx - XPE_GU, e = i2 / 1408, q = i2 % 1408, kb = q / 32, nb = q % 32, je = jm * 8 + e;
        if (DOWN8_MOE) xpose_item_fp8(in[27] + (size_t)je * DFF * D, D, kb * 64, nb * 32, (unsigned char*)wW(C, WE_DE + (size_t)je * 1024 * 2816), 2816, scr, lane, -1, G8_SCALE, nb * 32);
        else xpose_item(in[27] + (size_t)je * DFF * D, D, kb * 64, nb * 32, wW(C, WE_DE + (size_t)je * 1024 * 2816), 2816, nb * 32, scr, lane); }
}
__device__ __forceinline__ void expert_convert_share(const Ctx& C, int jm, int i0, int i1, int first_blk) {
    const int blk = oblk(); if (blk < first_blk) return;
    const int wave = owave(), lane = otid() & 63; LAS float* scr = (LAS float*)(C.lds + wave * 16384);
    const int nw = (ogrid() - first_blk) * NWAVE;
    for (int idx = i0 + (blk - first_blk) * NWAVE + wave; idx < i1; idx += nw) xpose_expert(C, jm, idx, scr, lane);
}
constexpr int XPOSE_ITEMS = 4 * 768 + 16 * 512 + 16 * 128 + 4 * 512 + 4 * 1408 + 2 * 1408;

__device__ __forceinline__ void p_prologue(const Ctx& C) {
    const float* const* in = oin(C.in_); const int tid = otid();
    { LAS float* scr = (LAS float*)(C.lds + owave() * 16384);
      const int gw = oblk() * NWAVE + owave(), NGW = ogrid() * NWAVE;
      for (int it = gw; it < XPOSE_ITEMS; it += NGW) xpose_dispatch(C, it, scr);
      if (!DEFER_EXPERT_CONV) for (int it = gw; it < 2 * XPE_ALL; it += NGW) xpose_expert(C, it / XPE_ALL, it % XPE_ALL, scr, otid() & 63); }
    { const size_t gt = (size_t)oblk() * NTHR + tid, NT = (size_t)ogrid() * NTHR;
      for (size_t o = gt; o < (size_t)4 * 512 * 1024; o += NT) {
          const int l = (int)(o >> 19), n = (int)((o >> 10) & 511), k = (int)(o & 1023);
          const float* wi = in[6] + ((size_t)l * D + k) * NIN; float s = 0.f;
          if (n < 256) { const int dir = n >> 7, nn = n & 127; const float* w2 = in[7] + ((size_t)(l * 2 + dir) * 16) * 128 + nn;
              for (int c = 0; c < 16; ++c) s += wi[768 + 16 * dir + c] * w2[c * 128]; }
          else { const int nn = n - 256, gi = nn >> 6, d = nn & 63; const float* pw = in[10] + ((size_t)(l * 4 + gi) * 64) * 64 + d;
              for (int c = 0; c < 64; ++c) s += wi[800 + 64 * gi + c] * pw[c * 64]; }
          wW(C, WE_WIN + (size_t)l * 6144 * 1024)[(size_t)(768 + n) * 1024 + k] = (bf16)f2bf(s);
      } }
    { const size_t gt = (size_t)oblk() * NTHR + tid, NT = (size_t)ogrid() * NTHR;
      { int* idt = (int*)(ows(C.ws_) + WS_ROUTE) + RT_IDT; for (size_t o = gt; o < (size_t)M; o += NT) idt[o] = (int)o; }
      { bf16* sw = wsb(C, WS_SGUW); const float* src = in[14]; for (size_t o = gt; o < (size_t)4 * 4 * 128 * 128; o += NT) sw[o] = (bf16)f2bf(src[o]); }
      { bf16* TF1 = wsb(C, WS_TF1); bf16* TF2 = wsb(C, WS_TF2); float* TW = (float*)(ows(C.ws_) + WS_TW); const float sc = 0.0027621358640099515f;
        for (size_t o = gt; o < (size_t)4 * 2 * 64 * 8; o += NT) { const int x = (int)(o & 7), lane = (int)((o >> 3) & 63), ks = (int)((o >> 9) & 1), ct = (int)(o >> 10), lr = lane & 15, lq = lane >> 4;
            const int po = ct >> 1, c = 16 * (ct & 1) + lr, a = 8 * lq + x; float sn, cs; sincospif((float)((c * a) & 31) * (1.0f / 16.0f), &sn, &cs);
            const float v = po == 0 ? (ks == 0 ? cs : sn) : (ks == 0 ? -sn : cs); TF1[o] = (bf16)f2bf(v); }
        for (size_t o = gt; o < (size_t)2 * 4 * 2 * 64 * 8; o += NT) { const int x = (int)(o & 7), lane = (int)((o >> 3) & 63), ks = (int)((o >> 9) & 1), dt = (int)((o >> 10) & 3), part = (int)(o >> 12), lr = lane & 15, lq = lane >> 4;
            const int d = 16 * dt + lr, bb = 32 * ks + (x < 4 ? 4 * lq + x : 16 + 4 * lq + (x - 4)); float sn, cs; sincospif((float)((d * bb) & 63) * (1.0f / 32.0f), &sn, &cs);
            TF2[o] = (bf16)f2bf((part == 0 ? cs : sn) * sc); }
        for (size_t o = gt; o < (size_t)4 * 2 * 4 * 64; o += NT) { const int lane = (int)(o & 63), r = (int)((o >> 6) & 3), ct = (int)((o >> 8) & 1), rt = (int)(o >> 9), lr = lane & 15, lq = lane >> 4;
            const int bb = 16 * rt + 4 * lq + r, c = 16 * ct + lr; float sn, cs; sincospif((float)(c * bb) * (1.0f / 1024.0f), &sn, &cs); TW[2 * o] = cs; TW[2 * o + 1] = sn; } }
      bf16* DLC = wsb(C, WS_DLC);
      for (size_t o = gt; o < (size_t)256 * 512; o += NT) { const int k = (int)(o >> 9), kk = (int)(o & 511), t = kk & 255; const int idx = (k * t) & 255; float sn, cs; sincospif((float)idx * (1.0f / 128.0f), &sn, &cs);
          DLC[o] = (bf16)f2bf((kk < 256 ? cs : sn) * 0.0078125f); }
      bf16* CS = wsb(C, WS_CS64);
      for (size_t o = gt; o < (size_t)128 * 64; o += NT) { const int pm = (int)(o >> 6), c = (int)(o & 63), m = pm & 63; const int idx = (m * c) & 63; float sn, cs; sincospif((float)idx * (1.0f / 32.0f), &sn, &cs);
          CS[o] = (bf16)f2bf(pm < 64 ? cs : -sn); } }
    __syncthreads();
    { LAS float* S = (LAS float*)C.lds;
      LAS float* RED = (LAS float*)(C.lds + 17 * 1024 * 4);
      for (int i = tid; i < 17 * 1024; i += NTHR) { const int r = i >> 10, k = i & 1023; const float v = r < 16 ? in[1][r * 1024 + k] : in[3][k]; S[i] = siluf_(v); }
      __syncthreads();
      for (int it = oblk(); it < 4 * 96; it += ogrid()) {
          const int l = it / 96, jb = it % 96, j = tid & 63, kg = tid >> 6;
          float acc[17];
#pragma unroll
          for (int r = 0; r < 17; ++r) acc[r] = 0.f;
          const float* wp = in[4] + ((size_t)l * D + kg * 128) * 6144 + jb * 64 + j;
          for (int kk = 0; kk < 128; ++kk) { const float w = wp[(size_t)kk * 6144];
#pragma unroll
              for (int r = 0; r < 17; ++r) acc[r] += S[r * 1024 + kg * 128 + kk] * w; }
#pragma unroll
          for (int r = 0; r < 17; ++r) RED[(kg * 17 + r) * 64 + j] = acc[r];
          __syncthreads();
          for (int o = tid; o < 17 * 64; o += NTHR) { const int r = o >> 6, jj = o & 63; float s = 0.f;
              for (int g = 0; g < 8; ++g) s += RED[(g * 17 + r) * 64 + jj];
              ((float*)(ows(C.ws_) + WS_MOD))[(size_t)(l * 17 + r) * 6144 + jb * 64 + jj] = s + in[5][(size_t)l * 6144 + jb * 64 + jj]; }
          __syncthreads();
      } }
}

struct RowV { f32x4 v[4]; };
__device__ __forceinline__ void row_ln(RowV& x, int  ) {
    float s = 0.f;
#pragma unroll
    for (int j = 0; j < 4; ++j) s += (x.v[j][0] + x.v[j][1]) + (x.v[j][2] + x.v[j][3]);
    const float mean = wave_sum(s) * (1.f / D); float q = 0.f;
#pragma unroll
    for (int j = 0; j < 4; ++j) { x.v[j] = x.v[j] - mean; q += (x.v[j][0] * x.v[j][0] + x.v[j][1] * x.v[j][1]) + (x.v[j][2] * x.v[j][2] + x.v[j][3] * x.v[j][3]); }
    const float rstd = __builtin_amdgcn_rsqf(wave_sum(q) * (1.f / D) + EPS);
#pragma unroll
    for (int j = 0; j < 4; ++j) x.v[j] = x.v[j] * rstd;
}
__device__ __forceinline__ void row_load_f32(RowV& x, const float* p, int lane) {
#pragma unroll
    for (int j = 0; j < 4; ++j) x.v[j] = *(const f32x4*)(p + 4 * lane + 256 * j);
}
__device__ __forceinline__ void row_load_bf16(RowV& x, const bf16* p, int lane) {
#pragma unroll
    for (int j = 0; j < 4; ++j) { const u32x2 w = *(const u32x2*)(p + 4 * lane + 256 * j); x.v[j] = (f32x4){bflo(w.x), bfhi(w.x), bflo(w.y), bfhi(w.y)}; }
}
__device__ __forceinline__ void row_store_f32(const RowV& x, float* p, int lane) {
#pragma unroll
    for (int j = 0; j < 4; ++j) *(f32x4*)(p + 4 * lane + 256 * j) = x.v[j];
}
__device__ __forceinline__ void row_store_fp8(const RowV& x, unsigned char* p, int lane) {
#pragma unroll
    for (int j = 0; j < 4; ++j) { int w = 0; w = __builtin_amdgcn_cvt_pk_fp8_f32(x.v[j][0], x.v[j][1], w, false); w = __builtin_amdgcn_cvt_pk_fp8_f32(x.v[j][2], x.v[j][3], w, true); *(int*)(p + 4 * lane + 256 * j) = w; }
}
__device__ __forceinline__ void row_store_bf16(const RowV& x, bf16* p, int lane) {
#pragma unroll
    for (int j = 0; j < 4; ++j) { u32x2 w; w.x = pk2(x.v[j][0], x.v[j][1]); w.y = pk2(x.v[j][2], x.v[j][3]); *(u32x2*)(p + 4 * lane + 256 * j) = w; }
}
__device__ __forceinline__ void row_mod(RowV& x, const float* shift, const float* scale, int lane) {
#pragma unroll
    for (int j = 0; j < 4; ++j) { const f32x4 sh = *(const f32x4*)(shift + 4 * lane + 256 * j), sc = *(const f32x4*)(scale + 4 * lane + 256 * j); x.v[j] = x.v[j] * (sc + 1.0f) + sh; }
}
__device__ __forceinline__ void row_affine(RowV& x, const float* g, const float* b, int lane) {
#pragma unroll
    for (int j = 0; j < 4; ++j) { const f32x4 gg = *(const f32x4*)(g + 4 * lane + 256 * j), bb = *(const f32x4*)(b + 4 * lane + 256 * j); x.v[j] = x.v[j] * gg + bb; }
}
__device__ __forceinline__ void row_mod_v(RowV& x, const RowV& shift, const RowV& scale) {
#pragma unroll
    for (int j = 0; j < 4; ++j) x.v[j] = x.v[j] * (scale.v[j] + 1.0f) + shift.v[j];
}
__device__ __forceinline__ void row_affine_v(RowV& x, const RowV& g, const RowV& b) {
#pragma unroll
    for (int j = 0; j < 4; ++j) x.v[j] = x.v[j] * g.v[j] + b.v[j];
}
__device__ __forceinline__ float* xrow(const Ctx& C, int m) { return m < MLAT ? oout(C.out_) + (size_t)m * D : (float*)(ows(C.ws_) + WS_XC) + (size_t)(m - MLAT) * D; }
__device__ __forceinline__ bf16* hbuf(const Ctx& C) { return XBF16 ? (bf16*)oout(C.out_) : wsb(C, WS_H); }
__device__ __forceinline__ unsigned char* h8buf(const Ctx& C) { return (unsigned char*)oout(C.out_) + OUT_H8; }
__device__ __forceinline__ const float* x0row(const Ctx& C, int m) { return m < MLAT ? oin(C.in_)[0] + (size_t)m * D : oin(C.in_)[2] + (size_t)(m - MLAT) * D; }

typedef _Float16 h16x2 __attribute__((ext_vector_type(2)));
struct XRaw { f32x4 f[4]; u32x2 h[4]; };
__device__ __forceinline__ void xraw_load(XRaw& R, const Ctx& C, int m, int lane, bool from_input) {
    if (from_input || !XBF16) { const float* p = from_input ? x0row(C, m) : xrow(C, m);
#pragma unroll
        for (int j = 0; j < 4; ++j) R.f[j] = *(const f32x4*)(p + 4 * lane + 256 * j); }
    else { const bf16* p = wsb(C, WS_H) + (size_t)m * D;
#pragma unroll
        for (int j = 0; j < 4; ++j) R.h[j] = *(const u32x2*)(p + 4 * lane + 256 * j); }
}
__device__ __forceinline__ void xraw_get(RowV& x, const XRaw& R, bool from_input) {
    if (from_input || !XBF16) {
#pragma unroll
        for (int j = 0; j < 4; ++j) x.v[j] = R.f[j]; }
    else {
#pragma unroll
        for (int j = 0; j < 4; ++j) { const unsigned wx = R.h[j].x, wy = R.h[j].y;
            const h16x2 a = __builtin_bit_cast(h16x2, wx), b = __builtin_bit_cast(h16x2, wy); x.v[j] = (f32x4){(float)a[0], (float)a[1], (float)b[0], (float)b[1]}; } }
}
__device__ __forceinline__ void yraw_load(u32x2 (&y)[4], const bf16* p, int lane) {
#pragma unroll
    for (int j = 0; j < 4; ++j) y[j] = *(const u32x2*)(p + 4 * lane + 256 * j);
}
__device__ __forceinline__ void yraw_get(RowV& y, const u32x2 (&w)[4]) {
#pragma unroll
    for (int j = 0; j < 4; ++j) y.v[j] = (f32x4){bflo(w[j].x), bfhi(w[j].x), bflo(w[j].y), bfhi(w[j].y)};
}
__device__ __forceinline__ void x_store(const RowV& x, const Ctx& C, int m, int lane) {
    if (XBF16) { bf16* p = wsb(C, WS_H) + (size_t)m * D;
#pragma unroll
        for (int j = 0; j < 4; ++j) { h16x2 a, b; a[0] = (_Float16)x.v[j][0]; a[1] = (_Float16)x.v[j][1]; b[0] = (_Float16)x.v[j][2]; b[1] = (_Float16)x.v[j][3];
            u32x2 w; w.x = __builtin_bit_cast(unsigned, a); w.y = __builtin_bit_cast(unsigned, b); *(u32x2*)(p + 4 * lane + 256 * j) = w; } }
    else row_store_f32(x, xrow(C, m), lane);
}
__device__ __forceinline__ void p_lna(const Ctx& C) {
    const int tid = otid(), lane = tid & 63, wave = owave();
    bf16* H = hbuf(C); const int rpb = M / 256; RowV shv, scv; int rcur = -1;
    const int nrow = rpb / NWAVE, jb = (nrow - 1) * 256 + ovr(C) * NWAVE + wave;
    RowV xn; row_load_f32(xn, x0row(C, lrow(C, jb)), lane);
    for (int k = 0; k < nrow; ++k) { const int m = lrow(C, jb - k * 256), r = row_r(m);
        if (r != rcur) { row_load_f32(shv, modv(C, 0, r, 0), lane); row_load_f32(scv, modv(C, 0, r, 1), lane); rcur = r; }
        RowV x = xn; if (k + 1 < nrow) row_load_f32(xn, x0row(C, lrow(C, jb - (k + 1) * 256)), lane);
        row_ln(x, lane); row_mod_v(x, shv, scv);
        row_store_bf16(x, H + (size_t)m * D, lane); row_store_fp8(x, h8buf(C) + (size_t)m * D, lane);
    }
}
__device__ __forceinline__ void p_lnb(const Ctx& C, int l, int mrows, bool dry = false) {
    const int tid = otid(), lane = tid & 63;
    bf16* H = dry ? wsb(C, WS_R + R_BIG + 152 * MiB) : hbuf(C); const bf16* Y = wsb(C, WS_R + R_YS);
    const bool moe = (l & 1); const int jm = l >> 1;
    const int rpb = mrows / 256;
    LAS float* WR = (LAS float*)C.lds;
    LAS int* LC = (LAS int*)(C.lds + 32768);
    int* rt = (int*)(ows(C.ws_) + WS_ROUTE);
    if (moe) {
        for (int i = tid; i < 8 * 1024; i += NTHR) { const int e = i >> 10, k = i & 1023; WR[i] = oin(C.in_)[24][((size_t)jm * D + k) * NE + e]; }
        if (tid < 8) LC[tid] = 0;
        __syncthreads();
    }
    RowV g2v, shv, scv, lgv, lbv; int rcur = -1;
    row_load_f32(lgv, oin(C.in_)[19] + (size_t)(l * 2 + 0) * D, lane); row_load_f32(lbv, oin(C.in_)[20] + (size_t)(l * 2 + 0) * D, lane);
    const int w0 = owave(), nrow = rpb / NWAVE, jb = ovr(C) * NWAVE + w0, mb = lrow(C, jb); const bool fin = (l == 0);
    XRaw xa; u32x2 ya[4];
    xraw_load(xa, C, mb, lane, fin); yraw_load(ya, Y + (size_t)mb * D, lane);
    XRaw xb = xa; u32x2 yb[4] = {ya[0], ya[1], ya[2], ya[3]};
    for (int k = 0; k < nrow; ++k) {
        const int m = lrow(C, jb + k * 256), mn = lrow(C, k + 1 < nrow ? jb + (k + 1) * 256 : jb), r = row_r(m);
        if (k + 1 < nrow) { xraw_load(xb, C, mn, lane, fin); yraw_load(yb, Y + (size_t)mn * D, lane); }
        if (r != rcur) { row_load_f32(g2v, modv(C, l, r, 2), lane); row_load_f32(shv, modv(C, l, r, 3), lane); row_load_f32(scv, modv(C, l, r, 4), lane); rcur = r; }
        RowV x, y; xraw_get(x, xa, fin); yraw_get(y, ya);
#pragma unroll
        for (int j = 0; j < 4; ++j) x.v[j] = x.v[j] * ALPHA + g2v.v[j] * y.v[j];
        row_ln(x, lane); row_affine_v(x, lgv, lbv);
        if (dry) row_store_f32(x, (float*)(ows(C.ws_) + WS_R + R_BIG) + (size_t)m * D, lane); else x_store(x, C, m, lane);
        row_ln(x, lane); row_mod_v(x, shv, scv);
        row_store_fp8(x, (dry ? (unsigned char*)H : h8buf(C)) + (size_t)m * D, lane);
        if (moe) {
            float lg[8];
#pragma unroll
            for (int e = 0; e < 8; ++e) { float s = 0.f;
#pragma unroll
                for (int j = 0; j < 4; ++j) { const f32x4 w = *(const LAS f32x4*)(WR + e * 1024 + 4 * lane + 256 * j); s += (x.v[j][0] * w[0] + x.v[j][1] * w[1]) + (x.v[j][2] * w[2] + x.v[j][3] * w[3]); }
                lg[e] = wave_sum(s); }
            if (lane == 0 && !dry) {
                int e1 = 0; float v1 = lg[0];
#pragma unroll
                for (int e = 1; e < 8; ++e) if (lg[e] > v1) { v1 = lg[e]; e1 = e; }
                int e2 = -1; float v2 = -3.0e38f;
#pragma unroll
                for (int e = 0; e < 8; ++e) if (e != e1 && lg[e] > v2) { v2 = lg[e]; e2 = e; }
                const float w1 = 1.0f / (1.0f + __expf(v2 - v1)), w2 = 1.0f - w1;
                const int r1 = __hip_atomic_fetch_add(&LC[e1], 1, __ATOMIC_RELAXED, __HIP_MEMORY_SCOPE_WORKGROUP), r2 = __hip_atomic_fetch_add(&LC[e2], 1, __ATOMIC_RELAXED, __HIP_MEMORY_SCOPE_WORKGROUP);
                rt[RT_TOKE + (size_t)m * 2] = e1; rt[RT_TOKE + (size_t)m * 2 + 1] = e2;
                rt[RT_TOKR + (size_t)m * 2] = r1; rt[RT_TOKR + (size_t)m * 2 + 1] = r2;
                ((float*)rt)[RT_TOKW + (size_t)m * 2] = w1; ((float*)rt)[RT_TOKW + (size_t)m * 2 + 1] = w2;
            }
        }
        asm volatile("" ::: "memory");
        xa = xb;
#pragma unroll
        for (int j = 0; j < 4; ++j) ya[j] = yb[j];
    }
    if (moe && !dry) {
        __syncthreads();
        if (tid < 8) { unsigned* cnt = (unsigned*)(ows(C.ws_) + WS_CTL) + CW_CNT + (jm * 8 + tid) * 64;
            const unsigned base = __hip_atomic_fetch_add(cnt, (unsigned)LC[tid], __ATOMIC_RELAXED, __HIP_MEMORY_SCOPE_AGENT);
            rt[RT_BLK + (ovx(C) * 32 + ovr(C)) * 8 + tid] = (int)base; }
    }
}
struct RouteInfo { int base[9]; int cnt[8]; int npanels; };
__device__ __forceinline__ void route_info(const Ctx& C, int jm, RouteInfo& R) {
    unsigned* cnt = (unsigned*)(ows(C.ws_) + WS_CTL) + CW_CNT; int b = 0;
#pragma unroll
    for (int e = 0; e < 8; ++e) { const int c = (int)__hip_atomic_load(cnt + (jm * 8 + e) * 64, __ATOMIC_RELAXED, __HIP_MEMORY_SCOPE_AGENT); R.cnt[e] = c; R.base[e] = b; b += ((c + 255) >> 8) << 8; }
    R.base[8] = b; R.npanels = b >> 8;
}
__device__ __forceinline__ void p_route_build(const Ctx& C, int l, int mrows) {
    const int tid = otid();
    const int jm = l >> 1; RouteInfo R; route_info(C, jm, R);
    int* rt = (int*)(ows(C.ws_) + WS_ROUTE); const int rpb = mrows / 256;
    const int gt = oblk() * NTHR + tid, NT = ogrid() * NTHR;
    for (int i = gt; i < mrows * 2; i += NT) { const int m = i >> 1, e = rt[RT_TOKE + i], blk = (m < MLAT ? (m >> 12) : ((m - MLAT) >> 9)) * 32 + ((m & 255) >> 3);
        int be = 0;
#pragma unroll
        for (int q = 0; q < 8; ++q) be = (q == e) ? R.base[q] : be;
        const int slot = be + rt[RT_BLK + blk * 8 + e] + rt[RT_TOKR + i];
        rt[RT_TOKS + i] = slot; rt[RT_S2T + slot] = m; }
    for (int s = gt; s < R.base[8]; s += NT) { int e = 0;
#pragma unroll
        for (int q = 1; q < 8; ++q) e = (s >= R.base[q]) ? q : e;
        int be = 0, ce = 0;
#pragma unroll
        for (int q = 0; q < 8; ++q) { be = (q == e) ? R.base[q] : be; ce = (q == e) ? R.cnt[q] : ce; }
        if (s >= be + ce) rt[RT_S2T + s] = 0;
        if ((s & 255) == 0) rt[RT_PE + (s >> 8)] = e; }
}
__device__ __forceinline__ void p_lnc(const Ctx& C, int l, int mrows, bool dry = false) {
    const int tid = otid(), lane = tid & 63, wave = owave();
    bf16* H = dry ? wsb(C, WS_R + 350 * MiB) : hbuf(C); const bf16* Y2 = wsb(C, WS_R + R_Y2);
    const bool moe = (l & 1); const int* rt = (const int*)(ows(C.ws_) + WS_ROUTE); const int rpb = mrows / 256;
    RowV g5v, shv, scv, lgv, lbv; int rcur = -1;
    row_load_f32(lgv, oin(C.in_)[19] + (size_t)(l * 2 + 1) * D, lane); row_load_f32(lbv, oin(C.in_)[20] + (size_t)(l * 2 + 1) * D, lane);
    const int nrow = rpb / NWAVE, jb = (nrow - 1) * 256 + ovr(C) * NWAVE + wave, mb = lrow(C, jb);
    int sa1 = 0, sa2 = 0, sb1 = 0, sb2 = 0, sc1 = 0, sc2 = 0; float wa1 = 0.f, wa2 = 0.f, wb1 = 0.f, wb2 = 0.f, wc1 = 0.f, wc2 = 0.f;
    if (moe) { sa1 = rt[RT_TOKS + (size_t)mb * 2]; sa2 = rt[RT_TOKS + (size_t)mb * 2 + 1]; wa1 = ((const float*)rt)[RT_TOKW + (size_t)mb * 2]; wa2 = ((const float*)rt)[RT_TOKW + (size_t)mb * 2 + 1];
        if (nrow > 1) { const size_t q = (size_t)lrow(C, jb - 256) * 2; sb1 = rt[RT_TOKS + q]; sb2 = rt[RT_TOKS + q + 1]; wb1 = ((const float*)rt)[RT_TOKW + q]; wb2 = ((const float*)rt)[RT_TOKW + q + 1]; } }
    XRaw xa; u32x2 ya[4], za[4];
    xraw_load(xa, C, mb, lane, false); yraw_load(ya, Y2 + (size_t)(moe ? sa1 : mb) * D, lane); if (moe) yraw_load(za, Y2 + (size_t)sa2 * D, lane); else { za[0] = ya[0]; za[1] = ya[1]; za[2] = ya[2]; za[3] = ya[3]; }
    XRaw xb = xa; u32x2 yb[4] = {ya[0], ya[1], ya[2], ya[3]}, zb[4] = {za[0], za[1], za[2], za[3]};
    for (int k = 0; k < nrow; ++k) {
        const int m = lrow(C, jb - k * 256), mn = lrow(C, k + 1 < nrow ? jb - (k + 1) * 256 : jb), r = row_r(m);
        if (moe && k + 2 < nrow) { const size_t q = (size_t)lrow(C, jb - (k + 2) * 256) * 2; sc1 = rt[RT_TOKS + q]; sc2 = rt[RT_TOKS + q + 1]; wc1 = ((const float*)rt)[RT_TOKW + q]; wc2 = ((const float*)rt)[RT_TOKW + q + 1]; }
        if (k + 1 < nrow) { xraw_load(xb, C, mn, lane, false); yraw_load(yb, Y2 + (size_t)(moe ? sb1 : mn) * D, lane); if (moe) yraw_load(zb, Y2 + (size_t)sb2 * D, lane); }
        if (r != rcur) { row_load_f32(g5v, modv(C, l, r, 5), lane); if (l < DEPTH - 1) { row_load_f32(shv, modv(C, l + 1, r, 0), lane); row_load_f32(scv, modv(C, l + 1, r, 1), lane); } rcur = r; }
        RowV x, y; xraw_get(x, xa, false); yraw_get(y, ya);
        if (moe) { RowV y2; yraw_get(y2, za);
#pragma unroll
            for (int j = 0; j < 4; ++j) y.v[j] = y.v[j] * wa1 + y2.v[j] * wa2; }
#pragma unroll
        for (int j = 0; j < 4; ++j) x.v[j] = x.v[j] * ALPHA + g5v.v[j] * y.v[j];
        row_ln(x, lane); row_affine_v(x, lgv, lbv);
        if (dry) row_store_f32(x, (float*)(ows(C.ws_) + WS_R) + (size_t)m * D, lane); else if (l == DEPTH - 1) row_store_f32(x, oout(C.out_) + (size_t)m * D, lane); else x_store(x, C, m, lane);
        if (l < DEPTH - 1) { row_ln(x, lane); row_mod_v(x, shv, scv); row_store_bf16(x, H + (size_t)m * D, lane); row_store_fp8(x, h8buf(C) + (size_t)m * D, lane); }
        asm volatile("" ::: "memory");
        xa = xb; sa1 = sb1; sa2 = sb2; wa1 = wb1; wa2 = wb2; sb1 = sc1; sb2 = sc2; wb1 = wc1; wb2 = wc2;
#pragma unroll
        for (int j = 0; j < 4; ++j) { ya[j] = yb[j]; za[j] = zb[j]; }
    }
}

__device__ __forceinline__ f32x4 mm4(float a, float b, f32x4 c) { return __builtin_amdgcn_mfma_f32_16x16x4f32(a, b, c, 0, 0, 0); }
__device__ __forceinline__ int gla_row0(int b, int sc) { return sc < 4 ? MLAT + b * TC + sc * 64 : b * T + (sc - 4) * 64; }
constexpr int GL_VT = 0, GL_LA = 9216, GL_SEG = 26112, GL_QT = 28160, GL_KT = 36608, GL_KWT = 45056, GL_DC = 54272, GL_QE = 54528, GL_KE = 64768, GL_SPT = 75008, GL_AT = 85248, GL_RS = 103680;
__device__ __forceinline__ void gla_load_common(const bf16* cols, int m0, int h, LAS unsigned char* lds, int tid, bool with_q) {
    const int row = tid >> 3, seg = tid & 7; const bf16* rp = cols + (size_t)(m0 + row) * NINP;
    { const u32x4 w = *(const u32x4*)(rp + C_V + h * 64 + seg * 8); LAS bf16* vt = (LAS bf16*)(lds + GL_VT) + (seg * 8) * 72 + ((((row >> 3) ^ seg) & 7) << 3) + (row & 7);
      vt[0 * 72] = (bf16)(w.x & 0xffff); vt[1 * 72] = (bf16)(w.x >> 16); vt[2 * 72] = (bf16)(w.y & 0xffff); vt[3 * 72] = (bf16)(w.y >> 16);
      vt[4 * 72] = (bf16)(w.z & 0xffff); vt[5 * 72] = (bf16)(w.z >> 16); vt[6 * 72] = (bf16)(w.w & 0xffff); vt[7 * 72] = (bf16)(w.w >> 16); }
    const int s4 = seg & 3, dir = seg >> 2;
    { const u32x4 a = *(const u32x4*)(rp + (dir ? C_LAB : C_LAF) + h * 32 + s4 * 8); LAS float* d = (LAS float*)(lds + GL_LA) + (dir * 64 + row) * 33 + s4 * 8;
      d[0] = bflo(a.x); d[1] = bfhi(a.x); d[2] = bflo(a.y); d[3] = bfhi(a.y); d[4] = bflo(a.z); d[5] = bfhi(a.z); d[6] = bflo(a.w); d[7] = bfhi(a.w); }
    if (dir == 0 || with_q) { const u32x4 a = *(const u32x4*)(rp + (dir ? C_Q : C_K) + h * 32 + s4 * 8); LAS float* d = (LAS float*)(lds + (dir ? GL_QT : GL_KT)) + row * 33 + s4 * 8;
      d[0] = bflo(a.x); d[1] = bfhi(a.x); d[2] = bflo(a.y); d[3] = bfhi(a.y); d[4] = bflo(a.z); d[5] = bfhi(a.z); d[6] = bflo(a.w); d[7] = bfhi(a.w); }
}
__device__ __forceinline__ void gla1_item(const Ctx& C, int g) {
    const int b = g / 144, rem = g % 144, sc = rem >> 2, h = rem & 3, m0 = gla_row0(b, sc);
    const bf16* cols = wsb(C, WS_R + R_COLS); LAS unsigned char* lds = C.lds;
    const int tid = otid(), lane = tid & 63, w = owave(), lr = lane & 15, lq = lane >> 4;
    gla_load_common(cols, m0, h, lds, tid, false);
    __syncthreads();
    const int dir = tid >> 8, d = (tid >> 3) & 31, sg = tid & 7;
    LAS float* LA = (LAS float*)(lds + GL_LA) + dir * 64 * 33; LAS float* SEG = (LAS float*)(lds + GL_SEG) + (dir * 32 + d) * 8;
    float v[8], pre[8]; float run = 0.f;
#pragma unroll
    for (int x = 0; x < 8; ++x) { v[x] = LA[(sg * 8 + x) * 33 + d]; run += v[x]; pre[x] = run; }
    SEG[sg] = run;
    __syncthreads();
    { float off = 0.f, tot = 0.f;
#pragma unroll
      for (int s2 = 0; s2 < 8; ++s2) { const float t2 = SEG[s2]; tot += t2; off += (s2 < sg) ? t2 : 0.f; }
      const LAS float* KT = (const LAS float*)(lds + GL_KT);
      float kw[8];
#pragma unroll
      for (int x = 0; x < 8; ++x) { const float wt = dir == 0 ? __expf(tot - (off + pre[x])) : __expf(off + pre[x] - v[x]); kw[x] = KT[(sg * 8 + x) * 33 + d] * wt; }
      u32x4 o; o.x = pk2(kw[0], kw[1]); o.y = pk2(kw[2], kw[3]); o.z = pk2(kw[4], kw[5]); o.w = pk2(kw[6], kw[7]);
      *(LAS u32x4*)(lds + GL_KWT + ((dir * 32 + d) * 72 + sg * 8) * 2) = o;
      if (sg == 0) ((LAS float*)(lds + GL_DC))[dir * 32 + d] = __expf(tot); }
    __syncthreads();
    { const int wd = w >> 2, et = w & 3;
      f32x4 a0 = (f32x4){0.f, 0.f, 0.f, 0.f}, a1 = a0;
#pragma unroll
      for (int ks = 0; ks < 2; ++ks) { const bf16x8 av = *(const LAS bf16x8*)(lds + GL_VT + ((et * 16 + lr) * 72 + (((ks * 4 + lq) ^ (2 * et + (lr >> 3))) & 7) * 8) * 2);
          const bf16x8 b0 = *(const LAS bf16x8*)(lds + GL_KWT + ((wd * 32 + lr) * 72 + ks * 32 + lq * 8) * 2), b1 = *(const LAS bf16x8*)(lds + GL_KWT + ((wd * 32 + 16 + lr) * 72 + ks * 32 + lq * 8) * 2);
          a0 = __builtin_amdgcn_mfma_f32_16x16x32_bf16(av, b0, a0, 0, 0, 0); a1 = __builtin_amdgcn_mfma_f32_16x16x32_bf16(av, b1, a1, 0, 0, 0); }
      const int cp = wd ? (sc < 4 ? 3 - sc : 39 - sc) : sc, ch = (b * 4 + h) * 2 + wd;
      float* DH = (float*)(ows(C.ws_) + WS_R + R_DH) + ((size_t)ch * 36 + cp) * 2048;
#pragma unroll
      for (int r = 0; r < 4; ++r) { const int e = et * 16 + 4 * lq + r; DH[e * 32 + lr] = a0[r]; DH[e * 32 + 16 + lr] = a1[r]; }
      if (tid < 64) { const int dd = tid >> 5, d2 = tid & 31; const int cp2 = dd ? (sc < 4 ? 3 - sc : 39 - sc) : sc;
          ((float*)(ows(C.ws_) + WS_R + R_DEC))[((size_t)((b * 4 + h) * 2 + dd) * 36 + cp2) * 32 + d2] = ((const LAS float*)(lds + GL_DC))[dd * 32 + d2]; } }
    __syncthreads();
}
__device__ __forceinline__ void gla2_all(const Ctx& C) {
    const int tid = otid();
    float* DH = (float*)(ows(C.ws_) + WS_R + R_DH); const float* DEC = (const float*)(ows(C.ws_) + WS_R + R_DEC);
    for (int il = ovr(C) * NTHR + tid; il < 16 * 2048; il += 32 * NTHR) { const int i = ovx(C) * 16 * 2048 + il, ch = i >> 11, el = i & 2047, d = el & 31;
        float* p = DH + (size_t)ch * 36 * 2048 + el; const float* dc = DEC + (size_t)ch * 36 * 32 + d;
        float dh[36], de[36];
#pragma unroll
        for (int cp = 0; cp < 36; ++cp) { dh[cp] = p[(size_t)cp * 2048]; de[cp] = dc[cp * 32]; }
        float S = 0.f;
#pragma unroll
        for (int cp = 0; cp < 36; ++cp) { p[(size_t)cp * 2048] = S; S = de[cp] * S + dh[cp]; } }
}
__device__ __forceinline__ void gla3_item(const Ctx& C, int l, int g) {
    const int b = g / 144, rem = g % 144, sc = rem >> 2, h = rem & 3, m0 = gla_row0(b, sc);
    const bf16* cols = wsb(C, WS_R + R_COLS); bf16* YS = wsb(C, WS_R + R_YS); LAS unsigned char* lds = C.lds;
    const int tid = otid(), lane = tid & 63, w = owave(), lr = lane & 15, lq = lane >> 4;
    gla_load_common(cols, m0, h, lds, tid, true);
    { const int dir = tid >> 8, e = (tid >> 2) & 63, dq = tid & 3; const int cp = dir ? (sc < 4 ? 3 - sc : 39 - sc) : sc, ch = (b * 4 + h) * 2 + dir;
      const float* sp = (const float*)(ows(C.ws_) + WS_R + R_DH) + ((size_t)ch * 36 + cp) * 2048 + e * 32 + dq * 8;
      const f32x4 s0 = *(const f32x4*)sp, s1 = *(const f32x4*)(sp + 4);
      u32x4 o; o.x = pk2(s0[0], s0[1]); o.y = pk2(s0[2], s0[3]); o.z = pk2(s1[0], s1[1]); o.w = pk2(s1[2], s1[3]);
      *(LAS u32x4*)(lds + GL_SPT + ((dir * 64 + e) * 40 + dq * 8) * 2) = o; }
    __syncthreads();
    { const int dir = tid >> 8, d = (tid >> 3) & 31, sg = tid & 7;
      LAS float* LA = (LAS float*)(lds + GL_LA) + dir * 64 * 33; LAS float* SEG = (LAS float*)(lds + GL_SEG) + (dir * 32 + d) * 8;
      float v[8], pre[8]; float run = 0.f;
#pragma unroll
      for (int x = 0; x < 8; ++x) { v[x] = LA[(sg * 8 + x) * 33 + d]; run += v[x]; pre[x] = run; }
      SEG[sg] = run;
      __syncthreads();
      float off = 0.f, tot = 0.f;
#pragma unroll
      for (int s2 = 0; s2 < 8; ++s2) { const float t2 = SEG[s2]; tot += t2; off += (s2 < sg) ? t2 : 0.f; }
      const LAS float* QT = (const LAS float*)(lds + GL_QT); const LAS float* KT = (const LAS float*)(lds + GL_KT);
      const int dsw = ((((d >> 3) ^ sg) & 3) << 3) + (d & 7);
      LAS bf16* QE = (LAS bf16*)(lds + GL_QE) + dir * 64 * 40 + dsw; LAS bf16* KE = (LAS bf16*)(lds + GL_KE) + dir * 64 * 40 + dsw;
#pragma unroll
      for (int x = 0; x < 8; ++x) { const int i = sg * 8 + x;
          const float bb = dir == 0 ? (off + pre[x]) : (tot - (off + pre[x] - v[x]));
          QE[i * 40] = (bf16)f2bf(QT[i * 33 + d] * __expf(bb)); KE[i * 40] = (bf16)f2bf(KT[i * 33 + d] * __expf(-bb)); } }
    __syncthreads();
    { const int dir = w >> 2, jt = w & 3;
      const bf16x8 bq = *(const LAS bf16x8*)(lds + GL_QE + ((dir * 64 + jt * 16 + lr) * 40 + ((lq ^ (2 * jt + (lr >> 3))) & 3) * 8) * 2);
#pragma unroll
      for (int it = 0; it < 4; ++it) { const bf16x8 ak = *(const LAS bf16x8*)(lds + GL_KE + ((dir * 64 + it * 16 + lr) * 40 + ((lq ^ (2 * it + (lr >> 3))) & 3) * 8) * 2);
          const f32x4 a = __builtin_amdgcn_mfma_f32_16x16x32_bf16(ak, bq, (f32x4){0.f, 0.f, 0.f, 0.f}, 0, 0, 0);
          const int j = jt * 16 + lr, i0 = it * 16 + 4 * lq; float m4[4];
#pragma unroll
          for (int r = 0; r < 4; ++r) { const int i = i0 + r; const bool keep = dir ? (i > j) : (i <= j); m4[r] = keep ? a[r] : 0.f; }
          u32x2 o; o.x = pk2(m4[0], m4[1]); o.y = pk2(m4[2], m4[3]);
          *(LAS u32x2*)(lds + GL_AT + ((dir * 64 + j) * 72 + i0) * 2) = o; } }
    __syncthreads();
    const int jt = w >> 1, et0 = 2 * (w & 1);
    f32x4 o0 = (f32x4){0.f, 0.f, 0.f, 0.f}, o1 = o0;
#pragma unroll
    for (int dir = 0; dir < 2; ++dir) {
#pragma unroll
        for (int ks = 0; ks < 2; ++ks) { const bf16x8 ba = *(const LAS bf16x8*)(lds + GL_AT + ((dir * 64 + jt * 16 + lr) * 72 + ks * 32 + lq * 8) * 2);
            o0 = __builtin_amdgcn_mfma_f32_16x16x32_bf16(*(const LAS bf16x8*)(lds + GL_VT + ((et0 * 16 + lr) * 72 + (((ks * 4 + lq) ^ (2 * et0 + (lr >> 3))) & 7) * 8) * 2), ba, o0, 0, 0, 0);
            o1 = __builtin_amdgcn_mfma_f32_16x16x32_bf16(*(const LAS bf16x8*)(lds + GL_VT + (((et0 + 1) * 16 + lr) * 72 + (((ks * 4 + lq) ^ (2 * (et0 + 1) + (lr >> 3))) & 7) * 8) * 2), ba, o1, 0, 0, 0); }
        const bf16x8 bq = *(const LAS bf16x8*)(lds + GL_QE + ((dir * 64 + jt * 16 + lr) * 40 + ((lq ^ (2 * jt + (lr >> 3))) & 3) * 8) * 2);
        o0 = __builtin_amdgcn_mfma_f32_16x16x32_bf16(*(const LAS bf16x8*)(lds + GL_SPT + ((dir * 64 + et0 * 16 + lr) * 40 + lq * 8) * 2), bq, o0, 0, 0, 0);
        o1 = __builtin_amdgcn_mfma_f32_16x16x32_bf16(*(const LAS bf16x8*)(lds + GL_SPT + ((dir * 64 + (et0 + 1) * 16 + lr) * 40 + lq * 8) * 2), bq, o1, 0, 0, 0);
    }
    { float ss = (o0[0] * o0[0] + o0[1] * o0[1]) + (o0[2] * o0[2] + o0[3] * o0[3]) + (o1[0] * o1[0] + o1[1] * o1[1]) + (o1[2] * o1[2] + o1[3] * o1[3]);
      ss += __shfl_xor(ss, 16); ss += __shfl_xor(ss, 32);
      if (lq == 0) ((LAS float*)(lds + GL_RS))[(jt * 16 + lr) * 2 + (w & 1)] = ss; }
    __syncthreads();
    { const int j = jt * 16 + lr; const LAS float* RS = (const LAS float*)(lds + GL_RS);
      const float rs = 1.0f / sqrtf((RS[j * 2] + RS[j * 2 + 1]) * (1.0f / 64.0f) + EPS);
      const size_t rowo = (size_t)(m0 + j);
#pragma unroll
      for (int q = 0; q < 2; ++q) { const int e = (et0 + q) * 16 + 4 * lq; const f32x4 o = q ? o1 : o0;
          const u32x2 rw = *(const u32x2*)(cols + rowo * NINP + C_R + h * 64 + e); const f32x4 gg = *(const f32x4*)(oin(C.in_)[9] + (size_t)l * 256 + h * 64 + e);
          u32x2 ow; ow.x = pk2(o[0] * rs * gg[0] * bflo(rw.x), o[1] * rs * gg[1] * bfhi(rw.x)); ow.y = pk2(o[2] * rs * gg[2] * bflo(rw.y), o[3] * rs * gg[3] * bfhi(rw.y));
          *(u32x2*)(YS + rowo * D + h * 64 + e) = ow; } }
    __syncthreads();
}

template <int GI> __device__ __forceinline__ void pool_lat_item_t(const Ctx& C, int l, int b, int slab) {
    constexpr int HW = 1 << GI; constexpr int RS = 64 * 16 + 16;
    const int ch0 = slab * 16;
    const bf16* cols = wsb(C, WS_R + R_COLS); bf16* YS = wsb(C, WS_R + R_YS);
    LAS float* G = (LAS float*)C.lds;
    const int tid = otid(), hf = tid & 1;
    u32x4 xin[8];
#pragma unroll
    for (int k = 0; k < 8; ++k) { const int t = (tid + k * NTHR) >> 1; xin[k] = *(const u32x4*)(cols + (size_t)(b * T + t) * NINP + C_POOL + ch0 + hf * 8); }
#pragma unroll
    for (int k = 0; k < 8; ++k) { const int t = (tid + k * NTHR) >> 1; LAS float* d = G + (t >> 6) * RS + (t & 63) * 16 + hf * 8; const u32x4 w = xin[k];
        *(LAS f32x4*)d = (f32x4){bflo(w.x), bfhi(w.x), bflo(w.y), bfhi(w.y)}; *(LAS f32x4*)(d + 4) = (f32x4){bflo(w.z), bfhi(w.z), bflo(w.w), bfhi(w.w)}; }
    __syncthreads();
#pragma unroll 1
    for (int q = 0; q < 2; ++q) { const int cix = tid + q * NTHR; float p[33]; p[0] = 0.f;
#pragma unroll
        for (int gr = 0; gr < 32; ++gr) p[gr + 1] = p[gr] + G[gr * RS + cix];
#pragma unroll
        for (int gr = 0; gr < 32; ++gr) { const int lo = gr - HW < 0 ? 0 : gr - HW, hi = gr + HW > 32 ? 32 : gr + HW;
            G[gr * RS + cix] = (p[hi] - p[lo]) * (1.0f / (float)(hi - lo)); } }
    __syncthreads();
    { const int gr = tid >> 4, ch = tid & 15; LAS float* Gr = G + gr * RS + ch; float p[65]; p[0] = 0.f;
#pragma unroll
      for (int gc = 0; gc < 64; ++gc) p[gc + 1] = p[gc] + Gr[gc * 16];
#pragma unroll
      for (int gc = 0; gc < 64; ++gc) { const int lo = gc - HW < 0 ? 0 : gc - HW, hi = gc + HW > 64 ? 64 : gc + HW;
          Gr[gc * 16] = (p[hi] - p[lo]) * (1.0f / (float)(hi - lo)); } }
    __syncthreads();
    { const float* ps = oin(C.in_)[11] + (size_t)l * 256 + ch0 + hf * 8; const f32x4 s0 = *(const f32x4*)ps, s1 = *(const f32x4*)(ps + 4);
#pragma unroll
      for (int k = 0; k < 8; ++k) { const int t = (tid + k * NTHR) >> 1; const LAS float* d = G + (t >> 6) * RS + (t & 63) * 16 + hf * 8; const f32x4 m0 = *(const LAS f32x4*)d, m1 = *(const LAS f32x4*)(d + 4); const u32x4 w = xin[k];
          u32x4 o; o.x = pk2((m0[0] - bflo(w.x)) * s0[0], (m0[1] - bfhi(w.x)) * s0[1]); o.y = pk2((m0[2] - bflo(w.y)) * s0[2], (m0[3] - bfhi(w.y)) * s0[3]);
          o.z = pk2((m1[0] - bflo(w.z)) * s1[0], (m1[1] - bfhi(w.z)) * s1[1]); o.w = pk2((m1[2] - bflo(w.w)) * s1[2], (m1[3] - bfhi(w.w)) * s1[3]);
          *(u32x4*)(YS + (size_t)(b * T + t) * D + 256 + ch0 + hf * 8) = o; } }
    __syncthreads();
}
__device__ __forceinline__ void pool_lat_item(const Ctx& C, int l, int p) {
    const int b = p >> 4, slab = p & 15, gi = slab >> 2;
    if (gi == 0) pool_lat_item_t<0>(C, l, b, slab); else if (gi == 1) pool_lat_item_t<1>(C, l, b, slab); else if (gi == 2) pool_lat_item_t<2>(C, l, b, slab); else pool_lat_item_t<3>(C, l, b, slab);
}
__device__ __forceinline__ void pool_ctx_item(const Ctx& C, int l, int p) {
    const int b = p >> 2, gi = p & 3, hw = 1 << gi;
    const bf16* cols = wsb(C, WS_R + R_COLS); bf16* YS = wsb(C, WS_R + R_YS);
    LAS float* G = (LAS float*)C.lds;
    const int tid = otid(), sg = tid & 7;
    u32x4 xin[4];
#pragma unroll
    for (int k = 0; k < 4; ++k) { const int t = (tid + k * NTHR) >> 3; xin[k] = *(const u32x4*)(cols + (size_t)(MLAT + b * TC + t) * NINP + C_POOL + gi * 64 + sg * 8); }
#pragma unroll
    for (int k = 0; k < 4; ++k) { const int t = (tid + k * NTHR) >> 3; LAS float* d = G + t * 64 + sg * 8; const u32x4 w = xin[k];
        *(LAS f32x4*)d = (f32x4){bflo(w.x), bfhi(w.x), bflo(w.y), bfhi(w.y)}; *(LAS f32x4*)(d + 4) = (f32x4){bflo(w.z), bfhi(w.z), bflo(w.w), bfhi(w.w)}; }
    __syncthreads();
    { const float* ps = oin(C.in_)[11] + (size_t)l * 256 + gi * 64 + sg * 8; const f32x4 s0 = *(const f32x4*)ps, s1 = *(const f32x4*)(ps + 4);
#pragma unroll
      for (int k = 0; k < 4; ++k) { const int t = (tid + k * NTHR) >> 3, lo = t - hw < 0 ? 0 : t - hw, hi = t + hw > 256 ? 256 : t + hw;
          f32x4 a0 = (f32x4){0.f, 0.f, 0.f, 0.f}, a1 = a0;
          for (int t2 = lo; t2 < hi; ++t2) { const LAS float* d = G + t2 * 64 + sg * 8; a0 += *(const LAS f32x4*)d; a1 += *(const LAS f32x4*)(d + 4); }
          const float inv = 1.0f / (float)(hi - lo); const u32x4 w = xin[k];
          u32x4 o; o.x = pk2((a0[0] * inv - bflo(w.x)) * s0[0], (a0[1] * inv - bfhi(w.x)) * s0[1]); o.y = pk2((a0[2] * inv - bflo(w.y)) * s0[2], (a0[3] * inv - bfhi(w.y)) * s0[3]);
          o.z = pk2((a1[0] * inv - bflo(w.z)) * s1[0], (a1[1] * inv - bfhi(w.z)) * s1[1]); o.w = pk2((a1[2] * inv - bflo(w.w)) * s1[2], (a1[3] * inv - bfhi(w.w)) * s1[3]);
          *(u32x4*)(YS + (size_t)(MLAT + b * TC + t) * D + 256 + gi * 64 + sg * 8) = o; } }
    __syncthreads();
}
__device__ __forceinline__ void sgu_item(const Ctx& C, int l, int s, bool loadw) {
    int m0, g;
    if (s < 1024) { const int b = s >> 6, n = (s >> 2) & 15; g = s & 3; m0 = b * T + n * 128; }
    else { const int s2 = s - 1024, b = s2 >> 3, n = (s2 >> 2) & 1; g = s2 & 3; m0 = MLAT + b * TC + n * 128; }
    const bf16* cols = wsb(C, WS_R + R_COLS); bf16* YS = wsb(C, WS_R + R_YS); LAS unsigned char* lds = C.lds;
    constexpr int SG_W = 0, SG_V = 34816;
    const int tid = otid(), lane = tid & 63, w = owave(), lr = lane & 15, lq = lane >> 4;
    if (loadw) { const bf16* wg = wsb(C, WS_SGUW) + (size_t)(l * 4 + g) * 128 * 128;
#pragma unroll
      for (int q = 0; q < 4; ++q) { const int i = tid + q * NTHR, r = i >> 4, c16 = i & 15; *(LAS u32x4*)(lds + SG_W + (r * 136 + c16 * 8) * 2) = *(const u32x4*)(wg + r * 128 + c16 * 8); } }
    const int srow = w * 16 + lr; const size_t rowo = (size_t)(m0 + srow); u32x2 uw[4];
#pragma unroll
    for (int ct = 0; ct < 4; ++ct) uw[ct] = *(const u32x2*)(cols + rowo * NINP + C_SU + g * 64 + ct * 16 + 4 * lq);
    const float bias = oin(C.in_)[15][(size_t)(l * 4 + g) * 128 + srow];
    { const int row = tid >> 2, q = tid & 3; const bf16* rp = cols + (size_t)(m0 + row) * NINP + C_SV + q * 64; float v[64]; float sm4[4] = {0.f, 0.f, 0.f, 0.f};
      const u32x4 own0 = *(const u32x4*)(cols + (size_t)(m0 + row) * NINP + C_SV + g * 64 + q * 16), own1 = *(const u32x4*)(cols + (size_t)(m0 + row) * NINP + C_SV + g * 64 + q * 16 + 8);
#pragma unroll
      for (int i = 0; i < 8; ++i) { const u32x4 x = *(const u32x4*)(rp + i * 8); v[8 * i] = bflo(x.x); v[8 * i + 1] = bfhi(x.x); v[8 * i + 2] = bflo(x.y); v[8 * i + 3] = bfhi(x.y); v[8 * i + 4] = bflo(x.z); v[8 * i + 5] = bfhi(x.z); v[8 * i + 6] = bflo(x.w); v[8 * i + 7] = bfhi(x.w); }
#pragma unroll
      for (int i = 0; i < 64; ++i) sm4[i & 3] += v[i];
      float sm = (sm4[0] + sm4[1]) + (sm4[2] + sm4[3]);
      sm += __shfl_xor(sm, 1); sm += __shfl_xor(sm, 2); const float mean = sm * (1.0f / 256.0f); float sq4[4] = {0.f, 0.f, 0.f, 0.f};
#pragma unroll
      for (int i = 0; i < 64; ++i) { v[i] -= mean; sq4[i & 3] += v[i] * v[i]; }
      float sq = (sq4[0] + sq4[1]) + (sq4[2] + sq4[3]);
      sq += __shfl_xor(sq, 1); sq += __shfl_xor(sq, 2); const float rstd = __builtin_amdgcn_rsqf(sq * (1.0f / 256.0f) + EPS);
      { const float* lg = oin(C.in_)[12] + (size_t)l * 256 + g * 64 + q * 16; const float* lb = oin(C.in_)[13] + (size_t)l * 256 + g * 64 + q * 16; LAS bf16* vt = (LAS bf16*)(lds + SG_V) + (q * 16) * 136 + row;
        const unsigned ow[8] = {own0.x, own0.y, own0.z, own0.w, own1.x, own1.y, own1.z, own1.w};
#pragma unroll
        for (int i = 0; i < 8; ++i) { vt[(2 * i) * 136] = (bf16)f2bf((bflo(ow[i]) - mean) * rstd * lg[2 * i] + lb[2 * i]); vt[(2 * i + 1) * 136] = (bf16)f2bf((bfhi(ow[i]) - mean) * rstd * lg[2 * i + 1] + lb[2 * i + 1]); } } }
    __syncthreads();
    f32x4 a[4];
#pragma unroll
    for (int ct = 0; ct < 4; ++ct) a[ct] = (f32x4){0.f, 0.f, 0.f, 0.f};
#pragma unroll
    for (int ks = 0; ks < 4; ++ks) { const bf16x8 bw = *(const LAS bf16x8*)(lds + SG_W + ((w * 16 + lr) * 136 + ks * 32 + lq * 8) * 2);
#pragma unroll
        for (int ct = 0; ct < 4; ++ct) a[ct] = __builtin_amdgcn_mfma_f32_16x16x32_bf16(*(const LAS bf16x8*)(lds + SG_V + ((ct * 16 + lr) * 136 + ks * 32 + lq * 8) * 2), bw, a[ct], 0, 0, 0); }
#pragma unroll
    for (int ct = 0; ct < 4; ++ct) { const int c = ct * 16 + 4 * lq;
        u32x2 o; o.x = pk2(bflo(uw[ct].x) * (a[ct][0] + bias), bfhi(uw[ct].x) * (a[ct][1] + bias)); o.y = pk2(bflo(uw[ct].y) * (a[ct][2] + bias), bfhi(uw[ct].y) * (a[ct][3] + bias));
        *(u32x2*)(YS + rowo * D + 768 + g * 64 + c) = o; }
    __syncthreads();
}
__device__ __forceinline__ void cdft_tile(const Ctx& C, int c) {
    const bf16* cols = wsb(C, WS_R + R_COLS); const bf16* CS = wsb(C, WS_CS64);
    const int tid = otid(), lane = tid & 63, wave = owave(), wr = wave >> 2, wc = wave & 3, fr = lane & 15, fq = lane >> 4;
    const bf16* pa0 = CS + (size_t)(tid >> 3) * 64 + (tid & 7) * 8; const bf16* pa1 = pa0 + 64 * 64;
    if (c < 1024) {
        const int b = c >> 6, g = (c >> 4) & 3, bq = c & 15; bf16* ZT = wsb(C, WS_R + R_ZT) + (size_t)b * 256 * 4096;
        const int n0 = tid >> 3, n1 = n0 + 64;
        const int t0 = 64 * (n0 & 31) + 4 * bq + (n0 >> 5), t1 = 64 * (n1 & 31) + 4 * bq + (n1 >> 5);
        const bf16* pb0 = cols + (size_t)(b * T + t0) * NINP + C_FFT + g * 64 + (tid & 7) * 8; const bf16* pb1 = cols + (size_t)(b * T + t1) * NINP + C_FFT + g * 64 + (tid & 7) * 8;
        f32x4 acc[4][2]; tg_zero(acc); tg_tile(acc, C.lds, pa0, pa1, pb0, pb1, 1);
#pragma unroll
        for (int m = 0; m < 4; ++m)
#pragma unroll
            for (int n = 0; n < 2; ++n) { const int row = wr * 64 + m * 16 + fr, col = wc * 32 + n * 16 + 4 * fq;
                const int p = row >> 6, mm = row & 63, j = col >> 5, a = col & 31; u32x2 w; w.x = pk2(acc[m][n][0], acc[m][n][1]); w.y = pk2(acc[m][n][2], acc[m][n][3]);
                *(u32x2*)(ZT + ((size_t)((g * 64 + mm) * 2 + p) * 64 + 4 * bq + j) * 32 + a) = w; }
    } else {
        const int c2 = c - 1024, b = c2 >> 3, g = (c2 >> 1) & 3, tt = c2 & 1, m0 = MLAT + b * TC + tt * 128; bf16* ZT = wsb(C, WS_R + R_ZTC) + (size_t)b * 256 * 512;
        const bf16* pb0 = cols + (size_t)(m0 + (tid >> 3)) * NINP + C_FFT + g * 64 + (tid & 7) * 8; const bf16* pb1 = pb0 + (size_t)64 * NINP;
        f32x4 acc[4][2]; tg_zero(acc); tg_tile(acc, C.lds, pa0, pa1, pb0, pb1, 1);
#pragma unroll
        for (int m = 0; m < 4; ++m)
#pragma unroll
            for (int n = 0; n < 2; ++n) { const int row = wr * 64 + m * 16 + fr, col = wc * 32 + n * 16 + 4 * fq;
                const int p = row >> 6, mm = row & 63; u32x2 w; w.x = pk2(acc[m][n][0], acc[m][n][1]); w.y = pk2(acc[m][n][2], acc[m][n][3]);
                *(u32x2*)(ZT + (size_t)(g * 64 + mm) * (2 * TC) + p * TC + tt * 128 + col) = w; }
    }
}
constexpr int FF_X = 0, FF_T1 = 81920, FF_T2 = 90112, FF_TW = 106496, FF_OUT = 0;
__device__ __forceinline__ void fft_load_tables(const Ctx& C) {
    const int tid = otid(); const u32x4* src = (const u32x4*)(ows(C.ws_) + WS_TF1);
#pragma unroll
    for (int q = 0; q < 5; ++q) { const int i = tid + q * NTHR; *(LAS u32x4*)(C.lds + FF_T1 + i * 16) = src[i]; }
    __syncthreads();
}
__device__ __forceinline__ void fft_item(const Ctx& C, int item) {
    const int b = item >> 5, ch0 = (item & 31) * 8; LAS unsigned char* lds = C.lds;
    const int tid = otid(), lane = tid & 63, w = owave(), lr = lane & 15, lq = lane >> 4;
    LAS unsigned char* fx = lds + FF_X + w * 10240;
    { const u32x4* src = (const u32x4*)(wsb(C, WS_R + R_ZT) + ((size_t)(b * 256 + ch0 + w)) * 4096);
#pragma unroll
      for (int i = 0; i < 8; ++i) { const int q = lane + 64 * i; *(LAS u32x4*)(fx + (q >> 2) * 80 + (q & 3) * 16) = src[q]; } }
    f32x4 acc1[4][4];
#pragma unroll
    for (int rt = 0; rt < 4; ++rt)
#pragma unroll
        for (int ct = 0; ct < 4; ++ct) acc1[rt][ct] = (f32x4){0.f, 0.f, 0.f, 0.f};
#pragma unroll
    for (int ks = 0; ks < 2; ++ks) { bf16x8 af[4];
#pragma unroll
        for (int rt = 0; rt < 4; ++rt) af[rt] = *(const LAS bf16x8*)(fx + (ks * 64 + 16 * rt + lr) * 80 + lq * 16);
#pragma unroll
        for (int ct = 0; ct < 4; ++ct) { const bf16x8 bfr = *(const LAS bf16x8*)(lds + FF_T1 + ((ct * 2 + ks) * 64 + lane) * 16);
#pragma unroll
            for (int rt = 0; rt < 4; ++rt) acc1[rt][ct] = __builtin_amdgcn_mfma_f32_16x16x32_bf16(af[rt], bfr, acc1[rt][ct], 0, 0, 0); } }
    bf16x8 VR[2][2], VI[2][2];
#pragma unroll
    for (int ct = 0; ct < 2; ++ct)
#pragma unroll
        for (int ks = 0; ks < 2; ++ks) { float vr[8], vi[8];
#pragma unroll
            for (int hf = 0; hf < 2; ++hf) { const int rt = 2 * ks + hf;
#pragma unroll
                for (int r = 0; r < 4; ++r) { const f32x2 tw = *(const LAS f32x2*)(lds + FF_TW + (((rt * 2 + ct) * 4 + r) * 64 + lane) * 8);
                    const float ur = acc1[rt][ct][r], ui = acc1[rt][ct + 2][r]; vr[hf * 4 + r] = ur * tw.x + ui * tw.y; vi[hf * 4 + r] = ui * tw.x - ur * tw.y; } }
            u32x4 pr, pi; pr.x = pk2(vr[0], vr[1]); pr.y = pk2(vr[2], vr[3]); pr.z = pk2(vr[4], vr[5]); pr.w = pk2(vr[6], vr[7]);
            pi.x = pk2(vi[0], vi[1]); pi.y = pk2(vi[2], vi[3]); pi.z = pk2(vi[4], vi[5]); pi.w = pk2(vi[6], vi[7]);
            VR[ct][ks] = __builtin_bit_cast(bf16x8, pr); VI[ct][ks] = __builtin_bit_cast(bf16x8, pi); }
    __syncthreads();
#pragma unroll
    for (int dt = 0; dt < 4; ++dt) { bf16x8 fc[2], fs[2];
#pragma unroll
        for (int ks = 0; ks < 2; ++ks) { fc[ks] = *(const LAS bf16x8*)(lds + FF_T2 + (((0 * 4 + dt) * 2 + ks) * 64 + lane) * 16); fs[ks] = *(const LAS bf16x8*)(lds + FF_T2 + (((1 * 4 + dt) * 2 + ks) * 64 + lane) * 16); }
#pragma unroll
        for (int ct = 0; ct < 2; ++ct) { f32x4 o = (f32x4){0.f, 0.f, 0.f, 0.f};
#pragma unroll
            for (int ks = 0; ks < 2; ++ks) { o = __builtin_amdgcn_mfma_f32_16x16x32_bf16(fc[ks], VR[ct][ks], o, 0, 0, 0); o = __builtin_amdgcn_mfma_f32_16x16x32_bf16(fs[ks], VI[ct][ks], o, 0, 0, 0); }
#pragma unroll
            for (int r = 0; r < 4; ++r) { const int d = 16 * dt + 4 * lq + r, c = 16 * ct + lr, k = c + 32 * d; *(LAS bf16*)(lds + FF_OUT + (k * 8 + w) * 2) = (bf16)f2bf(o[r]); } } }
    __syncthreads();
    { bf16* YS = wsb(C, WS_R + R_YS);
#pragma unroll
      for (int i = 0; i < 4; ++i) { const int k = tid + NTHR * i; *(u32x4*)(YS + (size_t)(b * T + k) * D + 512 + ch0) = *(const LAS u32x4*)(lds + FF_OUT + k * 16); } }
    __syncthreads();
}

constexpr bool LOCAL_BARS = true;
__global__ void __launch_bounds__(NTHR, 2) fwd_kernel(Params prm) {
    extern __shared__ __attribute__((aligned(16))) unsigned char lds_raw[];
    Ctx C; C.lds = (LAS unsigned char*)lds_raw; C.ws_ = prm.ws; C.in_ = prm.in; C.out_ = prm.out; C.vx = 0; C.vr = 0; C.loc = 0;

    volatile LAS unsigned* MISC = (volatile LAS unsigned*)(C.lds + LDS_MISC);
    if (threadIdx.x < 16) MISC[threadIdx.x] = 0u;
    __syncthreads();
    (void)xcd_barrier_post((unsigned*)(ows(C.ws_) + WS_CTL) + CW_BAR, MISC + 8);
#define BAR_(rel) do { XcdBarrier b_; b_.bar = (unsigned*)(ows(C.ws_) + WS_CTL) + CW_BAR; b_.x = (unsigned)__builtin_amdgcn_readfirstlane((int)xb_xcc_id()); b_.st = MISC + 8; xcd_barrier(b_, rel); } while (0)
#define GRID_BAR() BAR_(true)
#define BAR_X() BAR_(oloc(C) == 0)
#define BAR_L() do { if (LOCAL_BARS && oloc(C)) xcd_local_barrier((unsigned*)(ows(C.ws_) + WS_CTL) + CW_BAR, (unsigned)__builtin_amdgcn_readfirstlane((int)xb_xcc_id())); else BAR_(oloc(C) == 0); } while (0)

    p_prologue(C); GRID_BAR();
    { const int ok = (int)MISC[8 + 2];
      C.loc = __builtin_amdgcn_readfirstlane(ok); C.vx = __builtin_amdgcn_readfirstlane(ok ? (int)MISC[8 + 4] : (oblk() >> 5)); C.vr = __builtin_amdgcn_readfirstlane(ok ? (int)MISC[8 + 3] : (oblk() & 31)); }
    p_lna(C); BAR_L();

#pragma unroll 1
    for (int l = 0; l < DEPTH; ++l) {
        const bool last = (l == DEPTH - 1); const int mrows = last ? MLAT : M;
        const int nMl = last ? 16 : 18;
        const bf16* H = hbuf(C);
        { pg8::Gemm g{H, wW(C, WE_WIN + (size_t)l * 6144 * 1024), D, nullptr, D}; pg8::Sched<0> S; S.go.init_l(18, NINP / 256, ovr(C), ovx(C)); S.bp0 = 0; S.p0 = 0; S.pe = nullptr;
          { const int tid = otid(); if (tid < 64) *(LAS f32x4*)(C.lds + 131072 + tid * 16) = *(const f32x4*)(oin(C.in_)[8] + (size_t)l * 256 + tid * 4); __syncthreads(); }
          pg8::EpiCols E{wsb(C, WS_R + R_COLS)};
          pg8::gemm_phase<pg8::EpiCols, pg8::Sched<0>, false>(C.lds, g, S, E); }
        BAR_L();
        { const int nG = 288, nPL = 32, nPC = last ? 0 : 8, nSl = 128, nSc = last ? 0 : 16, nDl = 128, nDc = last ? 0 : 16;
          const int tot = nG + nPL + nPC + nSl + nSc + nDl + nDc, vx = ovx(C);
          for (int it = ovr(C); it < tot; it += 32) { int i = it;
              if (i < nG) { gla1_item(C, 288 * vx + i); continue; } i -= nG;
              if (i < nPL) { pool_lat_item(C, l, 32 * vx + i); continue; } i -= nPL;
              if (i < nPC) { pool_ctx_item(C, l, 8 * vx + i); continue; } i -= nPC;
              if (i < nSl + nSc) { sgu_item(C, l, i < nSl ? 128 * vx + i : 1024 + 16 * vx + (i - nSl), i < 32); continue; } i -= nSl + nSc;
              cdft_tile(C, i < nDl ? 128 * vx + i : 1024 + 16 * vx + (i - nDl)); } }
        BAR_L();
        gla2_all(C);
        fft_load_tables(C);
        for (int it = ovr(C); it < 64; it += 32) fft_item(C, 64 * ovx(C) + it);
        BAR_L();
        { for (int it = ovr(C); it < 288; it += 32) { const int gi = 288 * ovx(C) + it, rem = gi % 144; if (last && rem < 16) continue; gla3_item(C, l, gi); }
          bf16* YS = wsb(C, WS_R + R_YS);
          const int tid = otid(), lane = tid & 63, wave = owave(), wr = wave >> 2, wc = wave & 3, fr = lane & 15, fq = lane >> 4;
          const int nctx = last ? 0 : 8;
          for (int t2l = ovr(C); t2l < nctx; t2l += 32) { const int t2 = 8 * ovx(C) + t2l;
              const int b = t2 >> 2, tm = (t2 >> 1) & 1, tn = t2 & 1, K = 2 * TC, mrow0 = MLAT + b * TC; const bf16* A = wsb(C, WS_DLC); const bf16* Bt = wsb(C, WS_R + R_ZTC) + (size_t)b * 256 * 512;
              const bf16* pa0 = A + (size_t)(tm * 128 + (tid >> 3)) * K + (tid & 7) * 8; const bf16* pa1 = pa0 + (size_t)64 * K;
              const bf16* pb0 = Bt + (size_t)(tn * 128 + (tid >> 3)) * K + (tid & 7) * 8; const bf16* pb1 = pb0 + (size_t)64 * K;
              f32x4 acc[4][2]; tg_zero(acc); tg_tile(acc, C.lds, pa0, pa1, pb0, pb1, K / 64);
#pragma unroll
              for (int m = 0; m < 4; ++m)
#pragma unroll
                  for (int n = 0; n < 2; ++n) { const int row = mrow0 + tm * 128 + wr * 64 + m * 16 + fr, col = tn * 128 + wc * 32 + n * 16 + 4 * fq;
                      u32x2 w; w.x = pk2(acc[m][n][0], acc[m][n][1]); w.y = pk2(acc[m][n][2], acc[m][n][3]); *(u32x2*)(YS + (size_t)row * D + 512 + col) = w; }
          }
        }
        BAR_X();
        { pg8::Gemm g{wsb(C, WS_R + R_YS), wW(C, WE_WBR + (size_t)l * 4 * 1024 * 256), 256, nullptr, D}; pg8::Sched<4> S; S.go.init_l(nMl, 16, ovr(C), ovx(C), 1); S.bp0 = 0; S.p0 = 0; S.pe = nullptr;
          pg8::EpiP E{wsb(C, WS_R + R_G)};
          pg8::gemm_phase<pg8::EpiP, pg8::Sched<4>, false>(C.lds, g, S, E); }
        BAR_L();
        { pg8::Gemm g{(const bf16*)h8buf(C), (const bf16*)(ows(C.ws_) + WS_G8 + (size_t)l * 4096 * 1024), D / 2, nullptr, D / 2}; pg8::Sched<0> S; S.go.init_l(nMl, 16, ovr(C), ovx(C)); S.bp0 = 0; S.p0 = 0; S.pe = nullptr;
          pg8::EpiGateMix E{wsb(C, WS_R + R_G), wsb(C, WS_R + R_MM), 1.0f / G8_SCALE};
          pg8::gemm_phase<pg8::EpiGateMix, pg8::Sched<0>, false, true>(C.lds, g, S, E); }
        BAR_L();
        { pg8::Gemm g{wsb(C, WS_R + R_MM), wW(C, WE_WO + (size_t)l * D * D), D, nullptr, D}; pg8::Sched<0> S; S.go.init_l(nMl, 4, ovr(C), ovx(C), 1); S.bp0 = 0; S.p0 = 0; S.pe = nullptr;
          pg8::EpiAct E{wsb(C, WS_R + R_YS), D, EM_NONE, nullptr};
          pg8::gemm_phase<pg8::EpiAct, pg8::Sched<0>, false>(C.lds, g, S, E); }
        BAR_L();
        p_lnb(C, l, mrows);
        const bool moe = (l & 1); const int jm = l >> 1;
        if (moe) GRID_BAR(); else BAR_X();
        int npanels = mrows / 256;
        if (moe) { p_route_build(C, l, mrows); GRID_BAR(); RouteInfo R; route_info(C, jm, R); npanels = R.npanels; }
        { const int* rt = (const int*)(ows(C.ws_) + WS_ROUTE); const int* s2t = moe ? rt + RT_S2T : rt + RT_IDT; const int* pe = rt + RT_PE;
          const bf16* WGU = moe ? wW(C, WE_GUE + (size_t)jm * 8 * 5632 * 1024) : wW(C, WE_GUD + (size_t)jm * 5632 * 1024);
          const bf16* WDN = moe ? wW(C, WE_DE + (size_t)jm * 8 * 1024 * 2816) : wW(C, WE_DD + (size_t)jm * 1024 * 2816);
          bf16* ACT = wsb(C, WS_R + R_ACT); bf16* Y2 = wsb(C, WS_R + R_Y2);
          const int pcap = moe ? (DOWN8_MOE ? 296 : 128) : 144;
#pragma unroll 1
          for (int p0 = 0; p0 < npanels; p0 += pcap) { const int np = (npanels - p0) < pcap ? (npanels - p0) : pcap;
              const bool own = moe && oloc(C);
              const int plo = (np * ovx(C)) >> 3, phi = (np * (ovx(C) + 1)) >> 3;
              { pg8::Gemm g{(const bf16*)h8buf(C), WGU, D / 2, s2t, D / 2}; pg8::Sched<2> S; if (own) S.go.init_p(phi - plo, 22, ovr(C), plo); else if (moe) S.go.init(np, 22, ogrid(), oblk()); else S.go.init_l(nMl, 22, ovr(C), ovx(C), 1); S.bp0 = 0; S.p0 = p0; S.pe = moe ? pe : nullptr;
                const bool f8down = moe ? DOWN8_MOE : DOWN8_DENSE;
                pg8::EpiSwiGLU E{ACT, DFF, 1.0f / G8_SCALE, f8down ? ACT8_SCALE : 0.f};
                pg8::gemm_phase<pg8::EpiSwiGLU, pg8::Sched<2>, true, true>(C.lds, g, S, E); }
              if (moe && !own) GRID_BAR(); else BAR_L();
              if (moe ? DOWN8_MOE : DOWN8_DENSE) { pg8::Gemm g{ACT, WDN, DFF / 2, nullptr, DFF / 2}; pg8::Sched<3> S; if (own) S.go.init_p(phi - plo, 4, ovr(C), plo, 1); else if (moe) S.go.init(np, 4, ogrid(), oblk()); else S.go.init_l(nMl, 4, ovr(C), ovx(C)); S.bp0 = 8; S.p0 = p0; S.pe = moe ? pe : nullptr;
                pg8::EpiScale E{Y2, D, 1.0f / (G8_SCALE * ACT8_SCALE)};
                pg8::gemm_phase<pg8::EpiScale, pg8::Sched<3>, false, true>(C.lds, g, S, E); }
              else { pg8::Gemm g{ACT, WDN, DFF, nullptr, DFF}; pg8::Sched<3> S; if (own) S.go.init_p(phi - plo, 4, ovr(C), plo, 1); else if (moe) S.go.init(np, 4, ogrid(), oblk()); else S.go.init_l(nMl, 4, ovr(C), ovx(C)); S.bp0 = 4; S.p0 = p0; S.pe = moe ? pe : nullptr;
                pg8::EpiAct E{Y2, D, EM_NONE, nullptr};
                pg8::gemm_phase<pg8::EpiAct, pg8::Sched<3>, false>(C.lds, g, S, E); }
              if (!moe) BAR_L(); else if (own && p0 + np < npanels) BAR_X(); else GRID_BAR();
          } }
        p_lnc(C, l, mrows);
        if (!last) BAR_X();
    }
}

extern "C" void kernel_launch(void* const* d_in, const int* in_sizes, int n_in, void* d_out, int out_size, void* d_ws, size_t ws_size, hipStream_t stream) {
    static int grid = 0;
    if (grid == 0) {
        if (n_in != 28 || out_size != MLAT * D || ws_size < WS_END) { fprintf(stderr, "kernel_launch: unexpected shapes (n_in %d, out %d, ws %zu < %zu)\n", n_in, out_size, ws_size, (size_t)WS_END); grid = -1; return; }
        int dev = 0, cus = 0, per_cu = 0;
        if (hipGetDevice(&dev) != hipSuccess || hipDeviceGetAttribute(&cus, hipDeviceAttributeMultiprocessorCount, dev) != hipSuccess) { grid = -1; return; }
        if (hipFuncSetAttribute((const void*)fwd_kernel, hipFuncAttributeMaxDynamicSharedMemorySize, LDS_BYTES) != hipSuccess) { fprintf(stderr, "kernel_launch: hipFuncSetAttribute failed\n"); grid = -1; return; }
        if (hipOccupancyMaxActiveBlocksPerMultiprocessor(&per_cu, (const void*)fwd_kernel, NTHR, LDS_BYTES) != hipSuccess || per_cu < 1) fprintf(stderr, "kernel_launch: occupancy query says %d\n", per_cu);
        (void)hipGetLastError();
        grid = cus;
        if (grid != 256) { fprintf(stderr, "kernel_launch: built for 256 CUs, device has %d\n", cus); grid = -1; return; }
    }
    if (grid < 0) return;
    if (hipMemsetAsync((char*)d_ws + WS_CTL, 0, CTL_BYTES, stream) != hipSuccess) return;
    Params p{};
    for (int i = 0; i < 28; ++i) p.in[i] = (const float*)d_in[i];
    p.out = (float*)d_out; p.ws = (unsigned char*)d_ws;
    hipLaunchKernelGGL(fwd_kernel, dim3(grid), dim3(NTHR), LDS_BYTES, stream, p);
}
```

```cpp
#include <hip/hip_runtime.h>
#include <cstdio>
#include <cstdint>

#define GAS __attribute__((address_space(1)))
#define LAS __attribute__((address_space(3)))
typedef unsigned short bf16;
typedef short bf16x8 __attribute__((ext_vector_type(8)));
typedef float f32x4 __attribute__((ext_vector_type(4)));
typedef unsigned u32x4 __attribute__((ext_vector_type(4)));
typedef unsigned u32x2 __attribute__((ext_vector_type(2)));
typedef float f32x2 __attribute__((ext_vector_type(2)));

#ifndef PROBE
#define PROBE 0
#endif
constexpr int NB = 16, T = 2048, TC = 256, D = 1024, DEPTH = 4;
constexpr int MLAT = NB * T, MCTX = NB * TC, M = MLAT + MCTX;
constexpr int NIN = 1824, NINP = 2048, DFF = 2816, NE = 8;
constexpr int NTHR = 512, NWAVE = 8;
constexpr float ALPHA = 1.6817928305074290f;
constexpr float EPS = 1e-6f;
constexpr int C_Q = 0, C_K = 128, C_V = 256, C_R = 512, C_LAF = 768, C_LAB = 896, C_POOL = 1024, C_FFT = 1280, C_SU = 1536, C_SV = 1792;

constexpr size_t MiB = 1u << 20;
constexpr size_t WS_CTL = 0, CTL_BYTES = 1 * MiB;
constexpr size_t WS_MOD = 1 * MiB;
constexpr size_t WS_CS64 = 3 * MiB;
constexpr size_t WS_DLC = 3 * MiB + 65536;
constexpr size_t WS_SGUW = 3 * MiB + 512 * 1024;
constexpr size_t WS_TF1 = 4 * MiB;
constexpr size_t WS_TF2 = 4 * MiB + 8192;
constexpr size_t WS_TW = 4 * MiB + 24576;
constexpr size_t WS_ROUTE = 20 * MiB;
constexpr size_t WS_W = 22 * MiB;
constexpr size_t WS_XC = 384 * MiB;
constexpr size_t WS_G8 = WS_XC;
constexpr size_t OUT_H8 = 72 * MiB;
constexpr bool DOWN8_DENSE = true;
constexpr bool DOWN8_MOE = true;
constexpr float ACT8_SCALE = 2.0f;
constexpr float G8_SCALE = 32.0f;
constexpr size_t WS_H = 400 * MiB;
constexpr bool XBF16 = true;
constexpr size_t WS_R = 472 * MiB;
constexpr size_t WS_END = 904 * MiB;
constexpr size_t R_YS = 0, R_MM = 72 * MiB, R_BIG = 144 * MiB;
constexpr size_t R_COLS = R_BIG, R_SCR = R_BIG + 144 * MiB;
constexpr size_t R_ZT = R_SCR, R_ZTC = R_SCR + 32 * MiB, R_DH = R_SCR + 36 * MiB, R_DEC = R_SCR + 72 * MiB;
constexpr size_t R_G = R_BIG;
constexpr size_t R_ACT = 0, R_Y2 = 204 * MiB;
constexpr size_t WE_WIN = 0;
constexpr size_t WE_WBR = WE_WIN + (size_t)4 * 6144 * 1024;
constexpr size_t WE_WO = WE_WBR + (size_t)4 * 4 * 1024 * 256;
constexpr size_t WE_GUD = WE_WO + (size_t)4 * 1024 * 1024;
constexpr size_t WE_DD = WE_GUD + (size_t)2 * 5632 * 1024;
constexpr size_t WE_GUE = WE_DD + (size_t)2 * 1024 * 2816;
constexpr size_t WE_DE = WE_GUE + (size_t)2 * 8 * 5632 * 1024;
constexpr size_t WE_END = WE_DE + (size_t)2 * 8 * 1024 * 2816;
static_assert(WE_END * 2 <= 362 * MiB, "weights fit");
constexpr int MAXP = 296;
constexpr size_t RT_TOKE = 0, RT_TOKR = (size_t)M * 2, RT_TOKW = (size_t)M * 4, RT_TOKS = (size_t)M * 6, RT_S2T = (size_t)M * 8, RT_PE = RT_S2T + (size_t)MAXP * 256, RT_BLK = RT_PE + 512, RT_IDT = RT_BLK + 2048;
static_assert((RT_IDT + M) * 4 <= 2 * MiB, "route tables fit");
constexpr int CW_BAR = 4096;
constexpr int CW_CNT = 16384;
constexpr int LDS_BYTES = 147456;
constexpr int LDS_MISC = 147456 - 256;

typedef __bf16 hwbf2 __attribute__((ext_vector_type(2)));
__device__ __forceinline__ unsigned pk2(float lo, float hi) { hwbf2 v; v[0] = (__bf16)lo; v[1] = (__bf16)hi; return __builtin_bit_cast(unsigned, v); }
__device__ __forceinline__ unsigned f2bf(float f) { return (unsigned)__builtin_bit_cast(unsigned short, (__bf16)f); }
__device__ __forceinline__ unsigned pk4_fp8(float a, float b, float c, float d) { int w = 0; w = __builtin_amdgcn_cvt_pk_fp8_f32(a, b, w, false); w = __builtin_amdgcn_cvt_pk_fp8_f32(c, d, w, true); return (unsigned)w; }
__device__ __forceinline__ float bf2f(unsigned b) { return __builtin_bit_cast(float, b << 16); }
__device__ __forceinline__ float bflo(unsigned w) { return __builtin_bit_cast(float, w << 16); }
__device__ __forceinline__ float bfhi(unsigned w) { return __builtin_bit_cast(float, w & 0xffff0000u); }
typedef float f32x2 __attribute__((ext_vector_type(2)));
__device__ __forceinline__ float sigmoidf_(float x) { return __builtin_amdgcn_rcpf(1.0f + __expf(-x)); }
__device__ __forceinline__ float siluf_(float x) { return x * __builtin_amdgcn_rcpf(1.0f + __expf(-x)); }
__device__ __forceinline__ float gelu_tanh_(float x) { const float u = 0.7978845608028654f * (x + 0.044715f * x * x * x); return x * __builtin_amdgcn_rcpf(1.0f + __expf(-2.0f * u)); }
__device__ __forceinline__ float logsigmoidf_(float z) { return fminf(z, 0.f) - __logf(1.0f + __expf(-fabsf(z))); }
template <int CTRL, int RMASK> __device__ __forceinline__ float dpp_get(float v) { return __builtin_bit_cast(float, __builtin_amdgcn_update_dpp(0, __builtin_bit_cast(int, v), CTRL, RMASK, 0xF, true)); }
__device__ __forceinline__ float wave_sum(float v) {
    v += dpp_get<0xB1, 0xF>(v); v += dpp_get<0x4E, 0xF>(v); v += dpp_get<0x141, 0xF>(v); v += dpp_get<0x140, 0xF>(v);
    v += dpp_get<0x142, 0xA>(v); v += dpp_get<0x143, 0xC>(v);
    return __builtin_bit_cast(float, __builtin_amdgcn_readlane(__builtin_bit_cast(int, v), 63));
}

__device__ __forceinline__ int otid() { int t = threadIdx.x; asm volatile("" : "+v"(t)); return t; }
__device__ __forceinline__ int oblk() { int b = blockIdx.x; asm volatile("" : "+s"(b)); return b; }
__device__ __forceinline__ int ogrid() { int g = gridDim.x; asm volatile("" : "+s"(g)); return g; }
__device__ __forceinline__ int owave() { return __builtin_amdgcn_readfirstlane(otid() >> 6); }
__device__ __forceinline__ unsigned ozero() { unsigned z; asm volatile("s_mov_b32 %0, 0" : "=s"(z)); return z; }
__device__ __forceinline__ unsigned char* ows(unsigned char* p) { return p + ozero(); }
__device__ __forceinline__ const float* const* oin(const float* const* p) { return p; }
__device__ __forceinline__ float* oout(float* p) { return p + ozero(); }

#define XB_TMO      128
#define XB_XCNT(j)  (256  + 64 * (j))
#define XB_XSUB(j)  (1280 + 64 * (j))
#define XB_XGEN(j)  (2304 + 64 * (j))
#define XB_TOP      3328
#define XB_TOPGEN   3392
#define XB_LSUB(j)  (3456 + 64 * (j))
#define XB_LGEN(j)  (4480 + 64 * (j))
#define XCD_BAR_WORDS 3456
#define XB_SPIN_CAP (1u << 22)
__device__ __forceinline__ unsigned xb_ld(unsigned* p)              { return __hip_atomic_load(p, __ATOMIC_RELAXED, __HIP_MEMORY_SCOPE_AGENT); }
__device__ __forceinline__ unsigned xb_add(unsigned* p, unsigned v) { return __hip_atomic_fetch_add(p, v, __ATOMIC_RELAXED, __HIP_MEMORY_SCOPE_AGENT); }
__device__ __forceinline__ unsigned xb_xcc_id() { return (unsigned)__builtin_amdgcn_s_getreg((3 << 11) | 20) & 0xFu; }
#define XB_SPIN(cond, bar) do { unsigned _sp = 0; while (cond) { __builtin_amdgcn_s_sleep(1); \
    if ((++_sp & 255u) == 0u) { if (xb_ld(&(bar)[XB_TMO])) break; if (_sp > XB_SPIN_CAP) { atomicAdd(&(bar)[XB_TMO], 1u); break; } } } } while (0)
struct XcdBarrier { unsigned* bar; unsigned x; volatile LAS unsigned* st; };
__device__ __forceinline__ XcdBarrier xcd_barrier_post(unsigned* bar, volatile LAS unsigned* st) {
    XcdBarrier b; b.bar = bar; b.x = xb_xcc_id(); b.st = st;
    if (threadIdx.x == 0) { st[3] = xb_add(&bar[XB_XCNT(b.x)], 1u); st[4] = b.x; }
    return b;
}
__device__ __forceinline__ void xcd_barrier_complete(unsigned* bar, unsigned x, unsigned& nloc, unsigned& nx, unsigned& even) {
    const unsigned G = gridDim.x * gridDim.y * gridDim.z;
    unsigned sum, cnt, mine, odd, sp = 0u;
    for (;;) {
        sum = 0u; cnt = 0u; mine = 0u; odd = 0u;
#pragma unroll
        for (unsigned j = 0; j < 16; ++j) { const unsigned c = xb_ld(&bar[XB_XCNT(j)]); sum += c; cnt += (c > 0u) ? 1u : 0u; mine = (j == x) ? c : mine; odd += (j < 8u ? c != 32u : c != 0u) ? 1u : 0u; }
        if (sum == G) break;
        __builtin_amdgcn_s_sleep(1);
        if ((++sp & 255u) == 0u) { if (xb_ld(&bar[XB_TMO])) break; if (sp > XB_SPIN_CAP) { atomicAdd(&bar[XB_TMO], 1u); break; } }
    }
    nloc = mine > 0u ? mine : 1u; nx = cnt > 0u ? cnt : 1u; even = (odd == 0u && sum == 256u) ? 1u : 0u;
}
__device__ __forceinline__ void xcd_barrier(const XcdBarrier& b, bool rel) {
    asm volatile("s_waitcnt vmcnt(0)" ::: "memory");
    __syncthreads();
    if (otid() == 0) {
        unsigned* bar = b.bar;
        __builtin_amdgcn_s_waitcnt(0);
        unsigned nloc = b.st[0], nx = b.st[1];
        if (nloc == 0u) { unsigned even; xcd_barrier_complete(bar, b.x, nloc, nx, even); b.st[0] = nloc; b.st[1] = nx; b.st[2] = even; }
        const unsigned old = xb_add(&bar[XB_XSUB(b.x)], 1u);
        const unsigned gen = old / nloc;
        if (old + 1u == (gen + 1u) * nloc) {
            if (rel) __builtin_amdgcn_fence(__ATOMIC_RELEASE, "agent");
            asm volatile("s_waitcnt vmcnt(0)" ::: "memory");
            const unsigned og = xb_add(&bar[XB_TOP], 1u);
            const unsigned tg = og / nx;
            if (og + 1u == (tg + 1u) * nx) xb_add(&bar[XB_TOPGEN], 1u);
            else XB_SPIN(xb_ld(&bar[XB_TOPGEN]) == tg, bar);
            __builtin_amdgcn_fence(__ATOMIC_ACQUIRE, "agent");
            xb_add(&bar[XB_XGEN(b.x)], 1u);
            asm volatile("s_waitcnt vmcnt(0)" ::: "memory");
        } else {
            XB_SPIN(xb_ld(&bar[XB_XGEN(b.x)]) == gen, bar);
            __builtin_amdgcn_fence(__ATOMIC_ACQUIRE, "agent");
            asm volatile("s_waitcnt vmcnt(0)" ::: "memory");
        }
    }
    __syncthreads();
}

__device__ __forceinline__ void xcd_local_barrier(unsigned* bar, unsigned x) {
    asm volatile("s_waitcnt vmcnt(0)" ::: "memory");
    __syncthreads();
    if (otid() == 0) {
        __builtin_amdgcn_s_waitcnt(0);
        const unsigned old = xb_add(&bar[XB_LSUB(x)], 1u);
        const unsigned gen = old / 32u;
        if (old + 1u == (gen + 1u) * 32u) xb_add(&bar[XB_LGEN(x)], 1u);
        else XB_SPIN(xb_ld(&bar[XB_LGEN(x)]) == gen, bar);
        __builtin_amdgcn_fence(__ATOMIC_ACQUIRE, "agent");
        asm volatile("s_waitcnt vmcnt(0)" ::: "memory");
    }
    __syncthreads();
}

struct Params { const float* in[28]; float* out; unsigned char* ws; };
struct Ctx {
    LAS unsigned char* lds;
    unsigned char* ws_;
    const float* const* in_;
    float* out_;
    int vx, vr, loc;
};
__device__ __forceinline__ int ovx(const Ctx& C) { int v = C.vx; asm volatile("" : "+s"(v)); return v; }
__device__ __forceinline__ int ovr(const Ctx& C) { int v = C.vr; asm volatile("" : "+s"(v)); return v; }
__device__ __forceinline__ int oloc(const Ctx& C) { int v = C.loc; asm volatile("" : "+s"(v)); return v; }
__device__ __forceinline__ int lrow(const Ctx& C, int j) { const int vx = ovx(C); return j < 4096 ? 4096 * vx + j : MLAT + 512 * vx + (j - 4096); }
__device__ __forceinline__ bf16* wsb(const Ctx& C, size_t off) { return (bf16*)(ows(C.ws_) + off); }
__device__ __forceinline__ bf16* wW(const Ctx& C, size_t eoff) { return (bf16*)(ows(C.ws_) + WS_W) + eoff; }
__device__ __forceinline__ const float* modv(const Ctx& C, int l, int r, int part) { return (const float*)(ows(C.ws_) + WS_MOD) + ((size_t)(l * 17 + r) * 6144 + part * 1024); }
__device__ __forceinline__ int row_r(int m) { return m < MLAT ? (m >> 11) : 16; }

#define LBAR() do { asm volatile("s_waitcnt lgkmcnt(0)" ::: "memory"); __builtin_amdgcn_s_barrier(); asm volatile("" ::: "memory"); } while (0)
constexpr int TG_ROWB = 144;
constexpr int TG_OPB = 128 * TG_ROWB;
__device__ __forceinline__ void tg_tile(f32x4 (&acc)[4][2], LAS unsigned char* lds, const bf16* pa0, const bf16* pa1, const bf16* pb0, const bf16* pb1, int nk) {
    const int tid = otid(), lane = tid & 63, wave = tid >> 6, wr = wave >> 2, wc = wave & 3, fr = lane & 15, fq = lane >> 4;
    const int so0 = (tid >> 3) * TG_ROWB + (tid & 7) * 16, so1 = so0 + 64 * TG_ROWB;
    u32x4 ra0 = *(const u32x4*)pa0, ra1 = *(const u32x4*)pa1, rb0 = *(const u32x4*)pb0, rb1 = *(const u32x4*)pb1;
    *(LAS u32x4*)(lds + so0) = ra0; *(LAS u32x4*)(lds + so1) = ra1; *(LAS u32x4*)(lds + TG_OPB + so0) = rb0; *(LAS u32x4*)(lds + TG_OPB + so1) = rb1;
    LBAR();
    for (int kt = 0; kt < nk; ++kt) {
        const bool more = kt + 1 < nk;
        if (more) { const int ko = (kt + 1) * 64; ra0 = *(const u32x4*)(pa0 + ko); ra1 = *(const u32x4*)(pa1 + ko); rb0 = *(const u32x4*)(pb0 + ko); rb1 = *(const u32x4*)(pb1 + ko); }
        LAS unsigned char* cur = lds + (kt & 1) * (2 * TG_OPB);
#pragma unroll
        for (int ks = 0; ks < 2; ++ks) {
            bf16x8 af[4], bfr[2];
#pragma unroll
            for (int m = 0; m < 4; ++m) af[m] = *(const LAS bf16x8*)(cur + (wr * 64 + m * 16 + fr) * TG_ROWB + ks * 64 + fq * 16);
#pragma unroll
            for (int n = 0; n < 2; ++n) bfr[n] = *(const LAS bf16x8*)(cur + TG_OPB + (wc * 32 + n * 16 + fr) * TG_ROWB + ks * 64 + fq * 16);
#pragma unroll
            for (int m = 0; m < 4; ++m)
#pragma unroll
                for (int n = 0; n < 2; ++n) acc[m][n] = __builtin_amdgcn_mfma_f32_16x16x32_bf16(bfr[n], af[m], acc[m][n], 0, 0, 0);
        }
        if (more) { LAS unsigned char* nxt = lds + ((kt + 1) & 1) * (2 * TG_OPB);
            *(LAS u32x4*)(nxt + so0) = ra0; *(LAS u32x4*)(nxt + so1) = ra1; *(LAS u32x4*)(nxt + TG_OPB + so0) = rb0; *(LAS u32x4*)(nxt + TG_OPB + so1) = rb1; }
        LBAR();
    }
}
__device__ __forceinline__ void tg_zero(f32x4 (&acc)[4][2]) {
#pragma unroll
    for (int m = 0; m < 4; ++m)
#pragma unroll
        for (int n = 0; n < 2; ++n) acc[m][n] = (f32x4){0.f, 0.f, 0.f, 0.f};
}

enum { EM_NONE = 0, EM_SIGMOID = 1, EM_COLS = 2 };
__device__ __forceinline__ f32x4 epi_apply(f32x4 v, int mode, int col, const float* bgk) {
    if (mode == EM_NONE) return v;
    if (mode == EM_SIGMOID) { for (int j = 0; j < 4; ++j) v[j] = sigmoidf_(v[j]); return v; }
    if (col < C_K) { for (int j = 0; j < 4; ++j) v[j] *= 0.17677669529663689f; }
    else if (col < C_R) {}
    else if (col < C_LAF) { for (int j = 0; j < 4; ++j) v[j] = siluf_(v[j]); }
    else if (col < C_POOL) { for (int j = 0; j < 4; ++j) v[j] = logsigmoidf_(v[j] + bgk[col - C_LAF + j]) * 0.0625f; }
    else if (col < C_SU) {}
    else { for (int j = 0; j < 4; ++j) v[j] = gelu_tanh_(v[j]); }
    return v;
}
__device__ __forceinline__ void tg_gemm_plain(const Ctx& C, const bf16* A, int lda, const int* rowmap, int mrows, const bf16* Bt, int ldb, int ncols, int K,
                                              bf16* O, int ldo, int mode, const float* bgk) {
    const int tid = otid(), lane = tid & 63, wave = owave(), wr = wave >> 2, wc = wave & 3, fr = lane & 15, fq = lane >> 4;
    const int ntn = ncols / 128, ntiles = (mrows / 128) * ntn;
    for (int t = oblk(); t < ntiles; t += ogrid()) {
        const int tm = t / ntn, tn = t % ntn;
        const int r0 = tm * 128 + (tid >> 3), r1 = r0 + 64;
        const size_t ar0 = rowmap ? (size_t)rowmap[r0] : (size_t)r0, ar1 = rowmap ? (size_t)rowmap[r1] : (size_t)r1;
        const bf16* pa0 = A + ar0 * lda + (tid & 7) * 8; const bf16* pa1 = A + ar1 * lda + (tid & 7) * 8;
        const bf16* pb0 = Bt + (size_t)(tn * 128 + (tid >> 3)) * ldb + (tid & 7) * 8; const bf16* pb1 = pb0 + (size_t)64 * ldb;
        f32x4 acc[4][2]; tg_zero(acc);
        tg_tile(acc, C.lds, pa0, pa1, pb0, pb1, K / 64);
#pragma unroll
        for (int m = 0; m < 4; ++m)
#pragma unroll
            for (int n = 0; n < 2; ++n) {
                const int row = tm * 128 + wr * 64 + m * 16 + fr, col = tn * 128 + wc * 32 + n * 16 + 4 * fq;
                const f32x4 v = epi_apply(acc[m][n], mode, col, bgk);
                u32x2 w; w.x = pk2(v[0], v[1]); w.y = pk2(v[2], v[3]);
                *(u32x2*)(O + (size_t)row * ldo + col) = w;
            }
    }
}


namespace pg8 {
constexpr int BM = 256, BK = 64, HALF = 128, HTB = HALF * BK * 2, STAGE_BYTES = 8 * HTB;
__device__ __forceinline__ int lds_byte(int r, int c) { return r * 128 + ((((c >> 3) ^ (r >> 1)) & 7) << 4) + (c & 7) * 2; }
__device__ __forceinline__ void stage_rc(int b, int& R, int& C) { R = b >> 7; C = ((((b >> 4) ^ (R >> 1)) & 7) << 3) + ((b & 15) >> 1); }
__device__ __forceinline__ int perm32(int rho) { const int n = rho >> 4, i = rho & 15; return 8 * (i >> 2) + 4 * n + (i & 3); }
struct Unit { int ap, bp, orow, ocol, akb; };
struct Gemm { const bf16* A; const bf16* Bt; int K; const int* rowmap; int lda; };
struct GridOrder {
    int nM, nN, nwg, G, c, vx, pb, rev;
    __device__ __forceinline__ void init(int nM_, int nN_, int G_, int c_) { nM = nM_; nN = nN_; nwg = nM * nN; G = G_; c = c_; vx = -1; pb = 0; rev = 0; }
    __device__ __forceinline__ void init_l(int nMl, int nN_, int vr_, int vx_, int rev_ = 0) { nM = nMl; nN = nN_; nwg = nM * nN; G = 32; c = vr_; vx = vx_; pb = 0; rev = rev_; }
    __device__ __forceinline__ void init_p(int nMl, int nN_, int vr_, int pb_, int rev_ = 0) { nM = nMl; nN = nN_; nwg = nM * nN; G = 32; c = vr_; vx = -2; pb = pb_; rev = rev_; }
    __device__ __forceinline__ bool mn(int i, int& pm, int& pn) const {
        const long L = (long)i * G + c; if (L >= nwg) return false;
        int wgid = (int)L; if (vx == -1) { const int q = nwg / 8, r = nwg % 8, xcd = wgid % 8, off = wgid / 8; wgid = (xcd < r ? xcd * (q + 1) : r * (q + 1) + (xcd - r) * q) + off; }
        const int nig = 8 * nN, gid = wgid / nig, fm = gid * 8, gsz = (nM - fm) < 8 ? (nM - fm) : 8;
        pm = fm + ((wgid % nig) % gsz); pn = (wgid % nig) / gsz;
        if (rev) pm = nM - 1 - pm;
        if (vx >= 0) pm = pm < 16 ? 16 * vx + pm : 128 + 2 * vx + (pm - 16); else if (vx == -2) pm += pb;
        return true;
    }
};
__device__ __forceinline__ unsigned cvt_pk_bf16(float lo, float hi) { unsigned r; asm volatile("v_cvt_pk_bf16_f32 %0, %1, %2" : "=v"(r) : "v"(lo), "v"(hi)); return r; }

typedef int i32x4 __attribute__((ext_vector_type(4)));
template <class Epi, class Sched, bool GATHER, bool F8 = false>
__device__ __forceinline__ void gemm_phase(LAS unsigned char* lds, const Gemm g, const Sched& S, const Epi& E) {
    const int tid = otid(), wid = __builtin_amdgcn_readfirstlane(tid >> 6), lane = tid & 63, wr = wid >> 2, wc = wid & 3, fr = lane & 15, fq = lane >> 4;
    const int K = g.K, nt = K / BK;
    int Rl[2]; unsigned Cb[2], voffB[2];
#pragma unroll
    for (int i = 0; i < 2; ++i) { int R, Cc; stage_rc(tid * 16 + i * 8192, R, Cc); const int Rb = (R & ~31) + perm32(R & 31); Rl[i] = R; Cb[i] = (unsigned)Cc * 2u; voffB[i] = (unsigned)(Rb * K + Cc) * 2u; }
    const size_t kstep = (size_t)(BK * 2), hstep = (size_t)HALF * K * 2, tstep = 2 * hstep;
    const unsigned ldsw = (unsigned)wid * 1024u;
    const int aoff0 = lds_byte(wr * 64 + fr, fq * 8), aoff1 = lds_byte(wr * 64 + fr, 32 + fq * 8), boff0 = lds_byte(wc * 32 + fr, fq * 8), boff1 = lds_byte(wc * 32 + fr, 32 + fq * 8);
#define PG8_SA(b, h) (((b) * 2 + (h)) * HTB)
#define PG8_SB(b, h) ((4 + (b) * 2 + (h)) * HTB)
#define PG8_STAGE(bufoff, gbase, voff) do { _Pragma("unroll") for (int _i = 0; _i < 2; ++_i) \
        __builtin_amdgcn_global_load_lds((const unsigned*)((const char*)(gbase) + (voff)[_i]), (LAS unsigned*)(lds + (bufoff) + ldsw + _i * 8192), 16, 0, 0); } while (0)
#define PG8_LDA(dst, b, h) do { _Pragma("unroll") for (int m = 0; m < 4; ++m) { dst[m][0] = *(const LAS bf16x8*)(lds + PG8_SA(b, h) + aoff0 + m * 2048); dst[m][1] = *(const LAS bf16x8*)(lds + PG8_SA(b, h) + aoff1 + m * 2048); } } while (0)
#define PG8_LDB(dst, b, h) do { _Pragma("unroll") for (int n = 0; n < 2; ++n) { dst[n][0] = *(const LAS bf16x8*)(lds + PG8_SB(b, h) + boff0 + n * 2048); dst[n][1] = *(const LAS bf16x8*)(lds + PG8_SB(b, h) + boff1 + n * 2048); } } while (0)
#define PG8_MMA(ai, bj, At, Bt) do { __builtin_amdgcn_s_setprio(1); _Pragma("unroll") for (int m = 0; m < 4; ++m) _Pragma("unroll") for (int n = 0; n < 2; ++n) { \
        if (F8) { const i32x4 b0_ = __builtin_bit_cast(i32x4, Bt[n][0]), b1_ = __builtin_bit_cast(i32x4, Bt[n][1]), a0_ = __builtin_bit_cast(i32x4, At[m][0]), a1_ = __builtin_bit_cast(i32x4, At[m][1]); \
            acc[ai][bj][m][n] = __builtin_amdgcn_mfma_scale_f32_16x16x128_f8f6f4(__builtin_shufflevector(b0_, b1_, 0, 1, 2, 3, 4, 5, 6, 7), __builtin_shufflevector(a0_, a1_, 0, 1, 2, 3, 4, 5, 6, 7), acc[ai][bj][m][n], 0, 0, 0, 0x7F7F7F7F, 0, 0x7F7F7F7F); } \
        else { _Pragma("unroll") for (int k = 0; k < 2; ++k) acc[ai][bj][m][n] = __builtin_amdgcn_mfma_f32_16x16x32_bf16(Bt[n][k], At[m][k], acc[ai][bj][m][n], 0, 0, 0); } } __builtin_amdgcn_s_setprio(0); } while (0)
#define PG8_WAIT_V(n) asm volatile("s_waitcnt vmcnt(" #n ")" ::: "memory")
#define PG8_WAIT_L(n) asm volatile("s_waitcnt lgkmcnt(" #n ")" ::: "memory")
#define PG8_WAIT_VF() do { (void)fresh; PG8_WAIT_V(8); } while (0)
#define PG8_BAR __builtin_amdgcn_s_barrier()
#define PG8_SCHED __builtin_amdgcn_sched_barrier(0)
#define PG8_AOFF(dst, u) do { _Pragma("unroll") for (int _h = 0; _h < 2; ++_h) _Pragma("unroll") for (int _i = 0; _i < 2; ++_i) { \
        const int _r = (u).ap * BM + _h * HALF + Rl[_i]; const unsigned _row = GATHER ? (unsigned)g.rowmap[_r] : (unsigned)_r; dst[_h][_i] = _row * (unsigned)(g.lda * 2) + Cb[_i] + (unsigned)(u).akb; } } while (0)
    Unit cur, nxt; int ui = 0;
    if (!S.next(0, cur)) return;
    f32x4 acc[2][2][4][2];
#pragma unroll
    for (int a = 0; a < 2; ++a)
#pragma unroll
        for (int b = 0; b < 2; ++b)
#pragma unroll
            for (int m = 0; m < 4; ++m)
#pragma unroll
                for (int n = 0; n < 2; ++n) acc[a][b][m][n] = (f32x4){0.f, 0.f, 0.f, 0.f};
    bf16x8 At[4][2], B0[2][2], B1[2][2];
    unsigned ao[2][2], nao[2][2]; bool fresh = false;
    PG8_AOFF(ao, cur);
    const char* Ab = (const char*)g.A;
    const char* cB = (const char*)g.Bt + (size_t)cur.bp * tstep;
    PG8_STAGE(PG8_SB(0, 0), cB, voffB); PG8_STAGE(PG8_SB(0, 1), cB + hstep, voffB); PG8_STAGE(PG8_SA(0, 0), Ab, ao[0]); PG8_STAGE(PG8_SA(0, 1), Ab, ao[1]);
    if (wr == 1) PG8_BAR;
    PG8_WAIT_V(2); PG8_BAR;
    PG8_STAGE(PG8_SB(1, 0), cB + kstep, voffB); PG8_STAGE(PG8_SA(1, 0), Ab + kstep, ao[0]); PG8_STAGE(PG8_SB(1, 1), cB + hstep + kstep, voffB);
    PG8_WAIT_V(6); PG8_BAR;
    for (;;) {
        const bool has_next = S.next(ui + 1, nxt);
        if (has_next) { PG8_AOFF(nao, nxt); }
        else {
#pragma unroll
            for (int _h = 0; _h < 2; ++_h)
#pragma unroll
                for (int _i = 0; _i < 2; ++_i) nao[_h][_i] = ao[_h][_i]; }
        const char* nB = has_next ? (const char*)g.Bt + (size_t)nxt.bp * tstep : cB;
#pragma unroll 1
        for (int t = 0; t < nt; t += 2) {
            const bool last = (t == nt - 2);
            const char* a1 = Ab + (size_t)(t + 1) * kstep;
            const char* a2 = last ? Ab : Ab + (size_t)(t + 2) * kstep; const char* b2 = last ? nB : cB + (size_t)(t + 2) * kstep;
            const char* a3 = a2 + kstep; const char* b3 = b2 + kstep;
            PG8_LDB(B0, 0, 0); PG8_LDB(B1, 0, 1); PG8_SCHED; PG8_LDA(At, 0, 0); PG8_STAGE(PG8_SA(1, 1), a1, ao[1]);
            if (last) {
#pragma unroll
                for (int _h = 0; _h < 2; ++_h)
#pragma unroll
                    for (int _i = 0; _i < 2; ++_i) ao[_h][_i] = nao[_h][_i]; }
            PG8_WAIT_VF(); PG8_WAIT_L(0); PG8_BAR; PG8_MMA(0, 0, At, B0); PG8_MMA(0, 1, At, B1); PG8_BAR; PG8_SCHED;
            PG8_LDA(At, 0, 1); PG8_STAGE(PG8_SB(0, 0), b2, voffB); PG8_STAGE(PG8_SB(0, 1), b2 + hstep, voffB); PG8_STAGE(PG8_SA(0, 0), a2, ao[0]);
            PG8_WAIT_VF(); PG8_WAIT_L(0); PG8_BAR; PG8_MMA(1, 0, At, B0); PG8_MMA(1, 1, At, B1); PG8_BAR; PG8_SCHED;
            fresh = false;
            PG8_LDB(B0, 1, 0); PG8_LDB(B1, 1, 1); PG8_SCHED; PG8_LDA(At, 1, 0); PG8_STAGE(PG8_SA(0, 1), a2, ao[1]);
            PG8_WAIT_V(8); PG8_WAIT_L(0); PG8_BAR; PG8_MMA(0, 0, At, B0); PG8_MMA(0, 1, At, B1); PG8_BAR; PG8_SCHED;
            PG8_LDA(At, 1, 1); PG8_STAGE(PG8_SB(1, 0), b3, voffB); PG8_STAGE(PG8_SB(1, 1), b3 + hstep, voffB); PG8_STAGE(PG8_SA(1, 0), a3, ao[0]);
            PG8_WAIT_V(8); PG8_WAIT_L(0); PG8_BAR; PG8_MMA(1, 0, At, B0); PG8_MMA(1, 1, At, B1); PG8_BAR; PG8_SCHED;
        }
        if (wr == 0) PG8_BAR;
        E(acc, cur, wr, wc, fr, fq);
        if (PROBE == 12) { asm volatile("" ::: "memory"); E(acc, cur, wr, wc, fr, fq); }
        if (!has_next) break;
#pragma unroll
        for (int a = 0; a < 2; ++a)
#pragma unroll
            for (int b = 0; b < 2; ++b)
#pragma unroll
                for (int m = 0; m < 4; ++m)
#pragma unroll
                    for (int n = 0; n < 2; ++n) acc[a][b][m][n] = (f32x4){0.f, 0.f, 0.f, 0.f};
        cur = nxt; cB = nB; ++ui; fresh = true;
        if (wr == 1) PG8_BAR;
    }
    PG8_WAIT_V(0);
    PG8_BAR;
#undef PG8_SA
#undef PG8_SB
#undef PG8_STAGE
#undef PG8_LDA
#undef PG8_LDB
#undef PG8_MMA
#undef PG8_WAIT_V
#undef PG8_WAIT_L
#undef PG8_WAIT_VF
#undef PG8_BAR
#undef PG8_SCHED
#undef PG8_AOFF
}
struct EpiAct {
    static constexpr int NVM = 16;
    bf16* O; int ldo; int mode; const float* bgk;
    __device__ __forceinline__ void operator()(const f32x4 (&acc)[2][2][4][2], const Unit& u, int wr, int wc, int fr, int fq) const {
#pragma unroll
        for (int ai = 0; ai < 2; ++ai)
#pragma unroll
            for (int m = 0; m < 4; ++m) { bf16* rowp = O + (size_t)(u.orow + ai * HALF + wr * 64 + m * 16 + fr) * ldo + u.ocol + wc * 32 + 8 * fq;
#pragma unroll
                for (int bj = 0; bj < 2; ++bj) { const int col = u.ocol + bj * HALF + wc * 32 + 8 * fq;
                    const f32x4 v0 = epi_apply(acc[ai][bj][m][0], mode, col, bgk), v1 = epi_apply(acc[ai][bj][m][1], mode, col + 4, bgk);
                    u32x4 w; w.x = cvt_pk_bf16(v0[0], v0[1]); w.y = cvt_pk_bf16(v0[2], v0[3]); w.z = cvt_pk_bf16(v1[0], v1[1]); w.w = cvt_pk_bf16(v1[2], v1[3]);
                    *(u32x4*)(rowp + bj * HALF) = w; } }
    }
};
__device__ __forceinline__ size_t p_index(size_t row, int i, int c) { return row * 4096 + (size_t)((c >> 6) * 256 + ((c >> 5) & 1) * 128 + i * 32 + (c & 31)); }
struct EpiP {
    static constexpr int NVM = 16;
    bf16* O;
    __device__ __forceinline__ void operator()(const f32x4 (&acc)[2][2][4][2], const Unit& u, int wr, int wc, int fr, int fq) const {
        const int i = u.ocol >> 10, c0 = (u.ocol & 1023) + wc * 32 + 8 * fq;
#pragma unroll
        for (int ai = 0; ai < 2; ++ai)
#pragma unroll
            for (int m = 0; m < 4; ++m) { const size_t row = (size_t)(u.orow + ai * HALF + wr * 64 + m * 16 + fr);
#pragma unroll
                for (int bj = 0; bj < 2; ++bj) { const f32x4 v0 = acc[ai][bj][m][0], v1 = acc[ai][bj][m][1];
                    u32x4 w; w.x = cvt_pk_bf16(v0[0], v0[1]); w.y = cvt_pk_bf16(v0[2], v0[3]); w.z = cvt_pk_bf16(v1[0], v1[1]); w.w = cvt_pk_bf16(v1[2], v1[3]);
                    *(u32x4*)(O + p_index(row, i, c0 + bj * HALF)) = w; } }
    }
};
struct EpiCols {
    static constexpr int NVM = 16;
    bf16* O;
    __device__ __forceinline__ void operator()(const f32x4 (&acc)[2][2][4][2], const Unit& u, int wr, int wc, int fr, int fq) const {
        const int tile = __builtin_amdgcn_readfirstlane(u.ocol >> 8);
        f32x4 bv[2][2];
        if (tile == 3) {
#pragma unroll
            for (int bj = 0; bj < 2; ++bj)
#pragma unroll
                for (int n = 0; n < 2; ++n) bv[bj][n] = *(const LAS f32x4*)((LAS unsigned char*)131072 + (bj * HALF + wc * 32 + 8 * fq + 4 * n) * 4);
        }
#pragma unroll
        for (int ai = 0; ai < 2; ++ai)
#pragma unroll
            for (int m = 0; m < 4; ++m) { bf16* rowp = O + (size_t)(u.orow + ai * HALF + wr * 64 + m * 16 + fr) * NINP + u.ocol + wc * 32 + 8 * fq;
#pragma unroll
                for (int bj = 0; bj < 2; ++bj) { f32x4 v0 = acc[ai][bj][m][0], v1 = acc[ai][bj][m][1];
                    if (tile == 0) { if (bj == 0) { v0 = v0 * 0.17677669529663689f; v1 = v1 * 0.17677669529663689f; } }
                    else if (tile == 2) {
#pragma unroll
                        for (int j = 0; j < 4; ++j) { v0[j] = siluf_(v0[j]); v1[j] = siluf_(v1[j]); } }
                    else if (tile == 3) {
#pragma unroll
                        for (int j = 0; j < 4; ++j) { v0[j] = logsigmoidf_(v0[j] + bv[bj][0][j]) * 0.0625f; v1[j] = logsigmoidf_(v1[j] + bv[bj][1][j]) * 0.0625f; } }
                    else if (tile >= 6) {
#pragma unroll
                        for (int j = 0; j < 4; ++j) { v0[j] = gelu_tanh_(v0[j]); v1[j] = gelu_tanh_(v1[j]); } }
                    u32x4 w; w.x = cvt_pk_bf16(v0[0], v0[1]); w.y = cvt_pk_bf16(v0[2], v0[3]); w.z = cvt_pk_bf16(v1[0], v1[1]); w.w = cvt_pk_bf16(v1[2], v1[3]);
                    *(u32x4*)(rowp + bj * HALF) = w; } }
    }
};
struct EpiGateMix {
    static constexpr int NVM = 8;
    const bf16* P; bf16* MMo; float gs;
    __device__ __forceinline__ void operator()(const f32x4 (&acc)[2][2][4][2], const Unit& u, int wr, int wc, int fr, int fq) const {
        const int col = (u.ocol >> 2) + wc * 16 + 4 * fq;
#pragma unroll
        for (int ai = 0; ai < 2; ++ai) {
            u32x2 pw[4][4];
#pragma unroll
            for (int m = 0; m < 4; ++m) { const size_t row = (size_t)(u.orow + ai * HALF + wr * 64 + m * 16 + fr);
#pragma unroll
                for (int i = 0; i < 4; ++i) pw[m][i] = *(const u32x2*)(P + p_index(row, i, col)); }
#pragma unroll
            for (int m = 0; m < 4; ++m) { const size_t row = (size_t)(u.orow + ai * HALF + wr * 64 + m * 16 + fr);
                f32x2 s01 = (f32x2){0.f, 0.f}, s23 = s01; const float kc = -1.4426950408889634f * gs;
#pragma unroll
                for (int i = 0; i < 4; ++i) { const f32x4 g = acc[ai][i >> 1][m][i & 1];
                    f32x2 d01 = (f32x2){__builtin_amdgcn_exp2f(g[0] * kc), __builtin_amdgcn_exp2f(g[1] * kc)}, d23 = (f32x2){__builtin_amdgcn_exp2f(g[2] * kc), __builtin_amdgcn_exp2f(g[3] * kc)};
                    d01 = d01 + 1.0f; d23 = d23 + 1.0f;
                    const f32x2 r01 = (f32x2){__builtin_amdgcn_rcpf(d01[0]), __builtin_amdgcn_rcpf(d01[1])}, r23 = (f32x2){__builtin_amdgcn_rcpf(d23[0]), __builtin_amdgcn_rcpf(d23[1])};
                    const f32x2 p01 = (f32x2){bflo(pw[m][i].x), bfhi(pw[m][i].x)}, p23 = (f32x2){bflo(pw[m][i].y), bfhi(pw[m][i].y)};
                    s01 = r01 * p01 + s01; s23 = r23 * p23 + s23; }
                f32x4 s; s[0] = s01[0]; s[1] = s01[1]; s[2] = s23[0]; s[3] = s23[1];
                u32x2 w; w.x = cvt_pk_bf16(s[0], s[1]); w.y = cvt_pk_bf16(s[2], s[3]);
                *(u32x2*)(MMo + row * D + col) = w; } }
    }
};
struct EpiSwiGLU {
    static constexpr int NVM = 8;
    bf16* O; int ldo; float gs; float o8;
    __device__ __forceinline__ void operator()(const f32x4 (&acc)[2][2][4][2], const Unit& u, int wr, int wc, int fr, int fq) const {
#pragma unroll
        for (int ai = 0; ai < 2; ++ai)
#pragma unroll
            for (int m = 0; m < 4; ++m) { bf16* rowp = O + (size_t)(u.orow + ai * HALF + wr * 64 + m * 16 + fr) * ldo + u.ocol + wc * 32 + 8 * fq;
                f32x4 v0, v1;
                { const float kc = -1.4426950408889634f * gs, g2 = gs * gs * (o8 > 0.f ? o8 : 1.0f);
                  const f32x4 ga = acc[ai][0][m][0], gb = acc[ai][0][m][1], ua = acc[ai][1][m][0], ub = acc[ai][1][m][1];
                  f32x4 da, db;
#pragma unroll
                  for (int j = 0; j < 4; ++j) { da[j] = __builtin_amdgcn_exp2f(ga[j] * kc); db[j] = __builtin_amdgcn_exp2f(gb[j] * kc); }
                  da = da + 1.0f; db = db + 1.0f;
#pragma unroll
                  for (int j = 0; j < 4; ++j) { da[j] = __builtin_amdgcn_rcpf(da[j]); db[j] = __builtin_amdgcn_rcpf(db[j]); }
                  v0 = (ga * ua) * (da * g2); v1 = (gb * ub) * (db * g2); }
                if (o8 > 0.f) { u32x2 w; w.x = pk4_fp8(v0[0], v0[1], v0[2], v0[3]); w.y = pk4_fp8(v1[0], v1[1], v1[2], v1[3]);
                    *(u32x2*)((unsigned char*)O + (size_t)(u.orow + ai * HALF + wr * 64 + m * 16 + fr) * ldo + u.ocol + wc * 32 + 8 * fq) = w; }
                else { u32x4 w; w.x = cvt_pk_bf16(v0[0], v0[1]); w.y = cvt_pk_bf16(v0[2], v0[3]); w.z = cvt_pk_bf16(v1[0], v1[1]); w.w = cvt_pk_bf16(v1[2], v1[3]);
                    *(u32x4*)rowp = w; } }
    }
};
struct EpiScale {
    static constexpr int NVM = 16;
    bf16* O; int ldo; float gs;
    __device__ __forceinline__ void operator()(const f32x4 (&acc)[2][2][4][2], const Unit& u, int wr, int wc, int fr, int fq) const {
#pragma unroll
        for (int ai = 0; ai < 2; ++ai)
#pragma unroll
            for (int m = 0; m < 4; ++m) { bf16* rowp = O + (size_t)(u.orow + ai * HALF + wr * 64 + m * 16 + fr) * ldo + u.ocol + wc * 32 + 8 * fq;
#pragma unroll
                for (int bj = 0; bj < 2; ++bj) { const f32x4 v0 = acc[ai][bj][m][0] * gs, v1 = acc[ai][bj][m][1] * gs;
                    u32x4 w; w.x = cvt_pk_bf16(v0[0], v0[1]); w.y = cvt_pk_bf16(v0[2], v0[3]); w.z = cvt_pk_bf16(v1[0], v1[1]); w.w = cvt_pk_bf16(v1[2], v1[3]);
                    *(u32x4*)(rowp + bj * HALF) = w; } }
    }
};
template <int KIND> struct Sched {
    GridOrder go; int bp0, p0; const int* pe;
    __device__ __forceinline__ bool next(int i, Unit& u) const {
        int pm, pn; if (!go.mn(i, pm, pn)) return false;
        u.akb = 0;
        if (KIND == 0) { u.ap = pm; u.bp = bp0 + pn; u.orow = pm * BM; u.ocol = pn * BM; }
        else if (KIND == 4) { const int i = pn & 3, cp = pn >> 2; u.ap = pm; u.bp = i * 4 + cp; u.orow = pm * BM; u.ocol = i * 1024 + cp * BM; u.akb = i * 512; }
        else if (KIND == 1) { u.ap = pm; u.bp = pn; u.orow = pn * 2048 + pm * BM; u.ocol = 512; }
        else if (KIND == 2) { const int e = pe ? pe[p0 + pm] : 0; u.ap = p0 + pm; u.bp = e * 44 + pn; u.orow = pm * BM; u.ocol = pn * HALF; }
        else { const int e = pe ? pe[p0 + pm] : 0; u.ap = pm; u.bp = e * bp0 + pn; u.orow = (p0 + pm) * BM; u.ocol = pn * BM; }
        return true;
    }
};
}

__device__ __forceinline__ int gate_row(int i, int cc) { return 256 * (cc >> 6) + 128 * (i >> 1) + 32 * ((cc >> 4) & 3) + 8 * ((cc >> 2) & 3) + 4 * (i & 1) + (cc & 3); }
__device__ __forceinline__ void xpose_item(const float* W, int ldw, int k0, int n0, bf16* WT, int ldk, int drow0, LAS float* scr, int lane, int gate_i = -1) {
#pragma unroll 8
    for (int i = 0; i < 32; ++i) { const int kk = 2 * i + (lane >> 5); scr[kk * 33 + (lane & 31)] = W[(size_t)(k0 + kk) * ldw + n0 + (lane & 31)]; }
    asm volatile("s_waitcnt lgkmcnt(0)" ::: "memory");
    const int c = lane & 7;
#pragma unroll
    for (int j = 0; j < 4; ++j) { const int n = (lane >> 3) + 8 * j; const LAS float* s = scr + (8 * c) * 33 + n;
        u32x4 o; o.x = pk2(s[0 * 33], s[1 * 33]); o.y = pk2(s[2 * 33], s[3 * 33]); o.z = pk2(s[4 * 33], s[5 * 33]); o.w = pk2(s[6 * 33], s[7 * 33]);
        const int drow = gate_i < 0 ? drow0 + n : drow0 + gate_row(gate_i, n0 + n);
        *(u32x4*)(WT + (size_t)drow * ldk + k0 + 8 * c) = o; }
    asm volatile("s_waitcnt lgkmcnt(0)" ::: "memory");
}
__device__ __forceinline__ void xpose_item_fp8(const float* W, int ldw, int k0, int n0, unsigned char* WT, int ldk, LAS float* scr, int lane, int gate_i, float scale, int drow0 = 0) {
#pragma unroll 8
    for (int i = 0; i < 32; ++i) { const int kk = 2 * i + (lane >> 5); scr[kk * 33 + (lane & 31)] = W[(size_t)(k0 + kk) * ldw + n0 + (lane & 31)]; }
    asm volatile("s_waitcnt lgkmcnt(0)" ::: "memory");
    const int c = lane & 7;
#pragma unroll
    for (int j = 0; j < 4; ++j) { const int n = (lane >> 3) + 8 * j; const LAS float* s = scr + (8 * c) * 33 + n;
        u32x2 o; o.x = pk4_fp8(s[0 * 33] * scale, s[1 * 33] * scale, s[2 * 33] * scale, s[3 * 33] * scale); o.y = pk4_fp8(s[4 * 33] * scale, s[5 * 33] * scale, s[6 * 33] * scale, s[7 * 33] * scale);
        const int drow = gate_i < 0 ? drow0 + n : gate_row(gate_i, n0 + n);
        *(u32x2*)(WT + (size_t)drow * ldk + k0 + 8 * c) = o; }
    asm volatile("s_waitcnt lgkmcnt(0)" ::: "memory");
}
__device__ __forceinline__ void xpose_dispatch(const Ctx& C, int it, LAS float* scr) {
    const float* const* in = oin(C.in_); const int lane = otid() & 63;
    if (it < 4 * 768) { const int l = it / 768, r = it % 768, part = r / 384, q = r % 384, kb = q / 24, nb = q % 24;
        const int n0 = (part ? 1056 : 0) + nb * 32, drow = (part ? 1280 : 0) + nb * 32;
        xpose_item(in[6] + (size_t)l * D * NIN, NIN, kb * 64, n0, wW(C, WE_WIN + (size_t)l * 6144 * 1024), 1024, drow, scr, lane); return; }
    it -= 4 * 768;
    if (it < 16 * 512) { const int li = it / 512, q = it % 512, kb = q / 32, nb = q % 32, l = li >> 2, i = li & 3;
        xpose_item_fp8(in[16] + (size_t)li * D * D, D, kb * 64, nb * 32, ows(C.ws_) + WS_G8 + (size_t)l * 4096 * 1024, 1024, scr, lane, i, G8_SCALE); return; }
    it -= 16 * 512;
    if (it < 16 * 128) { const int li = it / 128, q = it % 128, kb = q / 32, nb = q % 32;
        xpose_item(in[17] + (size_t)li * 256 * D, D, kb * 64, nb * 32, wW(C, WE_WBR + (size_t)li * 1024 * 256), 256, nb * 32, scr, lane); return; }
    it -= 16 * 128;
    if (it < 4 * 512) { const int l = it / 512, q = it % 512, kb = q / 32, nb = q % 32;
        xpose_item(in[18] + (size_t)l * D * D, D, kb * 64, nb * 32, wW(C, WE_WO + (size_t)l * D * D), 1024, nb * 32, scr, lane); return; }
    it -= 4 * 512;
    if (it < 4 * 1408) { const int jw = it / 1408, q = it % 1408, kb = q / 88, nb = q % 88, j = jw >> 1, which = jw & 1, n0 = nb * 32;
        xpose_item_fp8(in[which ? 22 : 21] + (size_t)j * D * DFF, DFF, kb * 64, n0, (unsigned char*)wW(C, WE_GUD + (size_t)j * 5632 * 1024), 1024, scr, lane, -1, G8_SCALE, (n0 >> 7) * 256 + which * 128 + (n0 & 127)); return; }
    it -= 4 * 1408;
    if (it < 2 * 1408) { const int j = it / 1408, q = it % 1408, kb = q / 32, nb = q % 32;
        if (DOWN8_DENSE) xpose_item_fp8(in[23] + (size_t)j * DFF * D, D, kb * 64, nb * 32, (unsigned char*)wW(C, WE_DD + (size_t)j * 1024 * 2816), 2816, scr, lane, -1, G8_SCALE, nb * 32);
        else xpose_item(in[23] + (size_t)j * DFF * D, D, kb * 64, nb * 32, wW(C, WE_DD + (size_t)j * 1024 * 2816), 2816, nb * 32, scr, lane); return; }
    it -= 2 * 1408;
    (void)it;
}
constexpr int XPE_GU = 16 * 1408, XPE_ALL = 24 * 1408;
constexpr bool DEFER_EXPERT_CONV = false;
__device__ __forceinline__ void xpose_expert(const Ctx& C, int jm, int idx, LAS float* scr, int lane) {
    const float* const* in = oin(C.in_);
    if (idx < XPE_GU) { const int ew = idx / 1408, q = idx % 1408, kb = q / 88, nb = q % 88, e = ew >> 1, which = ew & 1, n0 = nb * 32, je = jm * 8 + e;
        xpose_item_fp8(in[which ? 26 : 25] + (size_t)je * D * DFF, DFF, kb * 64, n0, (unsigned char*)wW(C, WE_GUE + (size_t)je * 5632 * 1024), 1024, scr, lane, -1, G8_SCALE, (n0 >> 7) * 256 + which * 128 + (n0 & 127)); }
    else { const int i2 = idx - XPE_GU, e = i2 / 1408, q = i2 % 1408, kb = q / 32, nb = q % 32, je = jm * 8 + e;
        if (DOWN8_MOE) xpose_item_fp8(in[27] + (size_t)je * DFF * D, D, kb * 64, nb * 32, (unsigned char*)wW(C, WE_DE + (size_t)je * 1024 * 2816), 2816, scr, lane, -1, G8_SCALE, nb * 32);
        else xpose_item(in[27] + (size_t)je * DFF * D, D, kb * 64, nb * 32, wW(C, WE_DE + (size_t)je * 1024 * 2816), 2816, nb * 32, scr, lane); }
}
__device__ __forceinline__ void expert_convert_share(const Ctx& C, int jm, int i0, int i1, int first_blk) {
    const int blk = oblk(); if (blk < first_blk) return;
    const int wave = owave(), lane = otid() & 63; LAS float* scr = (LAS float*)(C.lds + wave * 16384);
    const int nw = (ogrid() - first_blk) * NWAVE;
    for (int idx = i0 + (blk - first_blk) * NWAVE + wave; idx < i1; idx += nw) xpose_expert(C, jm, idx, scr, lane);
}
constexpr int XPOSE_ITEMS = 4 * 768 + 16 * 512 + 16 * 128 + 4 * 512 + 4 * 1408 + 2 * 1408;

__device__ __forceinline__ void p_prologue(const Ctx& C) {
    const float* const* in = oin(C.in_); const int tid = otid();
    { LAS float* scr = (LAS float*)(C.lds + owave() * 16384);
      const int gw = oblk() * NWAVE + owave(), NGW = ogrid() * NWAVE;
      for (int it = gw; it < XPOSE_ITEMS; it += NGW) xpose_dispatch(C, it, scr);
      if (!DEFER_EXPERT_CONV) for (int it = gw; it < 2 * XPE_ALL; it += NGW) xpose_expert(C, it / XPE_ALL, it % XPE_ALL, scr, otid() & 63); }
    { const size_t gt = (size_t)oblk() * NTHR + tid, NT = (size_t)ogrid() * NTHR;
      for (size_t o = gt; o < (size_t)4 * 512 * 1024; o += NT) {
          const int l = (int)(o >> 19), n = (int)((o >> 10) & 511), k = (int)(o & 1023);
          const float* wi = in[6] + ((size_t)l * D + k) * NIN; float s = 0.f;
          if (n < 256) { const int dir = n >> 7, nn = n & 127; const float* w2 = in[7] + ((size_t)(l * 2 + dir) * 16) * 128 + nn;
              for (int c = 0; c < 16; ++c) s += wi[768 + 16 * dir + c] * w2[c * 128]; }
          else { const int nn = n - 256, gi = nn >> 6, d = nn & 63; const float* pw = in[10] + ((size_t)(l * 4 + gi) * 64) * 64 + d;
              for (int c = 0; c < 64; ++c) s += wi[800 + 64 * gi + c] * pw[c * 64]; }
          wW(C, WE_WIN + (size_t)l * 6144 * 1024)[(size_t)(768 + n) * 1024 + k] = (bf16)f2bf(s);
      } }
    { const size_t gt = (size_t)oblk() * NTHR + tid, NT = (size_t)ogrid() * NTHR;
      { int* idt = (int*)(ows(C.ws_) + WS_ROUTE) + RT_IDT; for (size_t o = gt; o < (size_t)M; o += NT) idt[o] = (int)o; }
      { bf16* sw = wsb(C, WS_SGUW); const float* src = in[14]; for (size_t o = gt; o < (size_t)4 * 4 * 128 * 128; o += NT) sw[o] = (bf16)f2bf(src[o]); }
      { bf16* TF1 = wsb(C, WS_TF1); bf16* TF2 = wsb(C, WS_TF2); float* TW = (float*)(ows(C.ws_) + WS_TW); const float sc = 0.0027621358640099515f;
        for (size_t o = gt; o < (size_t)4 * 2 * 64 * 8; o += NT) { const int x = (int)(o & 7), lane = (int)((o >> 3) & 63), ks = (int)((o >> 9) & 1), ct = (int)(o >> 10), lr = lane & 15, lq = lane >> 4;
            const int po = ct >> 1, c = 16 * (ct & 1) + lr, a = 8 * lq + x; float sn, cs; sincospif((float)((c * a) & 31) * (1.0f / 16.0f), &sn, &cs);
            const float v = po == 0 ? (ks == 0 ? cs : sn) : (ks == 0 ? -sn : cs); TF1[o] = (bf16)f2bf(v); }
        for (size_t o = gt; o < (size_t)2 * 4 * 2 * 64 * 8; o += NT) { const int x = (int)(o & 7), lane = (int)((o >> 3) & 63), ks = (int)((o >> 9) & 1), dt = (int)((o >> 10) & 3), part = (int)(o >> 12), lr = lane & 15, lq = lane >> 4;
            const int d = 16 * dt + lr, bb = 32 * ks + (x < 4 ? 4 * lq + x : 16 + 4 * lq + (x - 4)); float sn, cs; sincospif((float)((d * bb) & 63) * (1.0f / 32.0f), &sn, &cs);
            TF2[o] = (bf16)f2bf((part == 0 ? cs : sn) * sc); }
        for (size_t o = gt; o < (size_t)4 * 2 * 4 * 64; o += NT) { const int lane = (int)(o & 63), r = (int)((o >> 6) & 3), ct = (int)((o >> 8) & 1), rt = (int)(o >> 9), lr = lane & 15, lq = lane >> 4;
            const int bb = 16 * rt + 4 * lq + r, c = 16 * ct + lr; float sn, cs; sincospif((float)(c * bb) * (1.0f / 1024.0f), &sn, &cs); TW[2 * o] = cs; TW[2 * o + 1] = sn; } }
      bf16* DLC = wsb(C, WS_DLC);
      for (size_t o = gt; o < (size_t)256 * 512; o += NT) { const int k = (int)(o >> 9), kk = (int)(o & 511), t = kk & 255; const int idx = (k * t) & 255; float sn, cs; sincospif((float)idx * (1.0f / 128.0f), &sn, &cs);
          DLC[o] = (bf16)f2bf((kk < 256 ? cs : sn) * 0.0078125f); }
      bf16* CS = wsb(C, WS_CS64);
      for (size_t o = gt; o < (size_t)128 * 64; o += NT) { const int pm = (int)(o >> 6), c = (int)(o & 63), m = pm & 63; const int idx = (m * c) & 63; float sn, cs; sincospif((float)idx * (1.0f / 32.0f), &sn, &cs);
          CS[o] = (bf16)f2bf(pm < 64 ? cs : -sn); } }
    __syncthreads();
    { LAS float* S = (LAS float*)C.lds;
      LAS float* RED = (LAS float*)(C.lds + 17 * 1024 * 4);
      for (int i = tid; i < 17 * 1024; i += NTHR) { const int r = i >> 10, k = i & 1023; const float v = r < 16 ? in[1][r * 1024 + k] : in[3][k]; S[i] = siluf_(v); }
      __syncthreads();
      for (int it = oblk(); it < 4 * 96; it += ogrid()) {
          const int l = it / 96, jb = it % 96, j = tid & 63, kg = tid >> 6;
          float acc[17];
#pragma unroll
          for (int r = 0; r < 17; ++r) acc[r] = 0.f;
          const float* wp = in[4] + ((size_t)l * D + kg * 128) * 6144 + jb * 64 + j;
          for (int kk = 0; kk < 128; ++kk) { const float w = wp[(size_t)kk * 6144];
#pragma unroll
              for (int r = 0; r < 17; ++r) acc[r] += S[r * 1024 + kg * 128 + kk] * w; }
#pragma unroll
          for (int r = 0; r < 17; ++r) RED[(kg * 17 + r) * 64 + j] = acc[r];
          __syncthreads();
          for (int o = tid; o < 17 * 64; o += NTHR) { const int r = o >> 6, jj = o & 63; float s = 0.f;
              for (int g = 0; g < 8; ++g) s += RED[(g * 17 + r) * 64 + jj];
              ((float*)(ows(C.ws_) + WS_MOD))[(size_t)(l * 17 + r) * 6144 + jb * 64 + jj] = s + in[5][(size_t)l * 6144 + jb * 64 + jj]; }
          __syncthreads();
      } }
}

struct RowV { f32x4 v[4]; };
__device__ __forceinline__ void row_ln(RowV& x, int  ) {
    float s = 0.f;
#pragma unroll
    for (int j = 0; j < 4; ++j) s += (x.v[j][0] + x.v[j][1]) + (x.v[j][2] + x.v[j][3]);
    const float mean = wave_sum(s) * (1.f / D); float q = 0.f;
#pragma unroll
    for (int j = 0; j < 4; ++j) { x.v[j] = x.v[j] - mean; q += (x.v[j][0] * x.v[j][0] + x.v[j][1] * x.v[j][1]) + (x.v[j][2] * x.v[j][2] + x.v[j][3] * x.v[j][3]); }
    const float rstd = __builtin_amdgcn_rsqf(wave_sum(q) * (1.f / D) + EPS);
#pragma unroll
    for (int j = 0; j < 4; ++j) x.v[j] = x.v[j] * rstd;
}
__device__ __forceinline__ void row_load_f32(RowV& x, const float* p, int lane) {
#pragma unroll
    for (int j = 0; j < 4; ++j) x.v[j] = *(const f32x4*)(p + 4 * lane + 256 * j);
}
__device__ __forceinline__ void row_load_bf16(RowV& x, const bf16* p, int lane) {
#pragma unroll
    for (int j = 0; j < 4; ++j) { const u32x2 w = *(const u32x2*)(p + 4 * lane + 256 * j); x.v[j] = (f32x4){bflo(w.x), bfhi(w.x), bflo(w.y), bfhi(w.y)}; }
}
__device__ __forceinline__ void row_store_f32(const RowV& x, float* p, int lane) {
#pragma unroll
    for (int j = 0; j < 4; ++j) *(f32x4*)(p + 4 * lane + 256 * j) = x.v[j];
}
__device__ __forceinline__ void row_store_fp8(const RowV& x, unsigned char* p, int lane) {
#pragma unroll
    for (int j = 0; j < 4; ++j) { int w = 0; w = __builtin_amdgcn_cvt_pk_fp8_f32(x.v[j][0], x.v[j][1], w, false); w = __builtin_amdgcn_cvt_pk_fp8_f32(x.v[j][2], x.v[j][3], w, true); *(int*)(p + 4 * lane + 256 * j) = w; }
}
__device__ __forceinline__ void row_store_bf16(const RowV& x, bf16* p, int lane) {
#pragma unroll
    for (int j = 0; j < 4; ++j) { u32x2 w; w.x = pk2(x.v[j][0], x.v[j][1]); w.y = pk2(x.v[j][2], x.v[j][3]); *(u32x2*)(p + 4 * lane + 256 * j) = w; }
}
__device__ __forceinline__ void row_mod(RowV& x, const float* shift, const float* scale, int lane) {
#pragma unroll
    for (int j = 0; j < 4; ++j) { const f32x4 sh = *(const f32x4*)(shift + 4 * lane + 256 * j), sc = *(const f32x4*)(scale + 4 * lane + 256 * j); x.v[j] = x.v[j] * (sc + 1.0f) + sh; }
}
__device__ __forceinline__ void row_affine(RowV& x, const float* g, const float* b, int lane) {
#pragma unroll
    for (int j = 0; j < 4; ++j) { const f32x4 gg = *(const f32x4*)(g + 4 * lane + 256 * j), bb = *(const f32x4*)(b + 4 * lane + 256 * j); x.v[j] = x.v[j] * gg + bb; }
}
__device__ __forceinline__ void row_mod_v(RowV& x, const RowV& shift, const RowV& scale) {
#pragma unroll
    for (int j = 0; j < 4; ++j) x.v[j] = x.v[j] * (scale.v[j] + 1.0f) + shift.v[j];
}
__device__ __forceinline__ void row_affine_v(RowV& x, const RowV& g, const RowV& b) {
#pragma unroll
    for (int j = 0; j < 4; ++j) x.v[j] = x.v[j] * g.v[j] + b.v[j];
}
__device__ __forceinline__ float* xrow(const Ctx& C, int m) { return m < MLAT ? oout(C.out_) + (size_t)m * D : (float*)(ows(C.ws_) + WS_XC) + (size_t)(m - MLAT) * D; }
__device__ __forceinline__ bf16* hbuf(const Ctx& C) { return XBF16 ? (bf16*)oout(C.out_) : wsb(C, WS_H); }
__device__ __forceinline__ unsigned char* h8buf(const Ctx& C) { return (unsigned char*)oout(C.out_) + OUT_H8; }
__device__ __forceinline__ const float* x0row(const Ctx& C, int m) { return m < MLAT ? oin(C.in_)[0] + (size_t)m * D : oin(C.in_)[2] + (size_t)(m - MLAT) * D; }

typedef _Float16 h16x2 __attribute__((ext_vector_type(2)));
struct XRaw { f32x4 f[4]; u32x2 h[4]; };
__device__ __forceinline__ void xraw_load(XRaw& R, const Ctx& C, int m, int lane, bool from_input) {
    if (from_input || !XBF16) { const float* p = from_input ? x0row(C, m) : xrow(C, m);
#pragma unroll
        for (int j = 0; j < 4; ++j) R.f[j] = *(const f32x4*)(p + 4 * lane + 256 * j); }
    else { const bf16* p = wsb(C, WS_H) + (size_t)m * D;
#pragma unroll
        for (int j = 0; j < 4; ++j) R.h[j] = *(const u32x2*)(p + 4 * lane + 256 * j); }
}
__device__ __forceinline__ void xraw_get(RowV& x, const XRaw& R, bool from_input) {
    if (from_input || !XBF16) {
#pragma unroll
        for (int j = 0; j < 4; ++j) x.v[j] = R.f[j]; }
    else {
#pragma unroll
        for (int j = 0; j < 4; ++j) { const unsigned wx = R.h[j].x, wy = R.h[j].y;
            const h16x2 a = __builtin_bit_cast(h16x2, wx), b = __builtin_bit_cast(h16x2, wy); x.v[j] = (f32x4){(float)a[0], (float)a[1], (float)b[0], (float)b[1]}; } }
}
__device__ __forceinline__ void yraw_load(u32x2 (&y)[4], const bf16* p, int lane) {
#pragma unroll
    for (int j = 0; j < 4; ++j) y[j] = *(const u32x2*)(p + 4 * lane + 256 * j);
}
__device__ __forceinline__ void yraw_get(RowV& y, const u32x2 (&w)[4]) {
#pragma unroll
    for (int j = 0; j < 4; ++j) y.v[j] = (f32x4){bflo(w[j].x), bfhi(w[j].x), bflo(w[j].y), bfhi(w[j].y)};
}
__device__ __forceinline__ void x_store(const RowV& x, const Ctx& C, int m, int lane) {
    if (XBF16) { bf16* p = wsb(C, WS_H) + (size_t)m * D;
#pragma unroll
        for (int j = 0; j < 4; ++j) { h16x2 a, b; a[0] = (_Float16)x.v[j][0]; a[1] = (_Float16)x.v[j][1]; b[0] = (_Float16)x.v[j][2]; b[1] = (_Float16)x.v[j][3];
            u32x2 w; w.x = __builtin_bit_cast(unsigned, a); w.y = __builtin_bit_cast(unsigned, b); *(u32x2*)(p + 4 * lane + 256 * j) = w; } }
    else row_store_f32(x, xrow(C, m), lane);
}
__device__ __forceinline__ void p_lna(const Ctx& C) {
    const int tid = otid(), lane = tid & 63, wave = owave();
    bf16* H = hbuf(C); const int rpb = M / 256; RowV shv, scv; int rcur = -1;
    const int nrow = rpb / NWAVE, jb = (nrow - 1) * 256 + ovr(C) * NWAVE + wave;
    RowV xn; row_load_f32(xn, x0row(C, lrow(C, jb)), lane);
    for (int k = 0; k < nrow; ++k) { const int m = lrow(C, jb - k * 256), r = row_r(m);
        if (r != rcur) { row_load_f32(shv, modv(C, 0, r, 0), lane); row_load_f32(scv, modv(C, 0, r, 1), lane); rcur = r; }
        RowV x = xn; if (k + 1 < nrow) row_load_f32(xn, x0row(C, lrow(C, jb - (k + 1) * 256)), lane);
        row_ln(x, lane); row_mod_v(x, shv, scv);
        row_store_bf16(x, H + (size_t)m * D, lane); row_store_fp8(x, h8buf(C) + (size_t)m * D, lane);
    }
}
__device__ __forceinline__ void p_lnb(const Ctx& C, int l, int mrows, bool dry = false) {
    const int tid = otid(), lane = tid & 63;
    bf16* H = dry ? wsb(C, WS_R + R_BIG + 152 * MiB) : hbuf(C); const bf16* Y = wsb(C, WS_R + R_YS);
    const bool moe = (l & 1); const int jm = l >> 1;
    const int rpb = mrows / 256;
    LAS float* WR = (LAS float*)C.lds;
    LAS int* LC = (LAS int*)(C.lds + 32768);
    int* rt = (int*)(ows(C.ws_) + WS_ROUTE);
    if (moe) {
        for (int i = tid; i < 8 * 1024; i += NTHR) { const int e = i >> 10, k = i & 1023; WR[i] = oin(C.in_)[24][((size_t)jm * D + k) * NE + e]; }
        if (tid < 8) LC[tid] = 0;
        __syncthreads();
    }
    RowV g2v, shv, scv, lgv, lbv; int rcur = -1;
    row_load_f32(lgv, oin(C.in_)[19] + (size_t)(l * 2 + 0) * D, lane); row_load_f32(lbv, oin(C.in_)[20] + (size_t)(l * 2 + 0) * D, lane);
    const int w0 = owave(), nrow = rpb / NWAVE, jb = ovr(C) * NWAVE + w0, mb = lrow(C, jb); const bool fin = (l == 0);
    XRaw xa; u32x2 ya[4];
    xraw_load(xa, C, mb, lane, fin); yraw_load(ya, Y + (size_t)mb * D, lane);
    XRaw xb = xa; u32x2 yb[4] = {ya[0], ya[1], ya[2], ya[3]};
    for (int k = 0; k < nrow; ++k) {
        const int m = lrow(C, jb + k * 256), mn = lrow(C, k + 1 < nrow ? jb + (k + 1) * 256 : jb), r = row_r(m);
        if (k + 1 < nrow) { xraw_load(xb, C, mn, lane, fin); yraw_load(yb, Y + (size_t)mn * D, lane); }
        if (r != rcur) { row_load_f32(g2v, modv(C, l, r, 2), lane); row_load_f32(shv, modv(C, l, r, 3), lane); row_load_f32(scv, modv(C, l, r, 4), lane); rcur = r; }
        RowV x, y; xraw_get(x, xa, fin); yraw_get(y, ya);
#pragma unroll
        for (int j = 0; j < 4; ++j) x.v[j] = x.v[j] * ALPHA + g2v.v[j] * y.v[j];
        row_ln(x, lane); row_affine_v(x, lgv, lbv);
        if (dry) row_store_f32(x, (float*)(ows(C.ws_) + WS_R + R_BIG) + (size_t)m * D, lane); else x_store(x, C, m, lane);
        row_ln(x, lane); row_mod_v(x, shv, scv);
        row_store_fp8(x, (dry ? (unsigned char*)H : h8buf(C)) + (size_t)m * D, lane);
        if (moe) {
            float lg[8];
#pragma unroll
            for (int e = 0; e < 8; ++e) { float s = 0.f;
#pragma unroll
                for (int j = 0; j < 4; ++j) { const f32x4 w = *(const LAS f32x4*)(WR + e * 1024 + 4 * lane + 256 * j); s += (x.v[j][0] * w[0] + x.v[j][1] * w[1]) + (x.v[j][2] * w[2] + x.v[j][3] * w[3]); }
                lg[e] = wave_sum(s); }
            if (lane == 0 && !dry) {
                int e1 = 0; float v1 = lg[0];
#pragma unroll
                for (int e = 1; e < 8; ++e) if (lg[e] > v1) { v1 = lg[e]; e1 = e; }
                int e2 = -1; float v2 = -3.0e38f;
#pragma unroll
                for (int e = 0; e < 8; ++e) if (e != e1 && lg[e] > v2) { v2 = lg[e]; e2 = e; }
                const float w1 = 1.0f / (1.0f + __expf(v2 - v1)), w2 = 1.0f - w1;
                const int r1 = __hip_atomic_fetch_add(&LC[e1], 1, __ATOMIC_RELAXED, __HIP_MEMORY_SCOPE_WORKGROUP), r2 = __hip_atomic_fetch_add(&LC[e2], 1, __ATOMIC_RELAXED, __HIP_MEMORY_SCOPE_WORKGROUP);
                rt[RT_TOKE + (size_t)m * 2] = e1; rt[RT_TOKE + (size_t)m * 2 + 1] = e2;
                rt[RT_TOKR + (size_t)m * 2] = r1; rt[RT_TOKR + (size_t)m * 2 + 1] = r2;
                ((float*)rt)[RT_TOKW + (size_t)m * 2] = w1; ((float*)rt)[RT_TOKW + (size_t)m * 2 + 1] = w2;
            }
        }
        asm volatile("" ::: "memory");
        xa = xb;
#pragma unroll
        for (int j = 0; j < 4; ++j) ya[j] = yb[j];
    }
    if (moe && !dry) {
        __syncthreads();
        if (tid < 8) { unsigned* cnt = (unsigned*)(ows(C.ws_) + WS_CTL) + CW_CNT + (jm * 8 + tid) * 64;
            const unsigned base = __hip_atomic_fetch_add(cnt, (unsigned)LC[tid], __ATOMIC_RELAXED, __HIP_MEMORY_SCOPE_AGENT);
            rt[RT_BLK + (ovx(C) * 32 + ovr(C)) * 8 + tid] = (int)base; }
    }
}
struct RouteInfo { int base[9]; int cnt[8]; int npanels; };
__device__ __forceinline__ void route_info(const Ctx& C, int jm, RouteInfo& R) {
    unsigned* cnt = (unsigned*)(ows(C.ws_) + WS_CTL) + CW_CNT; int b = 0;
#pragma unroll
    for (int e = 0; e < 8; ++e) { const int c = (int)__hip_atomic_load(cnt + (jm * 8 + e) * 64, __ATOMIC_RELAXED, __HIP_MEMORY_SCOPE_AGENT); R.cnt[e] = c; R.base[e] = b; b += ((c + 255) >> 8) << 8; }
    R.base[8] = b; R.npanels = b >> 8;
}
__device__ __forceinline__ void p_route_build(const Ctx& C, int l, int mrows) {
    const int tid = otid();
    const int jm = l >> 1; RouteInfo R; route_info(C, jm, R);
    int* rt = (int*)(ows(C.ws_) + WS_ROUTE); const int rpb = mrows / 256;
    const int gt = oblk() * NTHR + tid, NT = ogrid() * NTHR;
    for (int i = gt; i < mrows * 2; i += NT) { const int m = i >> 1, e = rt[RT_TOKE + i], blk = (m < MLAT ? (m >> 12) : ((m - MLAT) >> 9)) * 32 + ((m & 255) >> 3);
        int be = 0;
#pragma unroll
        for (int q = 0; q < 8; ++q) be = (q == e) ? R.base[q] : be;
        const int slot = be + rt[RT_BLK + blk * 8 + e] + rt[RT_TOKR + i];
        rt[RT_TOKS + i] = slot; rt[RT_S2T + slot] = m; }
    for (int s = gt; s < R.base[8]; s += NT) { int e = 0;
#pragma unroll
        for (int q = 1; q < 8; ++q) e = (s >= R.base[q]) ? q : e;
        int be = 0, ce = 0;
#pragma unroll
        for (int q = 0; q < 8; ++q) { be = (q == e) ? R.base[q] : be; ce = (q == e) ? R.cnt[q] : ce; }
        if (s >= be + ce) rt[RT_S2T + s] = 0;
        if ((s & 255) == 0) rt[RT_PE + (s >> 8)] = e; }
}
__device__ __forceinline__ void p_lnc(const Ctx& C, int l, int mrows, bool dry = false) {
    const int tid = otid(), lane = tid & 63, wave = owave();
    bf16* H = dry ? wsb(C, WS_R + 350 * MiB) : hbuf(C); const bf16* Y2 = wsb(C, WS_R + R_Y2);
    const bool moe = (l & 1); const int* rt = (const int*)(ows(C.ws_) + WS_ROUTE); const int rpb = mrows / 256;
    RowV g5v, shv, scv, lgv, lbv; int rcur = -1;
    row_load_f32(lgv, oin(C.in_)[19] + (size_t)(l * 2 + 1) * D, lane); row_load_f32(lbv, oin(C.in_)[20] + (size_t)(l * 2 + 1) * D, lane);
    const int nrow = rpb / NWAVE, jb = (nrow - 1) * 256 + ovr(C) * NWAVE + wave, mb = lrow(C, jb);
    int sa1 = 0, sa2 = 0, sb1 = 0, sb2 = 0, sc1 = 0, sc2 = 0; float wa1 = 0.f, wa2 = 0.f, wb1 = 0.f, wb2 = 0.f, wc1 = 0.f, wc2 = 0.f;
    if (moe) { sa1 = rt[RT_TOKS + (size_t)mb * 2]; sa2 = rt[RT_TOKS + (size_t)mb * 2 + 1]; wa1 = ((const float*)rt)[RT_TOKW + (size_t)mb * 2]; wa2 = ((const float*)rt)[RT_TOKW + (size_t)mb * 2 + 1];
        if (nrow > 1) { const size_t q = (size_t)lrow(C, jb - 256) * 2; sb1 = rt[RT_TOKS + q]; sb2 = rt[RT_TOKS + q + 1]; wb1 = ((const float*)rt)[RT_TOKW + q]; wb2 = ((const float*)rt)[RT_TOKW + q + 1]; } }
    XRaw xa; u32x2 ya[4], za[4];
    xraw_load(xa, C, mb, lane, false); yraw_load(ya, Y2 + (size_t)(moe ? sa1 : mb) * D, lane); if (moe) yraw_load(za, Y2 + (size_t)sa2 * D, lane); else { za[0] = ya[0]; za[1] = ya[1]; za[2] = ya[2]; za[3] = ya[3]; }
    XRaw xb = xa; u32x2 yb[4] = {ya[0], ya[1], ya[2], ya[3]}, zb[4] = {za[0], za[1], za[2], za[3]};
    for (int k = 0; k < nrow; ++k) {
        const int m = lrow(C, jb - k * 256), mn = lrow(C, k + 1 < nrow ? jb - (k + 1) * 256 : jb), r = row_r(m);
        if (moe && k + 2 < nrow) { const size_t q = (size_t)lrow(C, jb - (k + 2) * 256) * 2; sc1 = rt[RT_TOKS + q]; sc2 = rt[RT_TOKS + q + 1]; wc1 = ((const float*)rt)[RT_TOKW + q]; wc2 = ((const float*)rt)[RT_TOKW + q + 1]; }
        if (k + 1 < nrow) { xraw_load(xb, C, mn, lane, false); yraw_load(yb, Y2 + (size_t)(moe ? sb1 : mn) * D, lane); if (moe) yraw_load(zb, Y2 + (size_t)sb2 * D, lane); }
        if (r != rcur) { row_load_f32(g5v, modv(C, l, r, 5), lane); if (l < DEPTH - 1) { row_load_f32(shv, modv(C, l + 1, r, 0), lane); row_load_f32(scv, modv(C, l + 1, r, 1), lane); } rcur = r; }
        RowV x, y; xraw_get(x, xa, false); yraw_get(y, ya);
        if (moe) { RowV y2; yraw_get(y2, za);
#pragma unroll
            for (int j = 0; j < 4; ++j) y.v[j] = y.v[j] * wa1 + y2.v[j] * wa2; }
#pragma unroll
        for (int j = 0; j < 4; ++j) x.v[j] = x.v[j] * ALPHA + g5v.v[j] * y.v[j];
        row_ln(x, lane); row_affine_v(x, lgv, lbv);
        if (dry) row_store_f32(x, (float*)(ows(C.ws_) + WS_R) + (size_t)m * D, lane); else if (l == DEPTH - 1) row_store_f32(x, oout(C.out_) + (size_t)m * D, lane); else x_store(x, C, m, lane);
        if (l < DEPTH - 1) { row_ln(x, lane); row_mod_v(x, shv, scv); row_store_bf16(x, H + (size_t)m * D, lane); row_store_fp8(x, h8buf(C) + (size_t)m * D, lane); }
        asm volatile("" ::: "memory");
        xa = xb; sa1 = sb1; sa2 = sb2; wa1 = wb1; wa2 = wb2; sb1 = sc1; sb2 = sc2; wb1 = wc1; wb2 = wc2;
#pragma unroll
        for (int j = 0; j < 4; ++j) { ya[j] = yb[j]; za[j] = zb[j]; }
    }
}

__device__ __forceinline__ f32x4 mm4(float a, float b, f32x4 c) { return __builtin_amdgcn_mfma_f32_16x16x4f32(a, b, c, 0, 0, 0); }
__device__ __forceinline__ int gla_row0(int b, int sc) { return sc < 4 ? MLAT + b * TC + sc * 64 : b * T + (sc - 4) * 64; }
constexpr int GL_VT = 0, GL_LA = 9216, GL_SEG = 26112, GL_QT = 28160, GL_KT = 36608, GL_KWT = 45056, GL_DC = 54272, GL_QE = 54528, GL_KE = 64768, GL_SPT = 75008, GL_AT = 85248, GL_RS = 103680;
__device__ __forceinline__ void gla_load_common(const bf16* cols, int m0, int h, LAS unsigned char* lds, int tid, bool with_q) {
    const int row = tid >> 3, seg = tid & 7; const bf16* rp = cols + (size_t)(m0 + row) * NINP;
    { const u32x4 w = *(const u32x4*)(rp + C_V + h * 64 + seg * 8); LAS bf16* vt = (LAS bf16*)(lds + GL_VT) + (seg * 8) * 72 + ((((row >> 3) ^ seg) & 7) << 3) + (row & 7);
      vt[0 * 72] = (bf16)(w.x & 0xffff); vt[1 * 72] = (bf16)(w.x >> 16); vt[2 * 72] = (bf16)(w.y & 0xffff); vt[3 * 72] = (bf16)(w.y >> 16);
      vt[4 * 72] = (bf16)(w.z & 0xffff); vt[5 * 72] = (bf16)(w.z >> 16); vt[6 * 72] = (bf16)(w.w & 0xffff); vt[7 * 72] = (bf16)(w.w >> 16); }
    const int s4 = seg & 3, dir = seg >> 2;
    { const u32x4 a = *(const u32x4*)(rp + (dir ? C_LAB : C_LAF) + h * 32 + s4 * 8); LAS float* d = (LAS float*)(lds + GL_LA) + (dir * 64 + row) * 33 + s4 * 8;
      d[0] = bflo(a.x); d[1] = bfhi(a.x); d[2] = bflo(a.y); d[3] = bfhi(a.y); d[4] = bflo(a.z); d[5] = bfhi(a.z); d[6] = bflo(a.w); d[7] = bfhi(a.w); }
    if (dir == 0 || with_q) { const u32x4 a = *(const u32x4*)(rp + (dir ? C_Q : C_K) + h * 32 + s4 * 8); LAS float* d = (LAS float*)(lds + (dir ? GL_QT : GL_KT)) + row * 33 + s4 * 8;
      d[0] = bflo(a.x); d[1] = bfhi(a.x); d[2] = bflo(a.y); d[3] = bfhi(a.y); d[4] = bflo(a.z); d[5] = bfhi(a.z); d[6] = bflo(a.w); d[7] = bfhi(a.w); }
}
__device__ __forceinline__ void gla1_item(const Ctx& C, int g) {
    const int b = g / 144, rem = g % 144, sc = rem >> 2, h = rem & 3, m0 = gla_row0(b, sc);
    const bf16* cols = wsb(C, WS_R + R_COLS); LAS unsigned char* lds = C.lds;
    const int tid = otid(), lane = tid & 63, w = owave(), lr = lane & 15, lq = lane >> 4;
    gla_load_common(cols, m0, h, lds, tid, false);
    LBAR();
    const int dir = tid >> 8, d = (tid >> 3) & 31, sg = tid & 7;
    LAS float* LA = (LAS float*)(lds + GL_LA) + dir * 64 * 33; LAS float* SEG = (LAS float*)(lds + GL_SEG) + (dir * 32 + d) * 8;
    float v[8], pre[8]; float run = 0.f;
#pragma unroll
    for (int x = 0; x < 8; ++x) { v[x] = LA[(sg * 8 + x) * 33 + d]; run += v[x]; pre[x] = run; }
    SEG[sg] = run;
    LBAR();
    { float off = 0.f, tot = 0.f;
#pragma unroll
      for (int s2 = 0; s2 < 8; ++s2) { const float t2 = SEG[s2]; tot += t2; off += (s2 < sg) ? t2 : 0.f; }
      const LAS float* KT = (const LAS float*)(lds + GL_KT);
      float kw[8];
#pragma unroll
      for (int x = 0; x < 8; ++x) { const float wt = dir == 0 ? __expf(tot - (off + pre[x])) : __expf(off + pre[x] - v[x]); kw[x] = KT[(sg * 8 + x) * 33 + d] * wt; }
      u32x4 o; o.x = pk2(kw[0], kw[1]); o.y = pk2(kw[2], kw[3]); o.z = pk2(kw[4], kw[5]); o.w = pk2(kw[6], kw[7]);
      *(LAS u32x4*)(lds + GL_KWT + ((dir * 32 + d) * 72 + sg * 8) * 2) = o;
      if (sg == 0) ((LAS float*)(lds + GL_DC))[dir * 32 + d] = __expf(tot); }
    LBAR();
    { const int wd = w >> 2, et = w & 3;
      f32x4 a0 = (f32x4){0.f, 0.f, 0.f, 0.f}, a1 = a0;
#pragma unroll
      for (int ks = 0; ks < 2; ++ks) { const bf16x8 av = *(const LAS bf16x8*)(lds + GL_VT + ((et * 16 + lr) * 72 + (((ks * 4 + lq) ^ (2 * et + (lr >> 3))) & 7) * 8) * 2);
          const bf16x8 b0 = *(const LAS bf16x8*)(lds + GL_KWT + ((wd * 32 + lr) * 72 + ks * 32 + lq * 8) * 2), b1 = *(const LAS bf16x8*)(lds + GL_KWT + ((wd * 32 + 16 + lr) * 72 + ks * 32 + lq * 8) * 2);
          a0 = __builtin_amdgcn_mfma_f32_16x16x32_bf16(av, b0, a0, 0, 0, 0); a1 = __builtin_amdgcn_mfma_f32_16x16x32_bf16(av, b1, a1, 0, 0, 0); }
      const int cp = wd ? (sc < 4 ? 3 - sc : 39 - sc) : sc, ch = (b * 4 + h) * 2 + wd;
      float* DH = (float*)(ows(C.ws_) + WS_R + R_DH) + ((size_t)ch * 36 + cp) * 2048;
#pragma unroll
      for (int r = 0; r < 4; ++r) { const int e = et * 16 + 4 * lq + r; DH[e * 32 + lr] = a0[r]; DH[e * 32 + 16 + lr] = a1[r]; }
      if (tid < 64) { const int dd = tid >> 5, d2 = tid & 31; const int cp2 = dd ? (sc < 4 ? 3 - sc : 39 - sc) : sc;
          ((float*)(ows(C.ws_) + WS_R + R_DEC))[((size_t)((b * 4 + h) * 2 + dd) * 36 + cp2) * 32 + d2] = ((const LAS float*)(lds + GL_DC))[dd * 32 + d2]; } }
    LBAR();
}
__device__ __forceinline__ void gla2_all(const Ctx& C) {
    const int tid = otid();
    float* DH = (float*)(ows(C.ws_) + WS_R + R_DH); const float* DEC = (const float*)(ows(C.ws_) + WS_R + R_DEC);
    for (int il = ovr(C) * NTHR + tid; il < 16 * 2048; il += 32 * NTHR) { const int i = ovx(C) * 16 * 2048 + il, ch = i >> 11, el = i & 2047, d = el & 31;
        float* p = DH + (size_t)ch * 36 * 2048 + el; const float* dc = DEC + (size_t)ch * 36 * 32 + d;
        float dh[36], de[36];
#pragma unroll
        for (int cp = 0; cp < 36; ++cp) { dh[cp] = p[(size_t)cp * 2048]; de[cp] = dc[cp * 32]; }
        float S = 0.f;
#pragma unroll
        for (int cp = 0; cp < 36; ++cp) { p[(size_t)cp * 2048] = S; S = de[cp] * S + dh[cp]; } }
}
constexpr int GL_RAW = 106496;
__device__ __forceinline__ void gla3_dma(const Ctx& C, int g, LAS unsigned char* lds, int tid) {
    const int b = g / 144, rem = g % 144, sc = rem >> 2, h = rem & 3, m0 = gla_row0(b, sc);
    const int row = tid >> 3, seg = tid & 7, s4 = seg & 3, dir = seg >> 2; const bf16* rp = wsb(C, WS_R + R_COLS) + (size_t)(m0 + row) * NINP;
    LAS unsigned char* dst = lds + GL_RAW + owave() * 1024;
    __builtin_amdgcn_global_load_lds((const unsigned*)(rp + C_V + h * 64 + seg * 8), (LAS unsigned*)(dst), 16, 0, 0);
    __builtin_amdgcn_global_load_lds((const unsigned*)(rp + (dir ? C_LAB : C_LAF) + h * 32 + s4 * 8), (LAS unsigned*)(dst + 8192), 16, 0, 0);
    __builtin_amdgcn_global_load_lds((const unsigned*)(rp + (dir ? C_Q : C_K) + h * 32 + s4 * 8), (LAS unsigned*)(dst + 16384), 16, 0, 0);
    __builtin_amdgcn_global_load_lds((const unsigned*)(rp + C_R + h * 64 + seg * 8), (LAS unsigned*)(dst + 24576), 16, 0, 0);
}
__device__ __forceinline__ void gla3_item(const Ctx& C, int l, int g, int gnext) {
    const int b = g / 144, rem = g % 144, sc = rem >> 2, h = rem & 3, m0 = gla_row0(b, sc);
    const bf16* cols = wsb(C, WS_R + R_COLS); bf16* YS = wsb(C, WS_R + R_YS); LAS unsigned char* lds = C.lds;
    const int tid = otid(), lane = tid & 63, w = owave(), lr = lane & 15, lq = lane >> 4;
    asm volatile("s_waitcnt vmcnt(0)" ::: "memory"); LBAR();
    u32x2 rwv[2];
    { const int row = tid >> 3, seg = tid & 7, s4 = seg & 3, dir = seg >> 2;
      { const u32x4 w4 = *(const LAS u32x4*)(lds + GL_RAW + tid * 16); LAS bf16* vt = (LAS bf16*)(lds + GL_VT) + (seg * 8) * 72 + ((((row >> 3) ^ seg) & 7) << 3) + (row & 7);
        vt[0 * 72] = (bf16)(w4.x & 0xffff); vt[1 * 72] = (bf16)(w4.x >> 16); vt[2 * 72] = (bf16)(w4.y & 0xffff); vt[3 * 72] = (bf16)(w4.y >> 16);
        vt[4 * 72] = (bf16)(w4.z & 0xffff); vt[5 * 72] = (bf16)(w4.z >> 16); vt[6 * 72] = (bf16)(w4.w & 0xffff); vt[7 * 72] = (bf16)(w4.w >> 16); }
      { const u32x4 a = *(const LAS u32x4*)(lds + GL_RAW + 8192 + tid * 16); LAS float* d = (LAS float*)(lds + GL_LA) + (dir * 64 + row) * 33 + s4 * 8;
        d[0] = bflo(a.x); d[1] = bfhi(a.x); d[2] = bflo(a.y); d[3] = bfhi(a.y); d[4] = bflo(a.z); d[5] = bfhi(a.z); d[6] = bflo(a.w); d[7] = bfhi(a.w); }
      { const u32x4 a = *(const LAS u32x4*)(lds + GL_RAW + 16384 + tid * 16); LAS float* d = (LAS float*)(lds + (dir ? GL_QT : GL_KT)) + row * 33 + s4 * 8;
        d[0] = bflo(a.x); d[1] = bfhi(a.x); d[2] = bflo(a.y); d[3] = bfhi(a.y); d[4] = bflo(a.z); d[5] = bfhi(a.z); d[6] = bflo(a.w); d[7] = bfhi(a.w); }
      { const int jt_ = w >> 1, j_ = jt_ * 16 + lr;
#pragma unroll
        for (int q = 0; q < 2; ++q) { const int e = (2 * (w & 1) + q) * 16 + 4 * lq; rwv[q] = *(const LAS u32x2*)(lds + GL_RAW + 24576 + (j_ * 8 + (e >> 3)) * 16 + (e & 7) * 2); } } }
    { const int dir = tid >> 8, e = (tid >> 2) & 63, dq = tid & 3; const int cp = dir ? (sc < 4 ? 3 - sc : 39 - sc) : sc, ch = (b * 4 + h) * 2 + dir;
      const float* sp = (const float*)(ows(C.ws_) + WS_R + R_DH) + ((size_t)ch * 36 + cp) * 2048 + e * 32 + dq * 8;
      const f32x4 s0 = *(const f32x4*)sp, s1 = *(const f32x4*)(sp + 4);
      u32x4 o; o.x = pk2(s0[0], s0[1]); o.y = pk2(s0[2], s0[3]); o.z = pk2(s1[0], s1[1]); o.w = pk2(s1[2], s1[3]);
      *(LAS u32x4*)(lds + GL_SPT + ((dir * 64 + e) * 40 + dq * 8) * 2) = o; }
    LBAR();
    if (gnext >= 0) gla3_dma(C, gnext, lds, tid);
    { const int dir = tid >> 8, d = (tid >> 3) & 31, sg = tid & 7;
      LAS float* LA = (LAS float*)(lds + GL_LA) + dir * 64 * 33; LAS float* SEG = (LAS float*)(lds + GL_SEG) + (dir * 32 + d) * 8;
      float v[8], pre[8]; float run = 0.f;
#pragma unroll
      for (int x = 0; x < 8; ++x) { v[x] = LA[(sg * 8 + x) * 33 + d]; run += v[x]; pre[x] = run; }
      SEG[sg] = run;
      LBAR();
      float off = 0.f, tot = 0.f;
#pragma unroll
      for (int s2 = 0; s2 < 8; ++s2) { const float t2 = SEG[s2]; tot += t2; off += (s2 < sg) ? t2 : 0.f; }
      const LAS float* QT = (const LAS float*)(lds + GL_QT); const LAS float* KT = (const LAS float*)(lds + GL_KT);
      const int dsw = ((((d >> 3) ^ sg) & 3) << 3) + (d & 7);
      LAS bf16* QE = (LAS bf16*)(lds + GL_QE) + dir * 64 * 40 + dsw; LAS bf16* KE = (LAS bf16*)(lds + GL_KE) + dir * 64 * 40 + dsw;
#pragma unroll
      for (int x = 0; x < 8; ++x) { const int i = sg * 8 + x;
          const float bb = dir == 0 ? (off + pre[x]) : (tot - (off + pre[x] - v[x]));
          QE[i * 40] = (bf16)f2bf(QT[i * 33 + d] * __expf(bb)); KE[i * 40] = (bf16)f2bf(KT[i * 33 + d] * __expf(-bb)); } }
    LBAR();
    { const int dir = w >> 2, jt = w & 3;
      const bf16x8 bq = *(const LAS bf16x8*)(lds + GL_QE + ((dir * 64 + jt * 16 + lr) * 40 + ((lq ^ (2 * jt + (lr >> 3))) & 3) * 8) * 2);
#pragma unroll
      for (int it = 0; it < 4; ++it) { const bf16x8 ak = *(const LAS bf16x8*)(lds + GL_KE + ((dir * 64 + it * 16 + lr) * 40 + ((lq ^ (2 * it + (lr >> 3))) & 3) * 8) * 2);
          const f32x4 a = __builtin_amdgcn_mfma_f32_16x16x32_bf16(ak, bq, (f32x4){0.f, 0.f, 0.f, 0.f}, 0, 0, 0);
          const int j = jt * 16 + lr, i0 = it * 16 + 4 * lq; float m4[4];
#pragma unroll
          for (int r = 0; r < 4; ++r) { const int i = i0 + r; const bool keep = dir ? (i > j) : (i <= j); m4[r] = keep ? a[r] : 0.f; }
          u32x2 o; o.x = pk2(m4[0], m4[1]); o.y = pk2(m4[2], m4[3]);
          *(LAS u32x2*)(lds + GL_AT + ((dir * 64 + j) * 72 + i0) * 2) = o; } }
    LBAR();
    const int jt = w >> 1, et0 = 2 * (w & 1);
    f32x4 o0 = (f32x4){0.f, 0.f, 0.f, 0.f}, o1 = o0;
#pragma unroll
    for (int dir = 0; dir < 2; ++dir) {
#pragma unroll
        for (int ks = 0; ks < 2; ++ks) { const bf16x8 ba = *(const LAS bf16x8*)(lds + GL_AT + ((dir * 64 + jt * 16 + lr) * 72 + ks * 32 + lq * 8) * 2);
            o0 = __builtin_amdgcn_mfma_f32_16x16x32_bf16(*(const LAS bf16x8*)(lds + GL_VT + ((et0 * 16 + lr) * 72 + (((ks * 4 + lq) ^ (2 * et0 + (lr >> 3))) & 7) * 8) * 2), ba, o0, 0, 0, 0);
            o1 = __builtin_amdgcn_mfma_f32_16x16x32_bf16(*(const LAS bf16x8*)(lds + GL_VT + (((et0 + 1) * 16 + lr) * 72 + (((ks * 4 + lq) ^ (2 * (et0 + 1) + (lr >> 3))) & 7) * 8) * 2), ba, o1, 0, 0, 0); }
        const bf16x8 bq = *(const LAS bf16x8*)(lds + GL_QE + ((dir * 64 + jt * 16 + lr) * 40 + ((lq ^ (2 * jt + (lr >> 3))) & 3) * 8) * 2);
        o0 = __builtin_amdgcn_mfma_f32_16x16x32_bf16(*(const LAS bf16x8*)(lds + GL_SPT + ((dir * 64 + et0 * 16 + lr) * 40 + lq * 8) * 2), bq, o0, 0, 0, 0);
        o1 = __builtin_amdgcn_mfma_f32_16x16x32_bf16(*(const LAS bf16x8*)(lds + GL_SPT + ((dir * 64 + (et0 + 1) * 16 + lr) * 40 + lq * 8) * 2), bq, o1, 0, 0, 0);
    }
    { float ss = (o0[0] * o0[0] + o0[1] * o0[1]) + (o0[2] * o0[2] + o0[3] * o0[3]) + (o1[0] * o1[0] + o1[1] * o1[1]) + (o1[2] * o1[2] + o1[3] * o1[3]);
      ss += __shfl_xor(ss, 16); ss += __shfl_xor(ss, 32);
      if (lq == 0) ((LAS float*)(lds + GL_RS))[(jt * 16 + lr) * 2 + (w & 1)] = ss; }
    LBAR();
    { const int j = jt * 16 + lr; const LAS float* RS = (const LAS float*)(lds + GL_RS);
      const float rs = 1.0f / sqrtf((RS[j * 2] + RS[j * 2 + 1]) * (1.0f / 64.0f) + EPS);
      const size_t rowo = (size_t)(m0 + j);
#pragma unroll
      for (int q = 0; q < 2; ++q) { const int e = (et0 + q) * 16 + 4 * lq; const f32x4 o = q ? o1 : o0;
          const u32x2 rw = rwv[q]; const f32x4 gg = *(const f32x4*)(oin(C.in_)[9] + (size_t)l * 256 + h * 64 + e);
          u32x2 ow; ow.x = pk2(o[0] * rs * gg[0] * bflo(rw.x), o[1] * rs * gg[1] * bfhi(rw.x)); ow.y = pk2(o[2] * rs * gg[2] * bflo(rw.y), o[3] * rs * gg[3] * bfhi(rw.y));
          *(u32x2*)(YS + rowo * D + h * 64 + e) = ow; } }
    LBAR();
}

template <int GI> __device__ __forceinline__ void pool_lat_item_t(const Ctx& C, int l, int b, int slab) {
    constexpr int HW = 1 << GI; constexpr int RS = 64 * 16 + 16;
    const int ch0 = slab * 16;
    const bf16* cols = wsb(C, WS_R + R_COLS); bf16* YS = wsb(C, WS_R + R_YS);
    LAS float* G = (LAS float*)C.lds;
    const int tid = otid(), hf = tid & 1;
    u32x4 xin[8];
#pragma unroll
    for (int k = 0; k < 8; ++k) { const int t = (tid + k * NTHR) >> 1; xin[k] = *(const u32x4*)(cols + (size_t)(b * T + t) * NINP + C_POOL + ch0 + hf * 8); }
#pragma unroll
    for (int k = 0; k < 8; ++k) { const int t = (tid + k * NTHR) >> 1; LAS float* d = G + (t >> 6) * RS + (t & 63) * 16 + hf * 8; const u32x4 w = xin[k];
        *(LAS f32x4*)d = (f32x4){bflo(w.x), bfhi(w.x), bflo(w.y), bfhi(w.y)}; *(LAS f32x4*)(d + 4) = (f32x4){bflo(w.z), bfhi(w.z), bflo(w.w), bfhi(w.w)}; }
    LBAR();
#pragma unroll 1
    for (int q = 0; q < 2; ++q) { const int cix = tid + q * NTHR; float p[33]; p[0] = 0.f;
#pragma unroll
        for (int gr = 0; gr < 32; ++gr) p[gr + 1] = p[gr] + G[gr * RS + cix];
#pragma unroll
        for (int gr = 0; gr < 32; ++gr) { const int lo = gr - HW < 0 ? 0 : gr - HW, hi = gr + HW > 32 ? 32 : gr + HW;
            G[gr * RS + cix] = (p[hi] - p[lo]) * (1.0f / (float)(hi - lo)); } }
    LBAR();
    { const int gr = tid >> 4, ch = tid & 15; LAS float* Gr = G + gr * RS + ch; float p[65]; p[0] = 0.f;
#pragma unroll
      for (int gc = 0; gc < 64; ++gc) p[gc + 1] = p[gc] + Gr[gc * 16];
#pragma unroll
      for (int gc = 0; gc < 64; ++gc) { const int lo = gc - HW < 0 ? 0 : gc - HW, hi = gc + HW > 64 ? 64 : gc + HW;
          Gr[gc * 16] = (p[hi] - p[lo]) * (1.0f / (float)(hi - lo)); } }
    LBAR();
    { const float* ps = oin(C.in_)[11] + (size_t)l * 256 + ch0 + hf * 8; const f32x4 s0 = *(const f32x4*)ps, s1 = *(const f32x4*)(ps + 4);
#pragma unroll
      for (int k = 0; k < 8; ++k) { const int t = (tid + k * NTHR) >> 1; const LAS float* d = G + (t >> 6) * RS + (t & 63) * 16 + hf * 8; const f32x4 m0 = *(const LAS f32x4*)d, m1 = *(const LAS f32x4*)(d + 4); const u32x4 w = xin[k];
          u32x4 o; o.x = pk2((m0[0] - bflo(w.x)) * s0[0], (m0[1] - bfhi(w.x)) * s0[1]); o.y = pk2((m0[2] - bflo(w.y)) * s0[2], (m0[3] - bfhi(w.y)) * s0[3]);
          o.z = pk2((m1[0] - bflo(w.z)) * s1[0], (m1[1] - bfhi(w.z)) * s1[1]); o.w = pk2((m1[2] - bflo(w.w)) * s1[2], (m1[3] - bfhi(w.w)) * s1[3]);
          *(u32x4*)(YS + (size_t)(b * T + t) * D + 256 + ch0 + hf * 8) = o; } }
    LBAR();
}
__device__ __forceinline__ void pool_lat_item(const Ctx& C, int l, int p) {
    const int b = p >> 4, slab = p & 15, gi = slab >> 2;
    if (gi == 0) pool_lat_item_t<0>(C, l, b, slab); else if (gi == 1) pool_lat_item_t<1>(C, l, b, slab); else if (gi == 2) pool_lat_item_t<2>(C, l, b, slab); else pool_lat_item_t<3>(C, l, b, slab);
}
__device__ __forceinline__ void pool_ctx_item(const Ctx& C, int l, int p) {
    const int b = p >> 2, gi = p & 3, hw = 1 << gi;
    const bf16* cols = wsb(C, WS_R + R_COLS); bf16* YS = wsb(C, WS_R + R_YS);
    LAS float* G = (LAS float*)C.lds;
    const int tid = otid(), sg = tid & 7;
    u32x4 xin[4];
#pragma unroll
    for (int k = 0; k < 4; ++k) { const int t = (tid + k * NTHR) >> 3; xin[k] = *(const u32x4*)(cols + (size_t)(MLAT + b * TC + t) * NINP + C_POOL + gi * 64 + sg * 8); }
#pragma unroll
    for (int k = 0; k < 4; ++k) { const int t = (tid + k * NTHR) >> 3; LAS float* d = G + t * 64 + sg * 8; const u32x4 w = xin[k];
        *(LAS f32x4*)d = (f32x4){bflo(w.x), bfhi(w.x), bflo(w.y), bfhi(w.y)}; *(LAS f32x4*)(d + 4) = (f32x4){bflo(w.z), bfhi(w.z), bflo(w.w), bfhi(w.w)}; }
    LBAR();
    { const float* ps = oin(C.in_)[11] + (size_t)l * 256 + gi * 64 + sg * 8; const f32x4 s0 = *(const f32x4*)ps, s1 = *(const f32x4*)(ps + 4);
#pragma unroll
      for (int k = 0; k < 4; ++k) { const int t = (tid + k * NTHR) >> 3, lo = t - hw < 0 ? 0 : t - hw, hi = t + hw > 256 ? 256 : t + hw;
          f32x4 a0 = (f32x4){0.f, 0.f, 0.f, 0.f}, a1 = a0;
          for (int t2 = lo; t2 < hi; ++t2) { const LAS float* d = G + t2 * 64 + sg * 8; a0 += *(const LAS f32x4*)d; a1 += *(const LAS f32x4*)(d + 4); }
          const float inv = 1.0f / (float)(hi - lo); const u32x4 w = xin[k];
          u32x4 o; o.x = pk2((a0[0] * inv - bflo(w.x)) * s0[0], (a0[1] * inv - bfhi(w.x)) * s0[1]); o.y = pk2((a0[2] * inv - bflo(w.y)) * s0[2], (a0[3] * inv - bfhi(w.y)) * s0[3]);
          o.z = pk2((a1[0] * inv - bflo(w.z)) * s1[0], (a1[1] * inv - bfhi(w.z)) * s1[1]); o.w = pk2((a1[2] * inv - bflo(w.w)) * s1[2], (a1[3] * inv - bfhi(w.w)) * s1[3]);
          *(u32x4*)(YS + (size_t)(MLAT + b * TC + t) * D + 256 + gi * 64 + sg * 8) = o; } }
    LBAR();
}
__device__ __forceinline__ void sgu_item(const Ctx& C, int l, int s, bool loadw) {
    int m0, g;
    if (s < 1024) { const int b = s >> 6, n = (s >> 2) & 15; g = s & 3; m0 = b * T + n * 128; }
    else { const int s2 = s - 1024, b = s2 >> 3, n = (s2 >> 2) & 1; g = s2 & 3; m0 = MLAT + b * TC + n * 128; }
    const bf16* cols = wsb(C, WS_R + R_COLS); bf16* YS = wsb(C, WS_R + R_YS); LAS unsigned char* lds = C.lds;
    constexpr int SG_W = 0, SG_V = 34816;
    const int tid = otid(), lane = tid & 63, w = owave(), lr = lane & 15, lq = lane >> 4;
    if (loadw) { const bf16* wg = wsb(C, WS_SGUW) + (size_t)(l * 4 + g) * 128 * 128;
#pragma unroll
      for (int q = 0; q < 4; ++q) { const int i = tid + q * NTHR, r = i >> 4, c16 = i & 15; *(LAS u32x4*)(lds + SG_W + (r * 136 + c16 * 8) * 2) = *(const u32x4*)(wg + r * 128 + c16 * 8); } }
    const int srow = w * 16 + lr; const size_t rowo = (size_t)(m0 + srow); u32x2 uw[4];
#pragma unroll
    for (int ct = 0; ct < 4; ++ct) uw[ct] = *(const u32x2*)(cols + rowo * NINP + C_SU + g * 64 + ct * 16 + 4 * lq);
    const float bias = oin(C.in_)[15][(size_t)(l * 4 + g) * 128 + srow];
    { const int row = tid >> 2, q = tid & 3; const bf16* rp = cols + (size_t)(m0 + row) * NINP + C_SV + q * 64; float v[64]; float sm4[4] = {0.f, 0.f, 0.f, 0.f};
      const u32x4 own0 = *(const u32x4*)(cols + (size_t)(m0 + row) * NINP + C_SV + g * 64 + q * 16), own1 = *(const u32x4*)(cols + (size_t)(m0 + row) * NINP + C_SV + g * 64 + q * 16 + 8);
#pragma unroll
      for (int i = 0; i < 8; ++i) { const u32x4 x = *(const u32x4*)(rp + i * 8); v[8 * i] = bflo(x.x); v[8 * i + 1] = bfhi(x.x); v[8 * i + 2] = bflo(x.y); v[8 * i + 3] = bfhi(x.y); v[8 * i + 4] = bflo(x.z); v[8 * i + 5] = bfhi(x.z); v[8 * i + 6] = bflo(x.w); v[8 * i + 7] = bfhi(x.w); }
#pragma unroll
      for (int i = 0; i < 64; ++i) sm4[i & 3] += v[i];
      float sm = (sm4[0] + sm4[1]) + (sm4[2] + sm4[3]);
      sm += __shfl_xor(sm, 1); sm += __shfl_xor(sm, 2); const float mean = sm * (1.0f / 256.0f); float sq4[4] = {0.f, 0.f, 0.f, 0.f};
#pragma unroll
      for (int i = 0; i < 64; ++i) { v[i] -= mean; sq4[i & 3] += v[i] * v[i]; }
      float sq = (sq4[0] + sq4[1]) + (sq4[2] + sq4[3]);
      sq += __shfl_xor(sq, 1); sq += __shfl_xor(sq, 2); const float rstd = __builtin_amdgcn_rsqf(sq * (1.0f / 256.0f) + EPS);
      { const float* lg = oin(C.in_)[12] + (size_t)l * 256 + g * 64 + q * 16; const float* lb = oin(C.in_)[13] + (size_t)l * 256 + g * 64 + q * 16; LAS bf16* vt = (LAS bf16*)(lds + SG_V) + (q * 16) * 136 + row;
        const unsigned ow[8] = {own0.x, own0.y, own0.z, own0.w, own1.x, own1.y, own1.z, own1.w};
#pragma unroll
        for (int i = 0; i < 8; ++i) { vt[(2 * i) * 136] = (bf16)f2bf((bflo(ow[i]) - mean) * rstd * lg[2 * i] + lb[2 * i]); vt[(2 * i + 1) * 136] = (bf16)f2bf((bfhi(ow[i]) - mean) * rstd * lg[2 * i + 1] + lb[2 * i + 1]); } } }
    LBAR();
    f32x4 a[4];
#pragma unroll
    for (int ct = 0; ct < 4; ++ct) a[ct] = (f32x4){0.f, 0.f, 0.f, 0.f};
#pragma unroll
    for (int ks = 0; ks < 4; ++ks) { const bf16x8 bw = *(const LAS bf16x8*)(lds + SG_W + ((w * 16 + lr) * 136 + ks * 32 + lq * 8) * 2);
#pragma unroll
        for (int ct = 0; ct < 4; ++ct) a[ct] = __builtin_amdgcn_mfma_f32_16x16x32_bf16(*(const LAS bf16x8*)(lds + SG_V + ((ct * 16 + lr) * 136 + ks * 32 + lq * 8) * 2), bw, a[ct], 0, 0, 0); }
#pragma unroll
    for (int ct = 0; ct < 4; ++ct) { const int c = ct * 16 + 4 * lq;
        u32x2 o; o.x = pk2(bflo(uw[ct].x) * (a[ct][0] + bias), bfhi(uw[ct].x) * (a[ct][1] + bias)); o.y = pk2(bflo(uw[ct].y) * (a[ct][2] + bias), bfhi(uw[ct].y) * (a[ct][3] + bias));
        *(u32x2*)(YS + rowo * D + 768 + g * 64 + c) = o; }
    LBAR();
}
__device__ __forceinline__ void cdft_tile(const Ctx& C, int c) {
    const bf16* cols = wsb(C, WS_R + R_COLS); const bf16* CS = wsb(C, WS_CS64);
    const int tid = otid(), lane = tid & 63, wave = owave(), wr = wave >> 2, wc = wave & 3, fr = lane & 15, fq = lane >> 4;
    const bf16* pa0 = CS + (size_t)(tid >> 3) * 64 + (tid & 7) * 8; const bf16* pa1 = pa0 + 64 * 64;
    if (c < 1024) {
        const int b = c >> 6, g = (c >> 4) & 3, bq = c & 15; bf16* ZT = wsb(C, WS_R + R_ZT) + (size_t)b * 256 * 4096;
        const int n0 = tid >> 3, n1 = n0 + 64;
        const int t0 = 64 * (n0 & 31) + 4 * bq + (n0 >> 5), t1 = 64 * (n1 & 31) + 4 * bq + (n1 >> 5);
        const bf16* pb0 = cols + (size_t)(b * T + t0) * NINP + C_FFT + g * 64 + (tid & 7) * 8; const bf16* pb1 = cols + (size_t)(b * T + t1) * NINP + C_FFT + g * 64 + (tid & 7) * 8;
        f32x4 acc[4][2]; tg_zero(acc); tg_tile(acc, C.lds, pa0, pa1, pb0, pb1, 1);
#pragma unroll
        for (int m = 0; m < 4; ++m)
#pragma unroll
            for (int n = 0; n < 2; ++n) { const int row = wr * 64 + m * 16 + fr, col = wc * 32 + n * 16 + 4 * fq;
                const int p = row >> 6, mm = row & 63, j = col >> 5, a = col & 31; u32x2 w; w.x = pk2(acc[m][n][0], acc[m][n][1]); w.y = pk2(acc[m][n][2], acc[m][n][3]);
                *(u32x2*)(ZT + ((size_t)((g * 64 + mm) * 2 + p) * 64 + 4 * bq + j) * 32 + a) = w; }
    } else {
        const int c2 = c - 1024, b = c2 >> 3, g = (c2 >> 1) & 3, tt = c2 & 1, m0 = MLAT + b * TC + tt * 128; bf16* ZT = wsb(C, WS_R + R_ZTC) + (size_t)b * 256 * 512;
        const bf16* pb0 = cols + (size_t)(m0 + (tid >> 3)) * NINP + C_FFT + g * 64 + (tid & 7) * 8; const bf16* pb1 = pb0 + (size_t)64 * NINP;
        f32x4 acc[4][2]; tg_zero(acc); tg_tile(acc, C.lds, pa0, pa1, pb0, pb1, 1);
#pragma unroll
        for (int m = 0; m < 4; ++m)
#pragma unroll
            for (int n = 0; n < 2; ++n) { const int row = wr * 64 + m * 16 + fr, col = wc * 32 + n * 16 + 4 * fq;
                const int p = row >> 6, mm = row & 63; u32x2 w; w.x = pk2(acc[m][n][0], acc[m][n][1]); w.y = pk2(acc[m][n][2], acc[m][n][3]);
                *(u32x2*)(ZT + (size_t)(g * 64 + mm) * (2 * TC) + p * TC + tt * 128 + col) = w; }
    }
}
constexpr int FF_X = 0, FF_T1 = 81920, FF_T2 = 90112, FF_TW = 106496, FF_OUT = 0;
__device__ __forceinline__ void fft_load_tables(const Ctx& C) {
    const int tid = otid(); const u32x4* src = (const u32x4*)(ows(C.ws_) + WS_TF1);
#pragma unroll
    for (int q = 0; q < 5; ++q) { const int i = tid + q * NTHR; *(LAS u32x4*)(C.lds + FF_T1 + i * 16) = src[i]; }
    LBAR();
}
__device__ __forceinline__ void fft_item(const Ctx& C, int item) {
    const int b = item >> 5, ch0 = (item & 31) * 8; LAS unsigned char* lds = C.lds;
    const int tid = otid(), lane = tid & 63, w = owave(), lr = lane & 15, lq = lane >> 4;
    LAS unsigned char* fx = lds + FF_X + w * 10240;
    { const u32x4* src = (const u32x4*)(wsb(C, WS_R + R_ZT) + ((size_t)(b * 256 + ch0 + w)) * 4096);
#pragma unroll
      for (int i = 0; i < 8; ++i) { const int q = lane + 64 * i; *(LAS u32x4*)(fx + (q >> 2) * 80 + (q & 3) * 16) = src[q]; } }
    f32x4 acc1[4][4];
#pragma unroll
    for (int rt = 0; rt < 4; ++rt)
#pragma unroll
        for (int ct = 0; ct < 4; ++ct) acc1[rt][ct] = (f32x4){0.f, 0.f, 0.f, 0.f};
#pragma unroll
    for (int ks = 0; ks < 2; ++ks) { bf16x8 af[4];
#pragma unroll
        for (int rt = 0; rt < 4; ++rt) af[rt] = *(const LAS bf16x8*)(fx + (ks * 64 + 16 * rt + lr) * 80 + lq * 16);
#pragma unroll
        for (int ct = 0; ct < 4; ++ct) { const bf16x8 bfr = *(const LAS bf16x8*)(lds + FF_T1 + ((ct * 2 + ks) * 64 + lane) * 16);
#pragma unroll
            for (int rt = 0; rt < 4; ++rt) acc1[rt][ct] = __builtin_amdgcn_mfma_f32_16x16x32_bf16(af[rt], bfr, acc1[rt][ct], 0, 0, 0); } }
    bf16x8 VR[2][2], VI[2][2];
#pragma unroll
    for (int ct = 0; ct < 2; ++ct)
#pragma unroll
        for (int ks = 0; ks < 2; ++ks) { float vr[8], vi[8];
#pragma unroll
            for (int hf = 0; hf < 2; ++hf) { const int rt = 2 * ks + hf;
#pragma unroll
                for (int r = 0; r < 4; ++r) { const f32x2 tw = *(const LAS f32x2*)(lds + FF_TW + (((rt * 2 + ct) * 4 + r) * 64 + lane) * 8);
                    const float ur = acc1[rt][ct][r], ui = acc1[rt][ct + 2][r]; vr[hf * 4 + r] = ur * tw.x + ui * tw.y; vi[hf * 4 + r] = ui * tw.x - ur * tw.y; } }
            u32x4 pr, pi; pr.x = pk2(vr[0], vr[1]); pr.y = pk2(vr[2], vr[3]); pr.z = pk2(vr[4], vr[5]); pr.w = pk2(vr[6], vr[7]);
            pi.x = pk2(vi[0], vi[1]); pi.y = pk2(vi[2], vi[3]); pi.z = pk2(vi[4], vi[5]); pi.w = pk2(vi[6], vi[7]);
            VR[ct][ks] = __builtin_bit_cast(bf16x8, pr); VI[ct][ks] = __builtin_bit_cast(bf16x8, pi); }
    LBAR();
#pragma unroll
    for (int dt = 0; dt < 4; ++dt) { bf16x8 fc[2], fs[2];
#pragma unroll
        for (int ks = 0; ks < 2; ++ks) { fc[ks] = *(const LAS bf16x8*)(lds + FF_T2 + (((0 * 4 + dt) * 2 + ks) * 64 + lane) * 16); fs[ks] = *(const LAS bf16x8*)(lds + FF_T2 + (((1 * 4 + dt) * 2 + ks) * 64 + lane) * 16); }
#pragma unroll
        for (int ct = 0; ct < 2; ++ct) { f32x4 o = (f32x4){0.f, 0.f, 0.f, 0.f};
#pragma unroll
            for (int ks = 0; ks < 2; ++ks) { o = __builtin_amdgcn_mfma_f32_16x16x32_bf16(fc[ks], VR[ct][ks], o, 0, 0, 0); o = __builtin_amdgcn_mfma_f32_16x16x32_bf16(fs[ks], VI[ct][ks], o, 0, 0, 0); }
#pragma unroll
            for (int r = 0; r < 4; ++r) { const int d = 16 * dt + 4 * lq + r, c = 16 * ct + lr, k = c + 32 * d; *(LAS bf16*)(lds + FF_OUT + (k * 8 + w) * 2) = (bf16)f2bf(o[r]); } } }
    LBAR();
    { bf16* YS = wsb(C, WS_R + R_YS);
#pragma unroll
      for (int i = 0; i < 4; ++i) { const int k = tid + NTHR * i; *(u32x4*)(YS + (size_t)(b * T + k) * D + 512 + ch0) = *(const LAS u32x4*)(lds + FF_OUT + k * 16); } }
    LBAR();
}

constexpr bool LOCAL_BARS = true;
__global__ void __launch_bounds__(NTHR, 2) fwd_kernel(Params prm) {
    extern __shared__ __attribute__((aligned(16))) unsigned char lds_raw[];
    Ctx C; C.lds = (LAS unsigned char*)lds_raw; C.ws_ = prm.ws; C.in_ = prm.in; C.out_ = prm.out; C.vx = 0; C.vr = 0; C.loc = 0;

    volatile LAS unsigned* MISC = (volatile LAS unsigned*)(C.lds + LDS_MISC);
    if (threadIdx.x < 16) MISC[threadIdx.x] = 0u;
    __syncthreads();
    (void)xcd_barrier_post((unsigned*)(ows(C.ws_) + WS_CTL) + CW_BAR, MISC + 8);
#define BAR_(rel) do { XcdBarrier b_; b_.bar = (unsigned*)(ows(C.ws_) + WS_CTL) + CW_BAR; b_.x = (unsigned)__builtin_amdgcn_readfirstlane((int)xb_xcc_id()); b_.st = MISC + 8; xcd_barrier(b_, rel); } while (0)
#define GRID_BAR() BAR_(true)
#define BAR_X() BAR_(oloc(C) == 0)
#define BAR_L() do { if (LOCAL_BARS && oloc(C)) xcd_local_barrier((unsigned*)(ows(C.ws_) + WS_CTL) + CW_BAR, (unsigned)__builtin_amdgcn_readfirstlane((int)xb_xcc_id())); else BAR_(oloc(C) == 0); } while (0)

    p_prologue(C); GRID_BAR();
    { const int ok = (int)MISC[8 + 2];
      C.loc = __builtin_amdgcn_readfirstlane(ok); C.vx = __builtin_amdgcn_readfirstlane(ok ? (int)MISC[8 + 4] : (oblk() >> 5)); C.vr = __builtin_amdgcn_readfirstlane(ok ? (int)MISC[8 + 3] : (oblk() & 31)); }
    p_lna(C); BAR_L();

#pragma unroll 1
    for (int l = 0; l < DEPTH; ++l) {
        const bool last = (l == DEPTH - 1); const int mrows = last ? MLAT : M;
        const int nMl = last ? 16 : 18;
        const bf16* H = hbuf(C);
        { pg8::Gemm g{H, wW(C, WE_WIN + (size_t)l * 6144 * 1024), D, nullptr, D}; pg8::Sched<0> S; S.go.init_l(18, NINP / 256, ovr(C), ovx(C)); S.bp0 = 0; S.p0 = 0; S.pe = nullptr;
          { const int tid = otid(); if (tid < 64) *(LAS f32x4*)(C.lds + 131072 + tid * 16) = *(const f32x4*)(oin(C.in_)[8] + (size_t)l * 256 + tid * 4); __syncthreads(); }
          pg8::EpiCols E{wsb(C, WS_R + R_COLS)};
          pg8::gemm_phase<pg8::EpiCols, pg8::Sched<0>, false>(C.lds, g, S, E); }
        BAR_L();
        { const int nG = 288, nPL = 32, nPC = last ? 0 : 8, nSl = 128, nSc = last ? 0 : 16, nDl = 128, nDc = last ? 0 : 16;
          const int tot = nG + nPL + nPC + nSl + nSc + nDl + nDc, vx = ovx(C);
          for (int it = ovr(C); it < tot; it += 32) { int i = it;
              if (i < nG) { gla1_item(C, 288 * vx + i); continue; } i -= nG;
              if (i < nPL) { pool_lat_item(C, l, 32 * vx + i); continue; } i -= nPL;
              if (i < nPC) { pool_ctx_item(C, l, 8 * vx + i); continue; } i -= nPC;
              if (i < nSl + nSc) { sgu_item(C, l, i < nSl ? 128 * vx + i : 1024 + 16 * vx + (i - nSl), i < 32); continue; } i -= nSl + nSc;
              cdft_tile(C, i < nDl ? 128 * vx + i : 1024 + 16 * vx + (i - nDl)); } }
        BAR_L();
        gla2_all(C);
        fft_load_tables(C);
        for (int it = ovr(C); it < 64; it += 32) fft_item(C, 64 * ovx(C) + it);
        BAR_L();
        { { const int g00 = 288 * ovx(C); int it = ovr(C);
            while (it < 288 && last && ((g00 + it) % 144) < 16) it += 32;
            if (it < 288) gla3_dma(C, g00 + it, C.lds, otid());
            while (it < 288) { int nx = it + 32; while (nx < 288 && last && ((g00 + nx) % 144) < 16) nx += 32;
                gla3_item(C, l, g00 + it, nx < 288 ? g00 + nx : -1); it = nx; } }
          bf16* YS = wsb(C, WS_R + R_YS);
          const int tid = otid(), lane = tid & 63, wave = owave(), wr = wave >> 2, wc = wave & 3, fr = lane & 15, fq = lane >> 4;
          const int nctx = last ? 0 : 8;
          for (int t2l = ovr(C); t2l < nctx; t2l += 32) { const int t2 = 8 * ovx(C) + t2l;
              const int b = t2 >> 2, tm = (t2 >> 1) & 1, tn = t2 & 1, K = 2 * TC, mrow0 = MLAT + b * TC; const bf16* A = wsb(C, WS_DLC); const bf16* Bt = wsb(C, WS_R + R_ZTC) + (size_t)b * 256 * 512;
              const bf16* pa0 = A + (size_t)(tm * 128 + (tid >> 3)) * K + (tid & 7) * 8; const bf16* pa1 = pa0 + (size_t)64 * K;
              const bf16* pb0 = Bt + (size_t)(tn * 128 + (tid >> 3)) * K + (tid & 7) * 8; const bf16* pb1 = pb0 + (size_t)64 * K;
              f32x4 acc[4][2]; tg_zero(acc); tg_tile(acc, C.lds, pa0, pa1, pb0, pb1, K / 64);
#pragma unroll
              for (int m = 0; m < 4; ++m)
#pragma unroll
                  for (int n = 0; n < 2; ++n) { const int row = mrow0 + tm * 128 + wr * 64 + m * 16 + fr, col = tn * 128 + wc * 32 + n * 16 + 4 * fq;
                      u32x2 w; w.x = pk2(acc[m][n][0], acc[m][n][1]); w.y = pk2(acc[m][n][2], acc[m][n][3]); *(u32x2*)(YS + (size_t)row * D + 512 + col) = w; }
          }
        }
        BAR_X();
        { pg8::Gemm g{wsb(C, WS_R + R_YS), wW(C, WE_WBR + (size_t)l * 4 * 1024 * 256), 256, nullptr, D}; pg8::Sched<4> S; S.go.init_l(nMl, 16, ovr(C), ovx(C), 1); S.bp0 = 0; S.p0 = 0; S.pe = nullptr;
          pg8::EpiP E{wsb(C, WS_R + R_G)};
          pg8::gemm_phase<pg8::EpiP, pg8::Sched<4>, false>(C.lds, g, S, E); }
        BAR_L();
        { pg8::Gemm g{(const bf16*)h8buf(C), (const bf16*)(ows(C.ws_) + WS_G8 + (size_t)l * 4096 * 1024), D / 2, nullptr, D / 2}; pg8::Sched<0> S; S.go.init_l(nMl, 16, ovr(C), ovx(C)); S.bp0 = 0; S.p0 = 0; S.pe = nullptr;
          pg8::EpiGateMix E{wsb(C, WS_R + R_G), wsb(C, WS_R + R_MM), 1.0f / G8_SCALE};
          pg8::gemm_phase<pg8::EpiGateMix, pg8::Sched<0>, false, true>(C.lds, g, S, E); }
        BAR_L();
        { pg8::Gemm g{wsb(C, WS_R + R_MM), wW(C, WE_WO + (size_t)l * D * D), D, nullptr, D}; pg8::Sched<0> S; S.go.init_l(nMl, 4, ovr(C), ovx(C), 1); S.bp0 = 0; S.p0 = 0; S.pe = nullptr;
          pg8::EpiAct E{wsb(C, WS_R + R_YS), D, EM_NONE, nullptr};
          pg8::gemm_phase<pg8::EpiAct, pg8::Sched<0>, false>(C.lds, g, S, E); }
        BAR_L();
        p_lnb(C, l, mrows);
        const bool moe = (l & 1); const int jm = l >> 1;
        if (moe) GRID_BAR(); else BAR_X();
        int npanels = mrows / 256;
        if (moe) { p_route_build(C, l, mrows); GRID_BAR(); RouteInfo R; route_info(C, jm, R); npanels = R.npanels; }
        { const int* rt = (const int*)(ows(C.ws_) + WS_ROUTE); const int* s2t = moe ? rt + RT_S2T : rt + RT_IDT; const int* pe = rt + RT_PE;
          const bf16* WGU = moe ? wW(C, WE_GUE + (size_t)jm * 8 * 5632 * 1024) : wW(C, WE_GUD + (size_t)jm * 5632 * 1024);
          const bf16* WDN = moe ? wW(C, WE_DE + (size_t)jm * 8 * 1024 * 2816) : wW(C, WE_DD + (size_t)jm * 1024 * 2816);
          bf16* ACT = wsb(C, WS_R + R_ACT); bf16* Y2 = wsb(C, WS_R + R_Y2);
          const int pcap = moe ? (DOWN8_MOE ? 296 : 128) : 144;
#pragma unroll 1
          for (int p0 = 0; p0 < npanels; p0 += pcap) { const int np = (npanels - p0) < pcap ? (npanels - p0) : pcap;
              const bool own = moe && oloc(C);
              const int plo = (np * ovx(C)) >> 3, phi = (np * (ovx(C) + 1)) >> 3;
              { pg8::Gemm g{(const bf16*)h8buf(C), WGU, D / 2, s2t, D / 2}; pg8::Sched<2> S; if (own) S.go.init_p(phi - plo, 22, ovr(C), plo); else if (moe) S.go.init(np, 22, ogrid(), oblk()); else S.go.init_l(nMl, 22, ovr(C), ovx(C), 1); S.bp0 = 0; S.p0 = p0; S.pe = moe ? pe : nullptr;
                const bool f8down = moe ? DOWN8_MOE : DOWN8_DENSE;
                pg8::EpiSwiGLU E{ACT, DFF, 1.0f / G8_SCALE, f8down ? ACT8_SCALE : 0.f};
                pg8::gemm_phase<pg8::EpiSwiGLU, pg8::Sched<2>, true, true>(C.lds, g, S, E); }
              if (moe && !own) GRID_BAR(); else BAR_L();
              if (moe ? DOWN8_MOE : DOWN8_DENSE) { pg8::Gemm g{ACT, WDN, DFF / 2, nullptr, DFF / 2}; pg8::Sched<3> S; if (own) S.go.init_p(phi - plo, 4, ovr(C), plo, 1); else if (moe) S.go.init(np, 4, ogrid(), oblk()); else S.go.init_l(nMl, 4, ovr(C), ovx(C)); S.bp0 = 8; S.p0 = p0; S.pe = moe ? pe : nullptr;
                pg8::EpiScale E{Y2, D, 1.0f / (G8_SCALE * ACT8_SCALE)};
                pg8::gemm_phase<pg8::EpiScale, pg8::Sched<3>, false, true>(C.lds, g, S, E); }
              else { pg8::Gemm g{ACT, WDN, DFF, nullptr, DFF}; pg8::Sched<3> S; if (own) S.go.init_p(phi - plo, 4, ovr(C), plo, 1); else if (moe) S.go.init(np, 4, ogrid(), oblk()); else S.go.init_l(nMl, 4, ovr(C), ovx(C)); S.bp0 = 4; S.p0 = p0; S.pe = moe ? pe : nullptr;
                pg8::EpiAct E{Y2, D, EM_NONE, nullptr};
                pg8::gemm_phase<pg8::EpiAct, pg8::Sched<3>, false>(C.lds, g, S, E); }
              if (!moe) BAR_L(); else if (own && p0 + np < npanels) BAR_X(); else GRID_BAR();
          } }
        p_lnc(C, l, mrows);
        if (!last) BAR_X();
    }
}

extern "C" void kernel_launch(void* const* d_in, const int* in_sizes, int n_in, void* d_out, int out_size, void* d_ws, size_t ws_size, hipStream_t stream) {
    static int grid = 0;
    if (grid == 0) {
        if (n_in != 28 || out_size != MLAT * D || ws_size < WS_END) { fprintf(stderr, "kernel_launch: unexpected shapes (n_in %d, out %d, ws %zu < %zu)\n", n_in, out_size, ws_size, (size_t)WS_END); grid = -1; return; }
        int dev = 0, cus = 0, per_cu = 0;
        if (hipGetDevice(&dev) != hipSuccess || hipDeviceGetAttribute(&cus, hipDeviceAttributeMultiprocessorCount, dev) != hipSuccess) { grid = -1; return; }
        if (hipFuncSetAttribute((const void*)fwd_kernel, hipFuncAttributeMaxDynamicSharedMemorySize, LDS_BYTES) != hipSuccess) { fprintf(stderr, "kernel_launch: hipFuncSetAttribute failed\n"); grid = -1; return; }
        if (hipOccupancyMaxActiveBlocksPerMultiprocessor(&per_cu, (const void*)fwd_kernel, NTHR, LDS_BYTES) != hipSuccess || per_cu < 1) fprintf(stderr, "kernel_launch: occupancy query says %d\n", per_cu);
        (void)hipGetLastError();
        grid = cus;
        if (grid != 256) { fprintf(stderr, "kernel_launch: built for 256 CUs, device has %d\n", cus); grid = -1; return; }
    }
    if (grid < 0) return;
    if (hipMemsetAsync((char*)d_ws + WS_CTL, 0, CTL_BYTES, stream) != hipSuccess) return;
    Params p{};
    for (int i = 0; i < 28; ++i) p.in[i] = (const float*)d_in[i];
    p.out = (float*)d_out; p.ws = (unsigned char*)d_ws;
    hipLaunchKernelGGL(fwd_kernel, dim3(grid), dim3(NTHR), LDS_BYTES, stream, p);
}
```
